# Optimizing an MI355X kernel written in HIP

```python
import jax, jax.numpy as jnp
from jax import lax
import numpy as np

D_MODEL = 1024
BATCH = 2
SEQ = 8192
DEPTH = 4
DEC_BATCH = 8
DEC_SEQ = 16
PAST_LEN = 4096

CHUNK = 64
N_A_LAYERS = DEPTH // 2
N_B_LAYERS = DEPTH - N_A_LAYERS
POOL_WINDOWS = (2, 4, 8, 16)
N_POOL_GROUPS = 4
POOL_GROUP_DIM = D_MODEL // N_POOL_GROUPS
POOL_HIST = max(POOL_WINDOWS) - 1
HEAD_DIM = 64
N_HEADS = D_MODEL // HEAD_DIM
N_KV_HEADS = 4
GQA_GROUP = N_HEADS // N_KV_HEADS
WINDOW = 128
WINDOW_CHUNKS = WINDOW // CHUNK
D_FF = -(-8 * D_MODEL // (3 * 256)) * 256
EPS = 1e-6
NEG_INF = -1e30

kernel_name = 'yoco_pool_swa_sink_stream_step'


def rms_norm(x, g):
    xf = x.astype(jnp.float32)
    y = xf * lax.rsqrt(jnp.mean(xf * xf, axis=-1, keepdims=True) + EPS)
    return (y * g.astype(jnp.float32)).astype(x.dtype)


def modulate(h, shift, scale):
    return h * (1 + scale[:, None, :]) + shift[:, None, :]


def pool_mixer(h, hist, pos0, w_pool, pool_scale):
    B, L, D = h.shape
    ext = jnp.concatenate([hist.astype(h.dtype), h], axis=1)
    csum = jnp.pad(jnp.cumsum(ext.astype(jnp.float32), axis=1), ((0, 0), (1, 0), (0, 0)))
    end = csum[:, POOL_HIST + 1:POOL_HIST + 1 + L, :]
    pos = pos0 + jnp.arange(L)
    parts = []
    for g, w in enumerate(POOL_WINDOWS):
        sl = slice(g * POOL_GROUP_DIM, (g + 1) * POOL_GROUP_DIM)
        start = csum[:, POOL_HIST + 1 - w:POOL_HIST + 1 - w + L, sl]
        count = jnp.minimum(w, pos + 1).astype(jnp.float32)[None, :, None]
        parts.append((end[..., sl] - start) / count)
    pooled = jnp.concatenate(parts, axis=-1)
    diff = (pooled - h.astype(jnp.float32)).astype(h.dtype).reshape(B, L, N_POOL_GROUPS, POOL_GROUP_DIM)
    out = jnp.einsum('blgc,gce->blge', diff, w_pool).reshape(B, L, D)
    return out * pool_scale


def window_attention(q, k_ext, v_ext, pos0, sinks):
    B, L = q.shape[0], q.shape[1]
    nb = -(-L // CHUNK)
    pad = nb * CHUNK - L
    qb = jnp.pad(q, ((0, 0), (0, pad), (0, 0), (0, 0))).reshape(B, nb, CHUNK, N_KV_HEADS, GQA_GROUP, HEAD_DIM)
    kblk = jnp.pad(k_ext, ((0, 0), (0, pad), (0, 0), (0, 0))).reshape(B, nb + WINDOW_CHUNKS, CHUNK, N_KV_HEADS, HEAD_DIM)
    vblk = jnp.pad(v_ext, ((0, 0), (0, pad), (0, 0), (0, 0))).reshape(B, nb + WINDOW_CHUNKS, CHUNK, N_KV_HEADS, HEAD_DIM)
    kb = jnp.concatenate([kblk[:, j:j + nb] for j in range(WINDOW_CHUNKS + 1)], axis=2)
    vb = jnp.concatenate([vblk[:, j:j + nb] for j in range(WINDOW_CHUNKS + 1)], axis=2)
    idx = jnp.arange((nb + WINDOW_CHUNKS) * CHUNK)
    valid = ((pos0 - WINDOW + idx) >= 0) & (idx < WINDOW + L)
    vmask = valid.reshape(nb + WINDOW_CHUNKS, CHUNK)
    mask = jnp.concatenate([vmask[j:j + nb] for j in range(WINDOW_CHUNKS + 1)], axis=1)
    logits = jnp.einsum('bnqkgd,bnskd->bnkgqs', qb.astype(jnp.float32), kb.astype(jnp.float32)) * (HEAD_DIM ** -0.5)
    logits = jnp.where(mask[None, :, None, None, None, :], logits, NEG_INF)
    sink = sinks.astype(jnp.float32).reshape(1, 1, N_KV_HEADS, GQA_GROUP, 1, 1)
    m = jnp.maximum(jnp.max(logits, axis=-1, keepdims=True), sink)
    p = jnp.exp(logits - m)
    denom = jnp.sum(p, axis=-1, keepdims=True) + jnp.exp(sink - m)
    out = jnp.einsum('bnkgqs,bnskd->bnqkgd', p / denom, vb.astype(jnp.float32))
    return out.reshape(B, nb * CHUNK, N_HEADS * HEAD_DIM)[:, :L].astype(q.dtype)


def swiglu(h, w_in, w_out):
    gate, up = jnp.split(h @ w_in, 2, axis=-1)
    return (jax.nn.silu(gate) * up) @ w_out


def trunk(x, c, pool_hist, k_hist, v_hist, pos0, w_ada, b_ada, g_mix, g_ffn, w_pool, pool_scale,
          w_q, g_q, sinks, w_o, g_kv, w_ada_kv, b_ada_kv, w_kv, g_k, w_ffn_in, w_ffn_out):
    B, L = x.shape[0], x.shape[1]
    c_act = jax.nn.silu(c)
    new_pool = []
    k_ext = None
    v_ext = None
    for i in range(DEPTH):
        ada = c_act @ w_ada[i] + b_ada[i]
        sh1, sc1, g1, sh2, sc2, g2 = jnp.split(ada, 6, axis=-1)
        h = modulate(rms_norm(x, g_mix[i]), sh1, sc1)
        if i < N_A_LAYERS:
            hist = pool_hist[i].astype(h.dtype)
            new_pool.append(jnp.concatenate([hist, h], axis=1)[:, -POOL_HIST:])
            mix = pool_mixer(h, hist, pos0, w_pool[i], pool_scale[i])
        else:
            j = i - N_A_LAYERS
            q = rms_norm((h @ w_q[j]).reshape(B, L, N_HEADS, HEAD_DIM), g_q[j])
            mix = window_attention(q, k_ext, v_ext, pos0, sinks[j]) @ w_o[j]
        x = x + g1[:, None, :] * mix
        h = modulate(rms_norm(x, g_ffn[i]), sh2, sc2)
        x = x + g2[:, None, :] * swiglu(h, w_ffn_in[i], w_ffn_out[i])
        if i == N_A_LAYERS - 1:
            sh_kv, sc_kv = jnp.split(c_act @ w_ada_kv + b_ada_kv, 2, axis=-1)
            hkv = modulate(rms_norm(x, g_kv), sh_kv, sc_kv)
            kv = (hkv @ w_kv).reshape(B, L, 2, N_KV_HEADS, HEAD_DIM)
            k_new = rms_norm(kv[:, :, 0], g_k)
            v_new = kv[:, :, 1]
            k_ext = jnp.concatenate([k_hist.astype(k_new.dtype), k_new], axis=1)
            v_ext = jnp.concatenate([v_hist.astype(v_new.dtype), v_new], axis=1)
    return x, jnp.stack(new_pool, axis=0), k_ext[:, -WINDOW:], v_ext[:, -WINDOW:]


def setup_inputs(seed: int = 0) -> dict:
    key = jax.random.key(seed)
    ks = jax.random.split(key, 32)
    nrm = jax.random.normal
    D = D_MODEL
    return {
        'x_prompt': nrm(ks[0], (BATCH, SEQ, D), jnp.float32),
        'x_sample': nrm(ks[1], (DEC_BATCH, DEC_SEQ, D), jnp.float32),
        'c_prompt': nrm(ks[2], (BATCH, D), jnp.float32),
        'c_sample': nrm(ks[3], (DEC_BATCH, D), jnp.float32),
        'state_pool': nrm(ks[4], (N_A_LAYERS, DEC_BATCH, POOL_HIST, D), jnp.float32),
        'cache_k': nrm(ks[5], (DEC_BATCH, WINDOW, N_KV_HEADS, HEAD_DIM), jnp.float32),
        'cache_v': nrm(ks[6], (DEC_BATCH, WINDOW, N_KV_HEADS, HEAD_DIM), jnp.float32),
        'w_ada': nrm(ks[7], (DEPTH, D, 6 * D), jnp.float32) * (0.3 * D ** -0.5),
        'b_ada': nrm(ks[8], (DEPTH, 6 * D), jnp.float32) * 0.02,
        'g_mix': 1.0 + 0.05 * nrm(ks[9], (DEPTH, D), jnp.float32),
        'g_ffn': 1.0 + 0.05 * nrm(ks[10], (DEPTH, D), jnp.float32),
        'w_pool': nrm(ks[11], (N_A_LAYERS, N_POOL_GROUPS, POOL_GROUP_DIM, POOL_GROUP_DIM), jnp.float32) * POOL_GROUP_DIM ** -0.5,
        'pool_scale': 1.0 + 0.1 * nrm(ks[12], (N_A_LAYERS, D), jnp.float32),
        'w_q': nrm(ks[13], (N_B_LAYERS, D, N_HEADS * HEAD_DIM), jnp.float32) * D ** -0.5,
        'g_q': 1.0 + 0.05 * nrm(ks[14], (N_B_LAYERS, HEAD_DIM), jnp.float32),
        'sinks': 0.5 * nrm(ks[15], (N_B_LAYERS, N_HEADS), jnp.float32),
        'w_o': nrm(ks[16], (N_B_LAYERS, N_HEADS * HEAD_DIM, D), jnp.float32) * (N_HEADS * HEAD_DIM) ** -0.5,
        'g_kv': 1.0 + 0.05 * nrm(ks[17], (D,), jnp.float32),
        'w_ada_kv': nrm(ks[18], (D, 2 * D), jnp.float32) * (0.3 * D ** -0.5),
        'b_ada_kv': nrm(ks[19], (2 * D,), jnp.float32) * 0.02,
        'w_kv': nrm(ks[20], (D, 2 * N_KV_HEADS * HEAD_DIM), jnp.float32) * D ** -0.5,
        'g_k': 1.0 + 0.05 * nrm(ks[21], (HEAD_DIM,), jnp.float32),
        'w_ffn_in': nrm(ks[22], (DEPTH, D, 2 * D_FF), jnp.float32) * D ** -0.5,
        'w_ffn_out': nrm(ks[23], (DEPTH, D_FF, D), jnp.float32) * D_FF ** -0.5,
    }


def reference(x_prompt, x_sample, c_prompt, c_sample, state_pool, cache_k, cache_v,
              w_ada, b_ada, g_mix, g_ffn, w_pool, pool_scale, w_q, g_q, sinks, w_o,
              g_kv, w_ada_kv, b_ada_kv, w_kv, g_k, w_ffn_in, w_ffn_out):
    B = x_prompt.shape[0]
    pool_zero = jnp.zeros((N_A_LAYERS, B, POOL_HIST, D_MODEL), x_prompt.dtype)
    kv_zero = jnp.zeros((B, WINDOW, N_KV_HEADS, HEAD_DIM), x_prompt.dtype)
    y_prompt, pool_p, k_p, v_p = trunk(x_prompt, c_prompt, pool_zero, kv_zero, kv_zero, 0,
                                       w_ada, b_ada, g_mix, g_ffn, w_pool, pool_scale, w_q, g_q, sinks, w_o,
                                       g_kv, w_ada_kv, b_ada_kv, w_kv, g_k, w_ffn_in, w_ffn_out)
    y_sample, pool_s, k_s, v_s = trunk(x_sample, c_sample, state_pool, cache_k, cache_v, PAST_LEN,
                                       w_ada, b_ada, g_mix, g_ffn, w_pool, pool_scale, w_q, g_q, sinks, w_o,
                                       g_kv, w_ada_kv, b_ada_kv, w_kv, g_k, w_ffn_in, w_ffn_out)
    return (y_prompt, y_sample, pool_p, k_p, v_p, pool_s, k_s, v_s)
```

```cpp
#include <hip/hip_runtime.h>
#include <cstdio>
#include <cstdint>

#define LAS __attribute__((address_space(3)))
typedef unsigned short bf16_t;
typedef short bf16x8 __attribute__((ext_vector_type(8)));
typedef short s16x4 __attribute__((ext_vector_type(4)));
typedef float f32x2 __attribute__((ext_vector_type(2)));
typedef float f32x4 __attribute__((ext_vector_type(4)));
typedef float f32x16 __attribute__((ext_vector_type(16)));
typedef unsigned u32x2 __attribute__((ext_vector_type(2)));
typedef unsigned u32x4 __attribute__((ext_vector_type(4)));
typedef __bf16 bf16x2_t __attribute__((ext_vector_type(2)));

#ifndef MK_ONE_LAUNCH
#define MK_ONE_LAUNCH 1
#endif

constexpr int D = 1024, SEQ = 8192, NBP = 2, NBS = 8, LS = 16, NBATCH = 10;
constexpr int MP = NBP * SEQ, MS = NBS * LS, MREAL = MP + MS, NTM = 65, MPAD = NTM * 256;
constexpr int DFF = 2816, NIN = 2 * DFF, HD = 64, NH = 16, NKV = 4, KVD = NKV * HD, WIN = 128, PH = 15;
constexpr int ADAW = 6 * D;
constexpr float EPS = 1e-6f;
constexpr int NPHASE = 19;

constexpr size_t O_Y = 0, O_POOLP = (size_t)MREAL * D, O_KP = O_POOLP + 2 * NBP * PH * D, O_VP = O_KP + (size_t)NBP * WIN * KVD,
                 O_POOLS = O_VP + (size_t)NBP * WIN * KVD, O_KS = O_POOLS + 2 * NBS * PH * D, O_VS = O_KS + (size_t)NBS * WIN * KVD, O_END = O_VS + (size_t)NBS * WIN * KVD;

constexpr size_t MiB = 1u << 20;
constexpr size_t WS_CTL = 0, CTL_ZERO_BYTES = 1 * MiB;
constexpr size_t WS_ADA = 1 * MiB, WS_ADAKV = 2 * MiB, WS_BIN = 3 * MiB, WS_BQ = 4 * MiB, WS_BKV = 4 * MiB + 128 * 1024, WS_SS = 5 * MiB, WS_T = 7 * MiB;
constexpr int T_GATE1 = 0, T_GAINF = 4, T_GATE2 = 8, T_GAINQ = 12, T_GAINKV = 14, T_NVEC = 15, TV = NBATCH * D;
constexpr size_t WS_WPOOL = 8 * MiB, WS_WQ = 9 * MiB, WS_WO = 13 * MiB, WS_WKV = 17 * MiB, WS_WIN = 18 * MiB, WS_WOUT = 62 * MiB;
constexpr size_t WS_KC = 84 * MiB, WS_VC = 84 * MiB + 512 * 1024, WS_KB = 85 * MiB, WS_VB = 94 * MiB;
constexpr size_t WS_AQ = 104 * MiB, WS_AB = 137 * MiB, WS_QO = 170 * MiB, WS_H = 203 * MiB, WS_END = 293 * MiB;
static_assert((size_t)MPAD * D * 2 <= 33 * MiB && (size_t)MPAD * DFF * 2 <= 90 * MiB && (size_t)MPAD * KVD * 2 <= 9 * MiB && (size_t)MPAD * 16 * 4 <= 3 * MiB, "ws map");
constexpr int CW_BAR = 4096;

__device__ __forceinline__ unsigned pk_bf16(float lo, float hi) { f32x2 v = {lo, hi}; bf16x2_t b = __builtin_convertvector(v, bf16x2_t); return __builtin_bit_cast(unsigned, b); }
__device__ __forceinline__ float bf_lo(unsigned u) { return __uint_as_float(u << 16); }
__device__ __forceinline__ float bf_hi(unsigned u) { return __uint_as_float(u & 0xffff0000u); }
__device__ __forceinline__ float wave_sum(float v) {
#pragma unroll
    for (int o = 1; o < 64; o <<= 1) v += __shfl_xor(v, o);
    return v;
}
__device__ __forceinline__ int batch_of(int row16) { return row16 < MP ? (row16 >> 13) : min(2 + ((row16 - MP) >> 4), NBATCH - 1); }
#define LDS_WAIT() asm volatile("s_waitcnt lgkmcnt(0)" ::: "memory")
#define VM_WAIT() asm volatile("s_waitcnt vmcnt(0)" ::: "memory")

namespace pg8 {
constexpr int BM = 256, BK = 64, HALF = 128, HTB = HALF * BK * 2, STAGE_BYTES = 8 * HTB, NXCD = 8, WGM = 8;
__host__ __device__ __forceinline__ int lds_byte(int r, int c) { const int st = (r >> 4) * 2 + (c >> 5), rr = r & 15, cc = c & 31, ob = rr * 64 + cc * 2; return st * 1024 + (ob ^ (((ob >> 9) & 1) << 5)); }
__host__ __device__ __forceinline__ void stage_rc(int b, int& R, int& C) { const int st = b / 1024, sb = b % 1024, swz = sb ^ (((sb >> 9) & 1) << 5); R = (st >> 1) * 16 + swz / 64; C = (st & 1) * 32 + (swz % 64) / 2; }
__host__ __device__ __forceinline__ int perm32(int rho) { const int n = rho >> 4, i = rho & 15; return 8 * (i >> 2) + 4 * n + (i & 3); }

struct Unit { int pm, pn; };
struct Gemm { const bf16_t* A; const bf16_t* Bt; int lda; int a_pn_off; int K; };

struct StaticOrder {
    int nM, nN, nwg, G, c;
    __host__ __device__ void init(int nM_, int nN_, int G_, int c_) { nM = nM_; nN = nN_; nwg = nM * nN; G = G_; c = c_; }
    __host__ __device__ bool next(int i, Unit& u) const {
        const long L = (long)i * G + c; if (L >= nwg) return false;
        int wgid = (int)L; { const int q = nwg / NXCD, r = nwg % NXCD, xcd = wgid % NXCD, off = wgid / NXCD; wgid = (xcd < r ? xcd * (q + 1) : r * (q + 1) + (xcd - r) * q) + off; }
        const int nig = WGM * nN, gid = wgid / nig, fm = gid * WGM, gsz = (nM - fm) < WGM ? (nM - fm) : WGM;
        u.pm = fm + ((wgid % nig) % gsz); u.pn = (wgid % nig) / gsz; return true;
    }
};

template <class Epi, class Sched, bool ALIGN_EPI = false>
__device__ __forceinline__ void gemm_phase(LAS unsigned char* lds, const int tid, const Gemm g, const Sched& S, const Epi& E) {
    const int wid = __builtin_amdgcn_readfirstlane(tid >> 6), lane = tid & 63, wr = wid >> 2, wc = wid & 3, fr = lane & 15, fq = lane >> 4;
    const int K = g.K, nt = K / BK, lda = g.lda;
    unsigned voffA[2], voffB[2];
#pragma unroll
    for (int i = 0; i < 2; ++i) { int R, C; stage_rc(tid * 16 + i * 8192, R, C); const int Rb = Epi::PERM ? ((R & ~31) + perm32(R & 31)) : R;
        voffA[i] = (unsigned)(R * lda + C) * 2u; voffB[i] = (unsigned)(Rb * K + C) * 2u; }
    const size_t kstep = (size_t)(BK * 2);
    const size_t hstepA = (size_t)HALF * lda * 2, hstepB = (size_t)HALF * K * 2;
    const size_t tstepA = 2 * hstepA, tstepB = 2 * hstepB;
    const unsigned ldsw = (unsigned)wid * 1024u;
    const int aoff = lds_byte(wr * 64 + fr, fq * 8), boff = lds_byte(wc * 32 + fr, fq * 8);
#define PG8_SA(b, h) (((b) * 2 + (h)) * HTB)
#define PG8_SB(b, h) ((4 + (b) * 2 + (h)) * HTB)
#define PG8_STAGE(bufoff, gbase, voff) do { _Pragma("unroll") for (int _i = 0; _i < 2; ++_i) \
        __builtin_amdgcn_global_load_lds((const unsigned*)((const char*)(gbase) + (voff)[_i]), (LAS unsigned*)(lds + (bufoff) + ldsw + _i * 8192), 16, 0, 0); } while (0)
#define PG8_LDA(dst, b, h) do { _Pragma("unroll") for (int m = 0; m < 4; ++m) _Pragma("unroll") for (int k = 0; k < 2; ++k) dst[m][k] = *(const LAS bf16x8*)(lds + PG8_SA(b, h) + aoff + m * 2048 + k * 1024); } while (0)
#define PG8_LDB(dst, b, h) do { _Pragma("unroll") for (int n = 0; n < 2; ++n) _Pragma("unroll") for (int k = 0; k < 2; ++k) dst[n][k] = *(const LAS bf16x8*)(lds + PG8_SB(b, h) + boff + n * 2048 + k * 1024); } while (0)
#define PG8_MMA(ai, bj, At, Bt) do { __builtin_amdgcn_s_setprio(1); _Pragma("unroll") for (int m = 0; m < 4; ++m) _Pragma("unroll") for (int n = 0; n < 2; ++n) _Pragma("unroll") for (int k = 0; k < 2; ++k) \
        acc[ai][bj][m][n] = __builtin_amdgcn_mfma_f32_16x16x32_bf16(Bt[n][k], At[m][k], acc[ai][bj][m][n], 0, 0, 0); __builtin_amdgcn_s_setprio(0); } while (0)
#define PG8_WAIT_V(n) asm volatile("s_waitcnt vmcnt(" #n ")" ::: "memory")
#define PG8_WAIT_L(n) asm volatile("s_waitcnt lgkmcnt(" #n ")" ::: "memory")
#define PG8_BAR __builtin_amdgcn_s_barrier()
#define PG8_SCHED __builtin_amdgcn_sched_barrier(0)
    Unit cur, nxt; int ui = 0;
    if (!S.next(0, cur)) return;
    f32x4 acc[2][2][4][2];
#pragma unroll
    for (int a = 0; a < 2; ++a)
#pragma unroll
        for (int b = 0; b < 2; ++b)
#pragma unroll
            for (int m = 0; m < 4; ++m)
#pragma unroll
                for (int n = 0; n < 2; ++n) acc[a][b][m][n] = (f32x4){0.f, 0.f, 0.f, 0.f};
    bf16x8 At[4][2], B0[2][2], B1[2][2];
    const char* cA = (const char*)g.A + (size_t)cur.pm * tstepA + (size_t)cur.pn * g.a_pn_off * 2; const char* cB = (const char*)g.Bt + (size_t)cur.pn * tstepB;
    PG8_STAGE(PG8_SB(0, 0), cB, voffB); PG8_STAGE(PG8_SB(0, 1), cB + hstepB, voffB); PG8_STAGE(PG8_SA(0, 0), cA, voffA); PG8_STAGE(PG8_SA(0, 1), cA + hstepA, voffA);
    if (wr == 1) PG8_BAR;
    PG8_WAIT_V(2); PG8_BAR;
    PG8_STAGE(PG8_SB(1, 0), cB + kstep, voffB); PG8_STAGE(PG8_SA(1, 0), cA + kstep, voffA); PG8_STAGE(PG8_SB(1, 1), cB + hstepB + kstep, voffB);
    PG8_WAIT_V(6); PG8_BAR;
    for (;;) {
        const bool has_next = S.next(ui + 1, nxt);
        const char* nA = has_next ? (const char*)g.A + (size_t)nxt.pm * tstepA + (size_t)nxt.pn * g.a_pn_off * 2 : cA; const char* nB = has_next ? (const char*)g.Bt + (size_t)nxt.pn * tstepB : cB;
        for (int t = 0; t < nt; t += 2) {
            const bool last = (t == nt - 2);
            const char* a1 = cA + (size_t)(t + 1) * kstep;
            const char* a2 = last ? nA : cA + (size_t)(t + 2) * kstep; const char* b2 = last ? nB : cB + (size_t)(t + 2) * kstep;
            const char* a3 = a2 + kstep; const char* b3 = b2 + kstep;
            PG8_LDB(B0, 0, 0); PG8_LDB(B1, 0, 1); PG8_SCHED; PG8_LDA(At, 0, 0); PG8_STAGE(PG8_SA(1, 1), a1 + hstepA, voffA);
            PG8_WAIT_V(8); PG8_WAIT_L(0); PG8_BAR; PG8_MMA(0, 0, At, B0); PG8_MMA(0, 1, At, B1); PG8_BAR; PG8_SCHED;
            PG8_LDA(At, 0, 1); PG8_STAGE(PG8_SB(0, 0), b2, voffB); PG8_STAGE(PG8_SB(0, 1), b2 + hstepB, voffB); PG8_STAGE(PG8_SA(0, 0), a2, voffA);
            PG8_WAIT_V(8); PG8_WAIT_L(0); PG8_BAR; PG8_MMA(1, 0, At, B0); PG8_MMA(1, 1, At, B1); PG8_BAR; PG8_SCHED;
            PG8_LDB(B0, 1, 0); PG8_LDB(B1, 1, 1); PG8_SCHED; PG8_LDA(At, 1, 0); PG8_STAGE(PG8_SA(0, 1), a2 + hstepA, voffA);
            PG8_WAIT_V(8); PG8_WAIT_L(0); PG8_BAR; PG8_MMA(0, 0, At, B0); PG8_MMA(0, 1, At, B1); PG8_BAR; PG8_SCHED;
            PG8_LDA(At, 1, 1); PG8_STAGE(PG8_SB(1, 0), b3, voffB); PG8_STAGE(PG8_SB(1, 1), b3 + hstepB, voffB); PG8_STAGE(PG8_SA(1, 0), a3, voffA);
            PG8_WAIT_V(8); PG8_WAIT_L(0); PG8_BAR; PG8_MMA(1, 0, At, B0); PG8_MMA(1, 1, At, B1); PG8_BAR; PG8_SCHED;
        }
        if constexpr (ALIGN_EPI) { if (wr == 0) PG8_BAR; }
        E(acc, cur, wr, wc, fr, fq);
        if (!has_next) break;
#pragma unroll
        for (int a = 0; a < 2; ++a)
#pragma unroll
            for (int b = 0; b < 2; ++b)
#pragma unroll
                for (int m = 0; m < 4; ++m)
#pragma unroll
                    for (int n = 0; n < 2; ++n) acc[a][b][m][n] = (f32x4){0.f, 0.f, 0.f, 0.f};
        cur = nxt; cA = nA; cB = nB; ++ui;
        if constexpr (ALIGN_EPI) { if (wr == 1) PG8_BAR; }
    }
    PG8_WAIT_V(0);
    if constexpr (!ALIGN_EPI) { if (wr == 0) PG8_BAR; }
    PG8_BAR;
#undef PG8_SA
#undef PG8_SB
#undef PG8_STAGE
#undef PG8_LDA
#undef PG8_LDB
#undef PG8_MMA
#undef PG8_WAIT_V
#undef PG8_WAIT_L
#undef PG8_BAR
#undef PG8_SCHED
}


template <bool XIN, int NA, bool HAS_SS> struct EpiRes {
    static constexpr bool PERM = false;
    LAS const unsigned char* xin_lds;
    float* X; unsigned char* ws;
    int gate_id, g1_id, g2_id;
    __device__ __forceinline__ void operator()(const f32x4 (&acc)[2][2][4][2], const Unit& u, int wr, int wc, int fr, int fq) const {
        const float* T = (const float*)(ws + WS_T);
        bf16_t* A1 = (bf16_t*)(ws + WS_AQ); bf16_t* A2 = (bf16_t*)(ws + WS_AB); float* SS = (float*)(ws + WS_SS);
        const float* gate = T + gate_id * TV; const float* g1 = T + g1_id * TV; const float* g2 = T + g2_id * TV;
        const unsigned colb = (unsigned)(u.pn * BM + wc * 32 + 4 * fq);
        const float* xo = X;
        if (XIN) { const unsigned long long pv = ((const LAS unsigned long long*)xin_lds)[u.pm < MP / BM ? 0 : 1];
            xo = (const float*)(((unsigned long long)(unsigned)__builtin_amdgcn_readfirstlane((int)(pv >> 32)) << 32) | (unsigned)__builtin_amdgcn_readfirstlane((int)pv)); }
#pragma unroll
        for (int ai = 0; ai < 2; ++ai)
#pragma unroll
            for (int m = 0; m < 4; ++m) {
                const int row16 = u.pm * BM + ai * HALF + wr * 64 + m * 16, row = row16 + fr, b = batch_of(row16);
                const int rowc = row < MREAL ? row : MREAL - 1;
                const unsigned xoff = (unsigned)rowc * D + colb, ooff = (unsigned)row * D + colb, toff = (unsigned)b * D + colb;
                float ss = 0.f;
#pragma unroll
                for (int bj = 0; bj < 2; ++bj) {
#pragma unroll
                    for (int n = 0; n < 2; ++n) {
                        const unsigned co = bj * HALF + n * 16;
                        const f32x4 x4 = *(const f32x4*)(xo + xoff + co);
                        const f32x4 g4 = *(const f32x4*)(gate + toff + co);
                        const f32x4 xn = x4 + g4 * acc[ai][bj][m][n];
                        if (row < MREAL) *(f32x4*)(X + ooff + co) = xn;
                        if (HAS_SS) ss += (xn[0] * xn[0] + xn[1] * xn[1]) + (xn[2] * xn[2] + xn[3] * xn[3]);
                        if (NA >= 1) { const f32x4 a = xn * *(const f32x4*)(g1 + toff + co); u32x2 w; w.x = pk_bf16(a[0], a[1]); w.y = pk_bf16(a[2], a[3]); *(u32x2*)(A1 + ooff + co) = w; }
                        if (NA >= 2) { const f32x4 a = xn * *(const f32x4*)(g2 + toff + co); u32x2 w; w.x = pk_bf16(a[0], a[1]); w.y = pk_bf16(a[2], a[3]); *(u32x2*)(A2 + ooff + co) = w; }
                        if (XIN) asm volatile("" ::: "memory");
                    }
                    asm volatile("" ::: "memory");
                }
                if (HAS_SS) { ss += __shfl_xor(ss, 16); ss += __shfl_xor(ss, 32); if (fq == 0) SS[(unsigned)row * 16 + u.pn * 4 + wc] = ss; }
            }
    }
};

__device__ __forceinline__ float row_rstd(const float* SS, int row) {
    const f32x4* p = (const f32x4*)(SS + (unsigned)row * 16);
    const f32x4 a = p[0], b = p[1], c = p[2], d = p[3];
    const float s = ((a[0] + a[1]) + (a[2] + a[3])) + ((b[0] + b[1]) + (b[2] + b[3])) + ((c[0] + c[1]) + (c[2] + c[3])) + ((d[0] + d[1]) + (d[2] + d[3]));
    return 1.0f / sqrtf(s * (1.0f / D) + EPS);
}
__device__ __forceinline__ float silu_f(float g) { return g * __builtin_amdgcn_rcpf(1.0f + __builtin_amdgcn_exp2f(-1.4426950408889634f * g)); }

struct EpiSwiglu {
    static constexpr bool PERM = true;
    const float* SS; const float* bias;
    bf16_t* H;
    __device__ __forceinline__ void operator()(const f32x4 (&acc)[2][2][4][2], const Unit& u, int wr, int wc, int fr, int fq) const {
        const int pc = u.pn * BM + wc * 32 + 8 * fq;
#pragma unroll
        for (int ai = 0; ai < 2; ++ai)
#pragma unroll
            for (int m = 0; m < 4; ++m) {
                const int row16 = u.pm * BM + ai * HALF + wr * 64 + m * 16, row = row16 + fr, b = batch_of(row16);
                const float rs = row_rstd(SS, row);
                const float* bp = bias + (size_t)b * NIN + pc;
                u32x4 w;
#pragma unroll
                for (int n = 0; n < 2; ++n) {
                    const f32x4 bg = *(const f32x4*)(bp + 4 * n), bu = *(const f32x4*)(bp + HALF + 4 * n);
                    const f32x4 gv = acc[ai][0][m][n] * rs + bg, uv = acc[ai][1][m][n] * rs + bu;
                    const float h0 = silu_f(gv[0]) * uv[0], h1 = silu_f(gv[1]) * uv[1], h2 = silu_f(gv[2]) * uv[2], h3 = silu_f(gv[3]) * uv[3];
                    if (n == 0) { w.x = pk_bf16(h0, h1); w.y = pk_bf16(h2, h3); } else { w.z = pk_bf16(h0, h1); w.w = pk_bf16(h2, h3); }
                }
                *(u32x4*)(H + (size_t)row * DFF + u.pn * HALF + wc * 32 + 8 * fq) = w;
                asm volatile("" ::: "memory");
            }
    }
};

template <int MODE> struct EpiHead {
    static constexpr bool PERM = true;
    const float* SS; const float* bias; int bias_stride; const float* gvec; float oscale;
    bf16_t* O0; bf16_t* O1; float* fk_p; float* fv_p; float* fk_s; float* fv_s;
    __device__ __forceinline__ void operator()(const f32x4 (&acc)[2][2][4][2], const Unit& u, int wr, int wc, int fr, int fq) const {
        const bool isv = (MODE == 1) && (u.pn == 1);
        const int ldo = (MODE == 0) ? D : KVD;
        const int ocol = (MODE == 0 ? (4 * u.pn + wc) * HD : wc * HD) + 8 * fq;
        bf16_t* Ob = (MODE == 0) ? O0 : (isv ? O1 : O0);
#pragma unroll
        for (int ai = 0; ai < 2; ++ai)
#pragma unroll
            for (int m = 0; m < 4; ++m) {
                const int row16 = u.pm * BM + ai * HALF + wr * 64 + m * 16, row = row16 + fr, b = batch_of(row16);
                const float rs = row_rstd(SS, row);
                const float* bp = bias + (size_t)b * bias_stride + u.pn * BM + wc * 32 + 8 * fq;
                f32x4 v[2][2]; float ss = 0.f;
#pragma unroll
                for (int bj = 0; bj < 2; ++bj)
#pragma unroll
                    for (int n = 0; n < 2; ++n) { v[bj][n] = acc[ai][bj][m][n] * rs + *(const f32x4*)(bp + bj * HALF + 4 * n);
                        ss += (v[bj][n][0] * v[bj][n][0] + v[bj][n][1] * v[bj][n][1]) + (v[bj][n][2] * v[bj][n][2] + v[bj][n][3] * v[bj][n][3]); }
                ss += __shfl_xor(ss, 16); ss += __shfl_xor(ss, 32);
                const float hr = 1.0f / sqrtf(ss * (1.0f / HD) + EPS);
                if (!isv) {
#pragma unroll
                    for (int bj = 0; bj < 2; ++bj)
#pragma unroll
                        for (int n = 0; n < 2; ++n) v[bj][n] = v[bj][n] * (hr * oscale) * *(const f32x4*)(gvec + 32 * bj + 8 * fq + 4 * n);
                }
                float* ftail = nullptr;
                if (MODE == 1) {
                    if (row < MP) { const int t = row & (SEQ - 1); if (t >= SEQ - WIN) ftail = (isv ? fv_p : fk_p) + ((size_t)(row >> 13) * WIN + (t - (SEQ - WIN))) * KVD; }
                    else if (row < MREAL) { const int bs = (row - MP) >> 4, t = (row - MP) & 15; ftail = (isv ? fv_s : fk_s) + ((size_t)bs * WIN + (WIN - LS) + t) * KVD; }
                }
#pragma unroll
                for (int bj = 0; bj < 2; ++bj) {
                    u32x4 w; w.x = pk_bf16(v[bj][0][0], v[bj][0][1]); w.y = pk_bf16(v[bj][0][2], v[bj][0][3]); w.z = pk_bf16(v[bj][1][0], v[bj][1][1]); w.w = pk_bf16(v[bj][1][2], v[bj][1][3]);
                    *(u32x4*)(Ob + (size_t)row * ldo + ocol + 32 * bj) = w;
                    if (MODE == 1) { if (ftail) { *(f32x4*)(ftail + ocol + 32 * bj) = v[bj][0]; *(f32x4*)(ftail + ocol + 32 * bj + 4) = v[bj][1]; } }
                }
                asm volatile("" ::: "memory");
            }
    }
};
}

namespace att {
constexpr int SLOTB = 8192;
constexpr int L_K = 0, L_V = 3 * SLOTB, L_WS = 6 * SLOTB, L_OST = L_WS + 8 * 256, L_BYTES = L_OST + 8 * 4096;
constexpr float LOG2E = 1.4426950408889634f, C2 = 0.125f * LOG2E, NEG = -1e30f;
__device__ __forceinline__ int crow(int r, int hi) { return (r & 3) + 8 * (r >> 2) + 4 * hi; }
typedef short v4i16_t __attribute__((ext_vector_type(4)));
__device__ __forceinline__ s16x4 vtr(const LAS unsigned char* p) { return __builtin_bit_cast(s16x4, __builtin_amdgcn_ds_read_tr16_b64_v4i16((LAS v4i16_t*)p)); }

__device__ __forceinline__ void attn_unit(LAS unsigned char* lds, const int tid, int bidx, int c, int g, const bf16_t* Q, bf16_t* O, const bf16_t* Kb, const bf16_t* Vb, const bf16_t* KC, const bf16_t* VC, const float* sinks) {
    const int lane = tid & 63, r32 = lane & 31, hi = lane >> 5; const int wid = __builtin_amdgcn_readfirstlane(tid >> 6);
    int row0, nq; const bf16_t* kp[3]; const bf16_t* vp[3]; int nv[3];
    if (bidx < NBP) {
        row0 = bidx * SEQ + 64 * c; nq = 64;
#pragma unroll
        for (int s = 0; s < 3; ++s) { const int tc = c - 2 + s; nv[s] = tc >= 0 ? 64 : 0; const int tcc = tc >= 0 ? tc : 0; kp[s] = Kb + (size_t)(bidx * SEQ + 64 * tcc) * KVD; vp[s] = Vb + (size_t)(bidx * SEQ + 64 * tcc) * KVD; }
    } else {
        const int bs = bidx - NBP; row0 = MP + bs * LS; nq = LS;
        kp[0] = KC + (size_t)(bs * WIN) * KVD; kp[1] = kp[0] + 64 * KVD; kp[2] = Kb + (size_t)row0 * KVD;
        vp[0] = VC + (size_t)(bs * WIN) * KVD; vp[1] = vp[0] + 64 * KVD; vp[2] = Vb + (size_t)row0 * KVD;
        nv[0] = 64; nv[1] = 64; nv[2] = LS;
    }
#pragma unroll
    for (int s = 0; s < 3; ++s) if (nv[s] > 0) {
        const bf16_t* ks = kp[s] + (size_t)lane * KVD + g * HD + wid * 8;
        const bf16_t* vs = vp[s] + (size_t)(16 * (wid & 3) + (lane >> 2)) * KVD + g * HD + (wid >> 2) * 32 + (lane & 3) * 8;
        __builtin_amdgcn_global_load_lds((const unsigned*)ks, (LAS unsigned*)(lds + L_K + s * SLOTB + wid * 1024), 16, 0, 0);
        __builtin_amdgcn_global_load_lds((const unsigned*)vs, (LAS unsigned*)(lds + L_V + s * SLOTB + wid * 1024), 16, 0, 0);
    }
    const int head = 4 * g + (wid >> 1), qoff = 32 * (wid & 1);
    const bf16_t* Qw = Q + (size_t)(row0 + qoff + r32) * D + head * HD + hi * 8;
    bf16x8 qr[4];
#pragma unroll
    for (int d0 = 0; d0 < 4; ++d0) qr[d0] = *(const bf16x8*)(Qw + d0 * 16);
    const float sink2 = sinks[head] * LOG2E;
    asm volatile("s_waitcnt vmcnt(0)" ::: "memory"); __builtin_amdgcn_s_barrier(); asm volatile("" ::: "memory");
    f32x16 p[3][2];
    float mx = sink2;
#pragma unroll
    for (int s = 0; s < 3; ++s) if (nv[s] > 0) {
        const LAS unsigned char* kb = lds + L_K + s * SLOTB + hi * 1024 + r32 * 16;
        f32x16 p0 = {}, p1 = {};
#pragma unroll
        for (int d0 = 0; d0 < 4; ++d0) {
            const bf16x8 b0 = *(const LAS bf16x8*)(kb + d0 * 2048), b1 = *(const LAS bf16x8*)(kb + d0 * 2048 + 512);
            p0 = __builtin_amdgcn_mfma_f32_32x32x16_bf16(b0, qr[d0], p0, 0, 0, 0); p1 = __builtin_amdgcn_mfma_f32_32x32x16_bf16(b1, qr[d0], p1, 0, 0, 0);
        }
        if (nv[s] < 64) {
#pragma unroll
            for (int r = 0; r < 16; ++r) { const int kv = crow(r, hi); if (kv >= nv[s]) p0[r] = NEG; if (kv + 32 >= nv[s]) p1[r] = NEG; }
        }
#pragma unroll
        for (int r = 0; r < 16; ++r) mx = fmaxf(mx, fmaxf(p0[r], p1[r]));
        p[s][0] = p0; p[s][1] = p1;
    }
    mx = fmaxf(mx, __shfl_xor(mx, 32));
    float l = 0.f;
    u32x4 pw[3][4];
#pragma unroll
    for (int s = 0; s < 3; ++s) if (nv[s] > 0) {
#pragma unroll
        for (int h2 = 0; h2 < 2; ++h2) {
            f32x16 e;
#pragma unroll
            for (int r = 0; r < 16; ++r) { e[r] = __builtin_amdgcn_exp2f(p[s][h2][r] - mx); l += e[r]; }
#pragma unroll
            for (int q = 0; q < 2; ++q) { u32x4 w; w.x = pk_bf16(e[8 * q], e[8 * q + 1]); w.y = pk_bf16(e[8 * q + 2], e[8 * q + 3]); w.z = pk_bf16(e[8 * q + 4], e[8 * q + 5]); w.w = pk_bf16(e[8 * q + 6], e[8 * q + 7]); pw[s][2 * h2 + q] = w; }
        }
    }
    l += __shfl_xor(l, 32);
    l += __builtin_amdgcn_exp2f(sink2 - mx);
    f32x16 o[2]; o[0] = f32x16{}; o[1] = f32x16{};
    const LAS unsigned char* vb0 = lds + L_V + ((lane >> 4) & 1) * 32 + (lane & 3) * 8 + (4 * hi + ((lane & 15) >> 2)) * 64;
#pragma unroll
    for (int s = 0; s < 3; ++s) if (nv[s] > 0) {
#pragma unroll
        for (int ks = 0; ks < 4; ++ks) {
            const bf16x8 pa = __builtin_bit_cast(bf16x8, pw[s][ks]);
#pragma unroll
            for (int d0 = 0; d0 < 2; ++d0) {
                const s16x4 lo = vtr(vb0 + s * SLOTB + d0 * 4096 + ks * 1024), hh = vtr(vb0 + s * SLOTB + d0 * 4096 + ks * 1024 + 512);
                const bf16x8 vf = (bf16x8){lo[0], lo[1], lo[2], lo[3], hh[0], hh[1], hh[2], hh[3]};
                o[d0] = __builtin_amdgcn_mfma_f32_32x32x16_bf16(pa, vf, o[d0], 0, 0, 0);
            }
        }
        __builtin_amdgcn_sched_barrier(0);
    }
    LAS float* wsf = (LAS float*)(lds + L_WS) + wid * 64;
    if (hi == 0) wsf[r32] = l;
    LDS_WAIT();
    float rli[16];
#pragma unroll
    for (int r = 0; r < 16; ++r) rli[r] = __builtin_amdgcn_rcpf(wsf[crow(r, hi)]);
    LAS bf16_t* stg = (LAS bf16_t*)(lds + L_OST) + wid * 2048;
#pragma unroll
    for (int r = 0; r < 16; ++r) { const int orow = crow(r, hi);
#pragma unroll
        for (int d0 = 0; d0 < 2; ++d0) stg[orow * 64 + d0 * 32 + r32] = (bf16_t)(pk_bf16(o[d0][r] * rli[r], 0.f) & 0xffffu); }
    LDS_WAIT();
    bf16_t* Ow = O + (size_t)(row0 + qoff) * D + head * HD;
#pragma unroll
    for (int i = 0; i < 4; ++i) { const int row = i * 8 + (lane >> 3), ch = lane & 7; const u32x4 v = *(const LAS u32x4*)(stg + row * 64 + ch * 8);
        if (qoff + row < nq) *(u32x4*)(Ow + (size_t)row * D + ch * 8) = v; }
    asm volatile("s_waitcnt lgkmcnt(0)" ::: "memory"); __builtin_amdgcn_s_barrier(); asm volatile("" ::: "memory");
}
}

constexpr int NWAVES = 8;
constexpr int RING_BYTES = 131072, LDSCTL_OFF = RING_BYTES, MISC_OFF = LDSCTL_OFF + 320, XIN_OFF = LDSCTL_OFF + 512, LDS_BYTES = 147456;

#define XB_TMO      128
#define XB_XCNT(j)  (256  + 64 * (j))
#define XB_XSUB(j)  (1280 + 64 * (j))
#define XB_XGEN(j)  (2304 + 64 * (j))
#define XB_TOP      3328
#define XB_TOPGEN   3392
#define XCD_BAR_WORDS 3456
#define XB_SPIN_CAP (1u << 18)
__device__ __forceinline__ unsigned xb_ld(unsigned* p)              { return __hip_atomic_load(p, __ATOMIC_RELAXED, __HIP_MEMORY_SCOPE_AGENT); }
__device__ __forceinline__ unsigned xb_add(unsigned* p, unsigned v) { return __hip_atomic_fetch_add(p, v, __ATOMIC_RELAXED, __HIP_MEMORY_SCOPE_AGENT); }
__device__ __forceinline__ unsigned xb_xcc_id() { return (unsigned)__builtin_amdgcn_s_getreg((3 << 11) | 20) & 0xFu; }
#define XB_SPIN(cond, bar) do { unsigned _sp = 0; while (cond) { __builtin_amdgcn_s_sleep(1); \
    if ((++_sp & 255u) == 0u) { if (xb_ld(&(bar)[XB_TMO])) break; if (_sp > XB_SPIN_CAP) { atomicAdd(&(bar)[XB_TMO], 1u); break; } } } } while (0)
struct XcdBarrier { unsigned* bar; unsigned x; volatile LAS unsigned* st; };
__device__ __forceinline__ XcdBarrier xcd_barrier_post(unsigned* bar, volatile LAS unsigned* st) {
    XcdBarrier b; b.bar = bar; b.x = xb_xcc_id(); b.st = st;
    if (threadIdx.x == 0) (void)xb_add(&bar[XB_XCNT(b.x)], 1u);
    return b;
}
__device__ __forceinline__ void xcd_barrier_complete(unsigned* bar, unsigned x, unsigned& nloc, unsigned& nx) {
    const unsigned G = gridDim.x * gridDim.y * gridDim.z;
    unsigned sum, cnt, mine, sp = 0u;
    for (;;) {
        sum = 0u; cnt = 0u; mine = 0u;
#pragma unroll
        for (unsigned j = 0; j < 16; ++j) { const unsigned c = xb_ld(&bar[XB_XCNT(j)]); sum += c; cnt += (c > 0u) ? 1u : 0u; mine = (j == x) ? c : mine; }
        if (sum == G) break;
        __builtin_amdgcn_s_sleep(1);
        if ((++sp & 255u) == 0u) { if (xb_ld(&bar[XB_TMO])) break; if (sp > XB_SPIN_CAP) { atomicAdd(&bar[XB_TMO], 1u); break; } }
    }
    nloc = mine > 0u ? mine : 1u; nx = cnt > 0u ? cnt : 1u;
}
__device__ __forceinline__ void xcd_barrier(const XcdBarrier& b, const int tid) {
    asm volatile("s_waitcnt vmcnt(0)" ::: "memory");
    __syncthreads();
    if (tid == 0) {
        unsigned* bar = b.bar;
        __builtin_amdgcn_s_waitcnt(0);
        unsigned nloc = b.st[0], nx = b.st[1];
        if (nloc == 0u) { xcd_barrier_complete(bar, b.x, nloc, nx); b.st[0] = nloc; b.st[1] = nx; }
        const unsigned old = xb_add(&bar[XB_XSUB(b.x)], 1u);
        const unsigned gen = old / nloc;
        if (old + 1u == (gen + 1u) * nloc) {
            __builtin_amdgcn_fence(__ATOMIC_RELEASE, "agent");
            asm volatile("s_waitcnt vmcnt(0)" ::: "memory");
            const unsigned og = xb_add(&bar[XB_TOP], 1u);
            const unsigned tg = og / nx;
            if (og + 1u == (tg + 1u) * nx) xb_add(&bar[XB_TOPGEN], 1u);
            else XB_SPIN(xb_ld(&bar[XB_TOPGEN]) == tg, bar);
            __builtin_amdgcn_fence(__ATOMIC_ACQUIRE, "agent");
            xb_add(&bar[XB_XGEN(b.x)], 1u);
            asm volatile("s_waitcnt vmcnt(0)" ::: "memory");
        } else {
            XB_SPIN(xb_ld(&bar[XB_XGEN(b.x)]) == gen, bar);
            __builtin_amdgcn_fence(__ATOMIC_ACQUIRE, "agent");
            asm volatile("s_waitcnt vmcnt(0)" ::: "memory");
        }
    }
    __syncthreads();
}

struct Args { const float* in[24]; float* out; unsigned char* ws; int ph_lo, ph_hi; };

struct Frame {
    LAS unsigned char* lds; int tid, lane, wave, vcu, G;
    float* out; unsigned char* ws;
};
#define FIN(i) (args.in[i])

__device__ __forceinline__ void transpose_item(const float* W, int ldn, int K, int k0, int s0, bf16_t* WT, int p0, LAS float* scr, int lane) {
#pragma unroll 8
    for (int i = 0; i < 32; ++i) { const int kk = 2 * i + (lane >> 5); scr[kk * 33 + (lane & 31)] = W[(size_t)(k0 + kk) * ldn + s0 + (lane & 31)]; }
    LDS_WAIT(); asm volatile("" ::: "memory");
    const int c = lane & 7;
#pragma unroll
    for (int j = 0; j < 4; ++j) { const int n = (lane >> 3) + 8 * j; const LAS float* s = scr + (8 * c) * 33 + n;
        u32x4 o; o.x = pk_bf16(s[0 * 33], s[1 * 33]); o.y = pk_bf16(s[2 * 33], s[3 * 33]); o.z = pk_bf16(s[4 * 33], s[5 * 33]); o.w = pk_bf16(s[6 * 33], s[7 * 33]);
        *(u32x4*)(WT + (size_t)(p0 + n) * K + k0 + 8 * c) = o; }
    LDS_WAIT(); asm volatile("" ::: "memory");
}
__device__ __forceinline__ int headperm_src(int p0) { const int pn = p0 >> 8, bj = (p0 >> 7) & 1, wc = (p0 >> 5) & 3; return (4 * pn + wc) * HD + 32 * bj; }
__device__ __forceinline__ int swiglu_src(int p0) { const int pn = p0 >> 8, bj = (p0 >> 7) & 1, r = p0 & 127; return bj * DFF + 128 * pn + r; }

constexpr int CV_POOL = 2 * 4 * 4 * 8, CV_WQ = 2 * 16 * 32, CV_WO = 2 * 16 * 32, CV_WKV = 16 * 16, CV_WIN = 4 * 16 * 176, CV_WOUT = 4 * 44 * 32;
constexpr int CV_TOTAL = CV_POOL + CV_WQ + CV_WO + CV_WKV + CV_WIN + CV_WOUT;

__device__ __forceinline__ void convert_item(Frame& F, const Args& args, int it, LAS float* scr) {
    unsigned char* ws = F.ws;
    if (it < CV_POOL) {
        const int lg = it >> 5, r = it & 31, kb = r >> 3, nb = r & 7;
        transpose_item(FIN(11) + (size_t)lg * 65536, 256, 256, 64 * kb, 32 * nb, (bf16_t*)(ws + WS_WPOOL) + (size_t)lg * 65536, 32 * nb, scr, F.lane); return; }
    it -= CV_POOL;
    if (it < CV_WQ) { const int j = it >> 9, r = it & 511, kb = r >> 5, nb = r & 31;
        transpose_item(FIN(13) + (size_t)j * D * D, D, D, 64 * kb, headperm_src(32 * nb), (bf16_t*)(ws + WS_WQ) + (size_t)j * D * D, 32 * nb, scr, F.lane); return; }
    it -= CV_WQ;
    if (it < CV_WO) { const int j = it >> 9, r = it & 511, kb = r >> 5, nb = r & 31;
        transpose_item(FIN(16) + (size_t)j * D * D, D, D, 64 * kb, 32 * nb, (bf16_t*)(ws + WS_WO) + (size_t)j * D * D, 32 * nb, scr, F.lane); return; }
    it -= CV_WO;
    if (it < CV_WKV) { const int kb = it >> 4, nb = it & 15;
        transpose_item(FIN(20), 2 * KVD, D, 64 * kb, headperm_src(32 * nb), (bf16_t*)(ws + WS_WKV), 32 * nb, scr, F.lane); return; }
    it -= CV_WKV;
    if (it < CV_WIN) { const int l = it / (16 * 176), r = it % (16 * 176), kb = r / 176, nb = r % 176;
        transpose_item(FIN(22) + (size_t)l * D * NIN, NIN, D, 64 * kb, swiglu_src(32 * nb), (bf16_t*)(ws + WS_WIN) + (size_t)l * NIN * D, 32 * nb, scr, F.lane); return; }
    it -= CV_WIN;
    { const int l = it / (44 * 32), r = it % (44 * 32), kb = r >> 5, nb = r & 31;
        transpose_item(FIN(23) + (size_t)l * DFF * D, D, DFF, 64 * kb, 32 * nb, (bf16_t*)(ws + WS_WOUT) + (size_t)l * D * DFF, 32 * nb, scr, F.lane); }
}

constexpr int ADA_ITEMS = 4 * 48 + 16;
__device__ __forceinline__ void ada_item(Frame& F, const Args& args, int it) {
    LAS float* CA = (LAS float*)F.lds;
    LAS float* RED = (LAS float*)(F.lds + 49152);
    const float* W; const float* bias; float* out; int ldn, n0, ostride;
    if (it < 192) { const int l = it / 48; n0 = (it % 48) * 128; W = FIN(7) + (size_t)l * D * ADAW; ldn = ADAW; bias = FIN(8) + l * ADAW; out = (float*)(F.ws + WS_ADA) + (size_t)l * NBATCH * ADAW; ostride = ADAW; }
    else { n0 = (it - 192) * 128; W = FIN(18); ldn = 2 * D; bias = FIN(19); out = (float*)(F.ws + WS_ADAKV); ostride = 2 * D; }
    for (int idx = F.tid; idx < NBATCH * D; idx += NWAVES * 64) { const int b = idx >> 10, k = idx & 1023;
        const float c = b < NBP ? FIN(2)[b * D + k] : FIN(3)[(b - NBP) * D + k]; CA[k * 12 + b] = c / (1.0f + __expf(-c)); }
    LDS_WAIT(); __syncthreads();
    f32x2 acc[NBATCH];
#pragma unroll
    for (int b = 0; b < NBATCH; ++b) acc[b] = (f32x2){0.f, 0.f};
    const float* wp = W + (size_t)(F.wave * 128) * ldn + n0 + 2 * F.lane;
#pragma unroll 8
    for (int k = 0; k < 128; ++k) {
        const f32x2 wv = *(const f32x2*)(wp + (size_t)k * ldn);
        const LAS f32x4* cp = (const LAS f32x4*)(CA + (F.wave * 128 + k) * 12);
        const f32x4 c0 = cp[0], c1 = cp[1], c2 = cp[2];
        acc[0] += wv * c0[0]; acc[1] += wv * c0[1]; acc[2] += wv * c0[2]; acc[3] += wv * c0[3]; acc[4] += wv * c1[0];
        acc[5] += wv * c1[1]; acc[6] += wv * c1[2]; acc[7] += wv * c1[3]; acc[8] += wv * c2[0]; acc[9] += wv * c2[1];
    }
#pragma unroll
    for (int b = 0; b < NBATCH; ++b) *(LAS f32x2*)(RED + (F.wave * NBATCH + b) * 128 + 2 * F.lane) = acc[b];
    LDS_WAIT(); __syncthreads();
    for (int idx = F.tid; idx < NBATCH * 128; idx += NWAVES * 64) { const int b = idx >> 7, c = idx & 127; float s = bias[n0 + c];
#pragma unroll
        for (int w = 0; w < NWAVES; ++w) s += RED[(w * NBATCH + b) * 128 + c];
        out[(size_t)b * ostride + n0 + c] = s; }
    LDS_WAIT(); __syncthreads();
}

constexpr int BI_WIN = 4 * 88, BI_WQ = 2 * 16, BI_WKV = 8, BI_TOTAL = BI_WIN + BI_WQ + BI_WKV;
__device__ __forceinline__ void bias_item(Frame& F, int it) {
    LAS float* SH = (LAS float*)F.lds;
    const bf16_t* W; const float* sh; int shs; float* out; int os, r0;
    if (it < BI_WIN) { const int l = it / 88; r0 = (it % 88) * 64; W = (const bf16_t*)(F.ws + WS_WIN) + (size_t)l * NIN * D; sh = (const float*)(F.ws + WS_ADA) + (size_t)l * NBATCH * ADAW + 3 * D; shs = ADAW;
        out = (float*)(F.ws + WS_BIN) + (size_t)l * NBATCH * NIN; os = NIN; }
    else if (it < BI_WIN + BI_WQ) { const int j = (it - BI_WIN) >> 4; r0 = ((it - BI_WIN) & 15) * 64; W = (const bf16_t*)(F.ws + WS_WQ) + (size_t)j * D * D; sh = (const float*)(F.ws + WS_ADA) + (size_t)(2 + j) * NBATCH * ADAW; shs = ADAW;
        out = (float*)(F.ws + WS_BQ) + (size_t)j * NBATCH * D; os = D; }
    else { r0 = (it - BI_WIN - BI_WQ) * 64; W = (const bf16_t*)(F.ws + WS_WKV); sh = (const float*)(F.ws + WS_ADAKV); shs = 2 * D; out = (float*)(F.ws + WS_BKV); os = 2 * KVD; }
    for (int idx = F.tid; idx < NBATCH * D; idx += NWAVES * 64) { const int b = idx >> 10, k = idx & 1023; SH[idx] = sh[(size_t)b * shs + k]; }
    LDS_WAIT(); __syncthreads();
#pragma unroll 1
    for (int i = 0; i < 8; ++i) {
        const int row = r0 + F.wave * 8 + i;
        const bf16_t* wp = W + (size_t)row * D + 4 * F.lane;
        float w[16];
#pragma unroll
        for (int q = 0; q < 4; ++q) { const u32x2 v = *(const u32x2*)(wp + 256 * q); w[4 * q] = bf_lo(v.x); w[4 * q + 1] = bf_hi(v.x); w[4 * q + 2] = bf_lo(v.y); w[4 * q + 3] = bf_hi(v.y); }
#pragma unroll
        for (int b = 0; b < NBATCH; ++b) { float s = 0.f;
#pragma unroll
            for (int q = 0; q < 4; ++q) { const f32x4 sv = *(const LAS f32x4*)(SH + b * D + 256 * q + 4 * F.lane); s += (w[4 * q] * sv[0] + w[4 * q + 1] * sv[1]) + (w[4 * q + 2] * sv[2] + w[4 * q + 3] * sv[3]); }
            s = wave_sum(s);
            if (F.lane == 0) out[(size_t)b * os + row] = s; }
    }
    LDS_WAIT(); __syncthreads();
}

constexpr int PP_ITEMS = 2 * 128 + NBS;
__device__ __forceinline__ void pool_prep_item(Frame& F, const Args& args, int layer, int item, const float* xsrc_p, const float* xsrc_s) {
    LAS float* RS = (LAS float*)F.lds;
    int bidx, t0, nrows, L, pos0, grow0; const float* xb; const float* hist; float* pout;
    if (item < 256) { bidx = item >> 7; t0 = (item & 127) * 64; nrows = 64; L = SEQ; pos0 = 0; grow0 = bidx * SEQ; xb = xsrc_p + (size_t)grow0 * D; hist = nullptr;
        pout = F.out + O_POOLP + (size_t)(layer * NBP + bidx) * PH * D; }
    else { const int bs = item - 256; bidx = NBP + bs; t0 = 0; nrows = LS; L = LS; pos0 = 4096; grow0 = MP + bs * LS; xb = xsrc_s + (size_t)(bs * LS) * D; hist = FIN(4) + (size_t)(layer * NBS + bs) * PH * D;
        pout = F.out + O_POOLS + (size_t)(layer * NBS + bs) * PH * D; }
    for (int e = F.wave; e < 15 + nrows; e += NWAVES) { const int t = t0 - 15 + e;
        if (t >= 0) { const f32x4* xr = (const f32x4*)(xb + (size_t)t * D) + F.lane; float s = 0.f;
#pragma unroll
            for (int j = 0; j < 4; ++j) { const f32x4 v = xr[64 * j]; s += (v[0] * v[0] + v[1] * v[1]) + (v[2] * v[2] + v[3] * v[3]); }
            s = wave_sum(s); if (F.lane == 0) RS[e] = 1.0f / sqrtf(s * (1.0f / D) + EPS); } }
    LDS_WAIT(); __syncthreads();
    const int g = F.wave & 3, rh = F.wave >> 2, w = 2 << g, col = 256 * g + 4 * F.lane;
    if (32 * rh < nrows) {
        const float* ada = (const float*)(F.ws + WS_ADA) + ((size_t)layer * NBATCH + bidx) * ADAW;
        const f32x4 gm = *(const f32x4*)(FIN(9) + layer * D + col) * (*(const f32x4*)(ada + D + col) + 1.0f);
        const f32x4 sh = *(const f32x4*)(ada + col);
        const int tb = t0 + 32 * rh;
        bf16_t* dout = (bf16_t*)(F.ws + WS_AB) + (size_t)grow0 * D + col;
        f32x4 ring[16];
        ring[0] = (f32x4){0.f, 0.f, 0.f, 0.f};
#pragma unroll
        for (int j = 1; j < 16; ++j) { const int t = tb - 16 + j;
            if (t >= 0) ring[j] = *(const f32x4*)(xb + (size_t)t * D + col) * RS[t - (t0 - 15)] * gm + sh;
            else if (hist) ring[j] = *(const f32x4*)(hist + (size_t)(15 + t) * D + col);
            else ring[j] = (f32x4){0.f, 0.f, 0.f, 0.f}; }
#pragma unroll
        for (int blk = 0; blk < 2; ++blk) if (32 * rh + 16 * blk < nrows) {
#pragma unroll
            for (int jj = 0; jj < 16; ++jj) { const int t = tb + 16 * blk + jj;
                const f32x4 h = *(const f32x4*)(xb + (size_t)t * D + col) * RS[t - (t0 - 15)] * gm + sh;
                ring[jj] = h;
                f32x4 s = ring[jj] + ring[(jj + 15) & 15];
                if (w > 2) { s += ring[(jj + 14) & 15] + ring[(jj + 13) & 15];
                    if (w > 4) { s += (ring[(jj + 12) & 15] + ring[(jj + 11) & 15]) + (ring[(jj + 10) & 15] + ring[(jj + 9) & 15]);
                        if (w > 8) s += ((ring[(jj + 8) & 15] + ring[(jj + 7) & 15]) + (ring[(jj + 6) & 15] + ring[(jj + 5) & 15])) + ((ring[(jj + 4) & 15] + ring[(jj + 3) & 15]) + (ring[(jj + 2) & 15] + ring[(jj + 1) & 15])); } }
                const int cnt = min(w, pos0 + t + 1);
                const f32x4 d = s * (1.0f / (float)cnt) - h;
                u32x2 o; o.x = pk_bf16(d[0], d[1]); o.y = pk_bf16(d[2], d[3]);
                *(u32x2*)(dout + (size_t)t * D) = o;
                if (t >= L - PH) *(f32x4*)(pout + (size_t)(t - (L - PH)) * D + col) = h; }
        }
    }
    LDS_WAIT(); __syncthreads();
}

__device__ __forceinline__ void ttable_item(Frame& F, const Args& args, int id) {
    const float* ADA = (const float*)(F.ws + WS_ADA); const float* ADAKV = (const float*)(F.ws + WS_ADAKV);
    float* T = (float*)(F.ws + WS_T) + (size_t)id * TV;
    for (int idx = F.tid; idx < TV; idx += NWAVES * 64) { const int b = idx >> 10, c = idx & 1023; float v;
        if (id < T_GAINF) { const int l = id - T_GATE1; v = ADA[((size_t)l * NBATCH + b) * ADAW + 2 * D + c]; if (l < 2) v *= FIN(12)[l * D + c]; }
        else if (id < T_GATE2) { const int l = id - T_GAINF; v = FIN(10)[l * D + c] * (1.0f + ADA[((size_t)l * NBATCH + b) * ADAW + 4 * D + c]); }
        else if (id < T_GAINQ) { const int l = id - T_GATE2; v = ADA[((size_t)l * NBATCH + b) * ADAW + 5 * D + c]; }
        else if (id < T_GAINKV) { const int l = 2 + id - T_GAINQ; v = FIN(9)[l * D + c] * (1.0f + ADA[((size_t)l * NBATCH + b) * ADAW + D + c]); }
        else v = FIN(17)[c] * (1.0f + ADAKV[(size_t)b * 2 * D + D + c]);
        T[idx] = v; }
}

#ifndef PH_MASK
#define PH_MASK 0x7ffff
#endif
__global__ void __launch_bounds__(NWAVES * 64, 2) yoco_fwd(Args args) {
    extern __shared__ __attribute__((aligned(16))) unsigned char lds_raw[];
    Frame F;
    F.lds = (LAS unsigned char*)lds_raw;
    F.tid = 0; F.lane = 0; F.wave = __builtin_amdgcn_readfirstlane((int)threadIdx.x >> 6);
    F.G = gridDim.x; { const int bx = blockIdx.x; F.vcu = __builtin_amdgcn_readfirstlane((F.G % 8 == 0) ? (bx % 8) * (F.G / 8) + bx / 8 : bx); }
    F.out = args.out; F.ws = args.ws;
    for (int u = threadIdx.x; u < (LDS_BYTES - LDSCTL_OFF) / 4; u += NWAVES * 64) ((LAS unsigned*)(F.lds + LDSCTL_OFF))[u] = 0u;
    __syncthreads();
    if (threadIdx.x == 0) { ((LAS unsigned long long*)(F.lds + XIN_OFF))[0] = (unsigned long long)FIN(0); ((LAS unsigned long long*)(F.lds + XIN_OFF))[1] = (unsigned long long)(FIN(1) - (size_t)MP * D); }
    __syncthreads();
    const int lo = args.ph_lo, hi = args.ph_hi;
    XcdBarrier bar; bar.bar = (unsigned*)(args.ws + WS_CTL) + CW_BAR; bar.x = 0; bar.st = nullptr;
    if (hi - lo > 1) bar = xcd_barrier_post((unsigned*)(args.ws + WS_CTL) + CW_BAR, (volatile LAS unsigned*)(F.lds + MISC_OFF) + 8);
#define WSP(T_, off) ((T_*)(wsl + (off)))
#pragma unroll 1
    for (int ph = lo; ph < hi; ++ph) {
        unsigned char* wsl = F.ws; asm volatile("" : "+s"(wsl));
        int lanel; asm volatile("v_mbcnt_lo_u32_b32 %0, -1, 0\n\tv_mbcnt_hi_u32_b32 %0, -1, %0" : "=v"(lanel));
        const int tidl = F.wave * 64 + lanel;
        Frame Fp = F; Fp.tid = tidl; Fp.lane = lanel; Fp.ws = wsl;
        const int layer = ph < 6 ? 0 : ph < 10 ? 1 : ph < 15 ? 2 : 3;
#define PHQ(k) (ph == (k) && ((PH_MASK >> (k)) & 1))
        if (PHQ(0)) {
            for (int it = F.vcu; it < ADA_ITEMS; it += F.G) ada_item(Fp, args, it);
            LAS float* scr = (LAS float*)(Fp.lds + Fp.wave * 16384);
            const int gw = F.vcu * NWAVES + Fp.wave, NGW = F.G * NWAVES;
            for (int it = gw; it < CV_TOTAL; it += NGW) convert_item(Fp, args, it, scr);
            const int gt = F.vcu * NWAVES * 64 + Fp.tid, NGT = F.G * NWAVES * 64;
            for (int i = gt; i < 2 * NBS * WIN * KVD / 4; i += NGT) {
                const int which = i >= NBS * WIN * KVD / 4, j = which ? i - NBS * WIN * KVD / 4 : i;
                const f32x4 v = ((const f32x4*)(which ? FIN(6) : FIN(5)))[j];
                u32x2 o; o.x = pk_bf16(v[0], v[1]); o.y = pk_bf16(v[2], v[3]);
                (which ? WSP(u32x2, WS_VC) : WSP(u32x2, WS_KC))[j] = o;
                const int e = j * 4, bs = e / (WIN * KVD), r = (e / KVD) % WIN, cidx = e % KVD;
                if (r >= LS) *(f32x4*)(F.out + (which ? O_VS : O_KS) + ((size_t)bs * WIN + (r - LS)) * KVD + cidx) = v;
            }
        } else if (PHQ(1)) {
            for (int it = F.vcu; it < PP_ITEMS; it += F.G) pool_prep_item(Fp, args, 0, it, FIN(0), FIN(1));
            for (int it = F.G - 1 - F.vcu; it < BI_TOTAL + T_NVEC; it += F.G) { if (it < BI_TOTAL) bias_item(Fp, it); else ttable_item(Fp, args, it - BI_TOTAL); }
        } else if (PHQ(5)) {
            for (int it = F.vcu; it < PP_ITEMS; it += F.G) pool_prep_item(Fp, args, 1, it, F.out, F.out + (size_t)MP * D);
        } else if (PHQ(2)) {
            int kp = 256; asm volatile("" : "+s"(kp));
            pg8::Gemm g{WSP(const bf16_t, WS_AB), WSP(const bf16_t, WS_WPOOL), D, 256, kp}; pg8::StaticOrder S; S.init(NTM, 4, F.G, (int)blockIdx.x);
            typedef pg8::EpiRes<true, 1, true> EP; EP E{Fp.lds + XIN_OFF, F.out, wsl, T_GATE1 + 0, T_GAINF + 0, 0};
            pg8::gemm_phase<EP, pg8::StaticOrder, true>(Fp.lds, tidl, g, S, E);
        } else if (PHQ(6) || PHQ(11) || PHQ(16) || PHQ(13)) {
            pg8::Gemm g; int gate_id, g1_id;
            if (ph == 6) { g = pg8::Gemm{WSP(const bf16_t, WS_AB), WSP(const bf16_t, WS_WPOOL) + (size_t)D * 256, D, 256, 256}; gate_id = T_GATE1 + 1; g1_id = T_GAINF + 1; }
            else if (ph == 13) { g = pg8::Gemm{WSP(const bf16_t, WS_H), WSP(const bf16_t, WS_WOUT) + (size_t)2 * D * DFF, DFF, 0, DFF}; gate_id = T_GATE2 + 2; g1_id = T_GAINQ + 1; }
            else { g = pg8::Gemm{WSP(const bf16_t, WS_QO), WSP(const bf16_t, WS_WO) + (size_t)(layer - 2) * D * D, D, 0, D}; gate_id = T_GATE1 + layer; g1_id = T_GAINF + layer; }
            pg8::StaticOrder S; S.init(NTM, 4, F.G, (int)blockIdx.x);
            typedef pg8::EpiRes<false, 1, true> EP; EP E{nullptr, F.out, wsl, gate_id, g1_id, 0};
            pg8::gemm_phase<EP, pg8::StaticOrder, true>(Fp.lds, tidl, g, S, E);
        } else if (PHQ(8)) {
            pg8::Gemm g{WSP(const bf16_t, WS_H), WSP(const bf16_t, WS_WOUT) + (size_t)1 * D * DFF, DFF, 0, DFF}; pg8::StaticOrder S; S.init(NTM, 4, F.G, (int)blockIdx.x);
            typedef pg8::EpiRes<false, 2, true> EP; EP E{nullptr, F.out, wsl, T_GATE2 + 1, T_GAINQ + 0, T_GAINKV};
            pg8::gemm_phase<EP, pg8::StaticOrder, true>(Fp.lds, tidl, g, S, E);
        } else if (PHQ(4) || PHQ(18)) {
            pg8::Gemm g{WSP(const bf16_t, WS_H), WSP(const bf16_t, WS_WOUT) + (size_t)layer * D * DFF, DFF, 0, DFF}; pg8::StaticOrder S; S.init(NTM, 4, F.G, (int)blockIdx.x);
            typedef pg8::EpiRes<false, 0, false> EP; EP E{nullptr, F.out, wsl, T_GATE2 + layer, 0, 0};
            pg8::gemm_phase<EP, pg8::StaticOrder, true>(Fp.lds, tidl, g, S, E);
        } else if (PHQ(3) || PHQ(7) || PHQ(12) || PHQ(17)) {
            pg8::Gemm g{WSP(const bf16_t, WS_AQ), WSP(const bf16_t, WS_WIN) + (size_t)layer * NIN * D, D, 0, D}; pg8::StaticOrder S; S.init(NTM, NIN / 256, F.G, (int)blockIdx.x);
            pg8::EpiSwiglu E{WSP(const float, WS_SS), WSP(const float, WS_BIN) + (size_t)layer * NBATCH * NIN, WSP(bf16_t, WS_H)};
            pg8::gemm_phase<pg8::EpiSwiglu, pg8::StaticOrder, true>(Fp.lds, tidl, g, S, E);
        } else if (PHQ(9) || PHQ(14)) {
            const int j = layer - 1;
            { pg8::Gemm g{WSP(const bf16_t, WS_AQ), WSP(const bf16_t, WS_WQ) + (size_t)j * D * D, D, 0, D}; pg8::StaticOrder S; S.init(NTM, 4, F.G, (int)blockIdx.x);
              pg8::EpiHead<0> E{WSP(const float, WS_SS), WSP(const float, WS_BQ) + (size_t)j * NBATCH * D, D, FIN(14) + j * HD, att::C2, WSP(bf16_t, WS_QO), nullptr, nullptr, nullptr, nullptr, nullptr};
              pg8::gemm_phase<pg8::EpiHead<0>, pg8::StaticOrder, true>(Fp.lds, tidl, g, S, E); }
            if (ph == 9) {
              pg8::Gemm g{WSP(const bf16_t, WS_AB), WSP(const bf16_t, WS_WKV), D, 0, D}; pg8::StaticOrder S; S.init(NTM, 2, F.G, F.G - 1 - (int)blockIdx.x);
              pg8::EpiHead<1> E{WSP(const float, WS_SS), WSP(const float, WS_BKV), 2 * KVD, FIN(21), 1.0f, WSP(bf16_t, WS_KB), WSP(bf16_t, WS_VB), F.out + O_KP, F.out + O_VP, F.out + O_KS, F.out + O_VS};
              pg8::gemm_phase<pg8::EpiHead<1>, pg8::StaticOrder, true>(Fp.lds, tidl, g, S, E); }
        } else if (PHQ(10) || PHQ(15)) {
            const int NU = NBP * 128 * NKV + NBS * NKV;
            const float* sk = FIN(15) + (layer - 2) * NH;
            for (int u = F.vcu; u < NU; u += F.G) {
                int bidx, c, g;
                if (u < NBP * 128 * NKV) { g = u & 3; c = (u >> 2) & 127; bidx = u >> 9; } else { const int v = u - NBP * 128 * NKV; g = v & 3; c = 0; bidx = NBP + (v >> 2); }
                att::attn_unit(Fp.lds, tidl, bidx, c, g, WSP(const bf16_t, WS_QO), WSP(bf16_t, WS_QO), WSP(const bf16_t, WS_KB), WSP(const bf16_t, WS_VB), WSP(const bf16_t, WS_KC), WSP(const bf16_t, WS_VC), sk);
            }
        }
        if (ph + 1 < hi) xcd_barrier(bar, tidl);
    }
}

extern "C" void kernel_launch(void* const* d_in, const int* in_sizes, int n_in, void* d_out, int out_size, void* d_ws, size_t ws_size, hipStream_t stream) {
    static int grid = 0;
    if (grid == 0) {
        if (n_in != 24 || (size_t)out_size != O_END || ws_size < WS_END) { fprintf(stderr, "kernel_launch: unexpected sizes n_in %d out %d ws %zu\n", n_in, out_size, ws_size); grid = -1; return; }
        int dev = 0, cus = 0, per_cu = 0;
        if (hipGetDevice(&dev) != hipSuccess || hipDeviceGetAttribute(&cus, hipDeviceAttributeMultiprocessorCount, dev) != hipSuccess) { grid = -1; return; }
        if (hipFuncSetAttribute((const void*)yoco_fwd, hipFuncAttributeMaxDynamicSharedMemorySize, LDS_BYTES) != hipSuccess) { fprintf(stderr, "kernel_launch: hipFuncSetAttribute failed\n"); grid = -1; return; }
        if (hipOccupancyMaxActiveBlocksPerMultiprocessor(&per_cu, (const void*)yoco_fwd, NWAVES * 64, LDS_BYTES) != hipSuccess || per_cu < 1) { fprintf(stderr, "kernel_launch: occupancy query reports %d blocks per CU\n", per_cu); grid = -1; (void)hipGetLastError(); return; }
        grid = cus;
    }
    if (grid < 0) return;
    (void)hipMemsetAsync((char*)d_ws + WS_CTL, 0, CTL_ZERO_BYTES, stream);
    Args a{};
    for (int i = 0; i < 24; ++i) a.in[i] = (const float*)d_in[i];
    a.out = (float*)d_out; a.ws = (unsigned char*)d_ws;
#if MK_ONE_LAUNCH
    a.ph_lo = 0; a.ph_hi = NPHASE;
    hipLaunchKernelGGL(yoco_fwd, dim3(grid), dim3(NWAVES * 64), LDS_BYTES, stream, a);
#else
    for (int p = 0; p < NPHASE; ++p) { a.ph_lo = p; a.ph_hi = p + 1; hipLaunchKernelGGL(yoco_fwd, dim3(grid), dim3(NWAVES * 64), LDS_BYTES, stream, a); }
#endif
}
```

```cpp
#include <hip/hip_runtime.h>
#include <cstdio>
#include <cstdint>

#define LAS __attribute__((address_space(3)))
typedef unsigned short bf16_t;
typedef short bf16x8 __attribute__((ext_vector_type(8)));
typedef short s16x4 __attribute__((ext_vector_type(4)));
typedef float f32x2 __attribute__((ext_vector_type(2)));
typedef float f32x4 __attribute__((ext_vector_type(4)));
typedef float f32x16 __attribute__((ext_vector_type(16)));
typedef unsigned u32x2 __attribute__((ext_vector_type(2)));
typedef unsigned u32x4 __attribute__((ext_vector_type(4)));
typedef __bf16 bf16x2_t __attribute__((ext_vector_type(2)));

#ifndef MK_ONE_LAUNCH
#define MK_ONE_LAUNCH 1
#define WT_AUX 0
#endif

constexpr int D = 1024, SEQ = 8192, NBP = 2, NBS = 8, LS = 16, NBATCH = 10;
constexpr int MP = NBP * SEQ, MS = NBS * LS, MREAL = MP + MS, NTM = 65, MPAD = NTM * 256;
constexpr int DFF = 2816, NIN = 2 * DFF, HD = 64, NH = 16, NKV = 4, KVD = NKV * HD, WIN = 128, PH = 15;
constexpr int ADAW = 6 * D;
constexpr float EPS = 1e-6f;
constexpr int NPHASE = 19;

constexpr size_t O_Y = 0, O_POOLP = (size_t)MREAL * D, O_KP = O_POOLP + 2 * NBP * PH * D, O_VP = O_KP + (size_t)NBP * WIN * KVD,
                 O_POOLS = O_VP + (size_t)NBP * WIN * KVD, O_KS = O_POOLS + 2 * NBS * PH * D, O_VS = O_KS + (size_t)NBS * WIN * KVD, O_END = O_VS + (size_t)NBS * WIN * KVD;

constexpr size_t MiB = 1u << 20;
constexpr size_t WS_CTL = 0, CTL_ZERO_BYTES = 1 * MiB;
constexpr size_t WS_ADA = 1 * MiB, WS_ADAKV = 2 * MiB, WS_BIN = 3 * MiB, WS_BQ = 4 * MiB, WS_BKV = 4 * MiB + 128 * 1024, WS_SS = 5 * MiB, WS_T = 7 * MiB;
constexpr int T_GATE1 = 0, T_GAINF = 4, T_GATE2 = 8, T_GAINQ = 12, T_GAINKV = 14, T_NVEC = 15, TV = NBATCH * D;
constexpr size_t WS_WPOOL = 8 * MiB, WS_WQ = 9 * MiB, WS_WO = 13 * MiB, WS_WKV = 17 * MiB, WS_WIN = 18 * MiB, WS_WOUT = 62 * MiB;
constexpr size_t WS_KC = 84 * MiB, WS_VC = 84 * MiB + 512 * 1024, WS_KB = 85 * MiB, WS_VB = 94 * MiB;
constexpr size_t WS_AQ = 104 * MiB, WS_AB = 137 * MiB, WS_QO = 170 * MiB, WS_H = 203 * MiB, WS_END = 293 * MiB;
static_assert((size_t)MPAD * D * 2 <= 33 * MiB && (size_t)MPAD * DFF * 2 <= 90 * MiB && (size_t)MPAD * KVD * 2 <= 9 * MiB && (size_t)MPAD * 16 * 4 <= 3 * MiB, "ws map");
constexpr int CW_BAR = 4096, CW_CNT = 8192;

__device__ __forceinline__ unsigned pk_bf16(float lo, float hi) { f32x2 v = {lo, hi}; bf16x2_t b = __builtin_convertvector(v, bf16x2_t); return __builtin_bit_cast(unsigned, b); }
__device__ __forceinline__ float bf_lo(unsigned u) { return __uint_as_float(u << 16); }
__device__ __forceinline__ float bf_hi(unsigned u) { return __uint_as_float(u & 0xffff0000u); }
__device__ __forceinline__ float wave_sum(float v) {
#pragma unroll
    for (int o = 1; o < 64; o <<= 1) v += __shfl_xor(v, o);
    return v;
}
__device__ __forceinline__ int batch_of(int row16) { return row16 < MP ? (row16 >> 13) : min(2 + ((row16 - MP) >> 4), NBATCH - 1); }
#ifndef WT_AUX
#define WT_AUX 16
#endif
typedef __amdgpu_buffer_rsrc_t rsrc_t;
__device__ __forceinline__ rsrc_t mk_rsrc(const void* p, unsigned bytes) { return __builtin_amdgcn_make_buffer_rsrc((void*)p, 0, (int)bytes, 0x00020000); }
__device__ __forceinline__ void st16_wt(rsrc_t r, unsigned off, u32x4 v) { __builtin_amdgcn_raw_buffer_store_b128(v, r, (int)off, 0, WT_AUX); }
__device__ __forceinline__ void st16f_wt(rsrc_t r, unsigned off, f32x4 v) { __builtin_amdgcn_raw_buffer_store_b128(__builtin_bit_cast(u32x4, v), r, (int)off, 0, WT_AUX); }
__device__ __forceinline__ void st8_wt(rsrc_t r, unsigned off, u32x2 v) { __builtin_amdgcn_raw_buffer_store_b64(v, r, (int)off, 0, WT_AUX); }
__device__ __forceinline__ void st4_wt(rsrc_t r, unsigned off, float v) { __builtin_amdgcn_raw_buffer_store_b32(__float_as_uint(v), r, (int)off, 0, WT_AUX); }
__device__ __forceinline__ f32x4 ld16f(rsrc_t r, unsigned off) { return __builtin_bit_cast(f32x4, __builtin_amdgcn_raw_buffer_load_b128(r, (int)off, 0, 0)); }
#define LDS_WAIT() asm volatile("s_waitcnt lgkmcnt(0)" ::: "memory")
#define VM_WAIT() asm volatile("s_waitcnt vmcnt(0)" ::: "memory")

namespace pg8 {
constexpr int BM = 256, BK = 64, HALF = 128, HTB = HALF * BK * 2, STAGE_BYTES = 8 * HTB, NXCD = 8, WGM = 8;
__host__ __device__ __forceinline__ int lds_byte(int r, int c) { const int st = (r >> 4) * 2 + (c >> 5), rr = r & 15, cc = c & 31, ob = rr * 64 + cc * 2; return st * 1024 + (ob ^ (((ob >> 9) & 1) << 5)); }
__host__ __device__ __forceinline__ void stage_rc(int b, int& R, int& C) { const int st = b / 1024, sb = b % 1024, swz = sb ^ (((sb >> 9) & 1) << 5); R = (st >> 1) * 16 + swz / 64; C = (st & 1) * 32 + (swz % 64) / 2; }
__host__ __device__ __forceinline__ int perm32(int rho) { const int n = rho >> 4, i = rho & 15; return 8 * (i >> 2) + 4 * n + (i & 3); }

struct Unit { int pm, pn; };
struct Gemm { const bf16_t* A; const bf16_t* Bt; int lda; int a_pn_off; int K; };

struct StaticOrder {
    int nM, nN, nwg, G, c;
    __host__ __device__ void init(int nM_, int nN_, int G_, int c_) { nM = nM_; nN = nN_; nwg = nM * nN; G = G_; c = c_; }
    __host__ __device__ bool next(int i, Unit& u) const {
        const long L = (long)i * G + c; if (L >= nwg) return false;
        int wgid = (int)L; { const int q = nwg / NXCD, r = nwg % NXCD, xcd = wgid % NXCD, off = wgid / NXCD; wgid = (xcd < r ? xcd * (q + 1) : r * (q + 1) + (xcd - r) * q) + off; }
        const int nig = WGM * nN, gid = wgid / nig, fm = gid * WGM, gsz = (nM - fm) < WGM ? (nM - fm) : WGM;
        u.pm = fm + ((wgid % nig) % gsz); u.pn = (wgid % nig) / gsz; return true;
    }
};
constexpr int NPAN = 65;
__device__ __forceinline__ void dep_publish(unsigned* cnt, int seam, int pm, int lane) {
    asm volatile("s_waitcnt vmcnt(0)" ::: "memory");
    if (lane == 0) __hip_atomic_fetch_add(cnt + (size_t)(seam * NPAN + pm) * 64, 1u, __ATOMIC_RELAXED, __HIP_MEMORY_SCOPE_AGENT);
}
__device__ __forceinline__ void dep_poll(unsigned* cnt, int seam, int pm, unsigned need) {
    unsigned* p = cnt + (size_t)(seam * NPAN + pm) * 64;
    const unsigned long long t0 = __builtin_amdgcn_s_memrealtime();
    while ((unsigned)__builtin_amdgcn_readfirstlane(__hip_atomic_load(p, __ATOMIC_RELAXED, __HIP_MEMORY_SCOPE_AGENT)) < need) {
        if (__builtin_amdgcn_s_memrealtime() - t0 > 2000000ull) break;
        __builtin_amdgcn_s_sleep(2); }
}
struct DepOrder : StaticOrder {
    unsigned* cnt; int wseam, pseam; unsigned need_p, need_s; int wait_next; int last_pm;
    __device__ __forceinline__ void a_ready(const Unit& u, int wid) {
        if (wseam < 0 || u.pm == last_pm) return;
        if (wid == 0) {
            dep_poll(cnt, wseam, u.pm, u.pm == NPAN - 1 ? need_s : need_p);
            if (wait_next && u.pm + 1 < NPAN) dep_poll(cnt, wseam, u.pm + 1, u.pm + 1 == NPAN - 1 ? need_s : need_p);
            __builtin_amdgcn_fence(__ATOMIC_ACQUIRE, "agent");
            asm volatile("s_waitcnt vmcnt(0)" ::: "memory");
        }
        asm volatile("" ::: "memory"); __builtin_amdgcn_s_barrier(); asm volatile("" ::: "memory");
        last_pm = u.pm;
    }
    __device__ __forceinline__ void done(const Unit& u, int lane) const { if (pseam >= 0) dep_publish(cnt, pseam, u.pm, lane); }
};

template <class Epi, class Sched, bool ALIGN_EPI = false>
__device__ __forceinline__ void gemm_phase(LAS unsigned char* lds, const int tid, const Gemm g, Sched& S, const Epi& E) {
    const int wid = __builtin_amdgcn_readfirstlane(tid >> 6), lane = tid & 63, wr = wid >> 2, wc = wid & 3, fr = lane & 15, fq = lane >> 4;
    const int K = g.K, nt = K / BK, lda = g.lda;
    unsigned voffA[2], voffB[2];
#pragma unroll
    for (int i = 0; i < 2; ++i) { int R, C; stage_rc(tid * 16 + i * 8192, R, C); const int Rb = Epi::PERM ? ((R & ~31) + perm32(R & 31)) : R;
        voffA[i] = (unsigned)(R * lda + C) * 2u; voffB[i] = (unsigned)(Rb * K + C) * 2u; }
    const size_t kstep = (size_t)(BK * 2);
    const size_t hstepA = (size_t)HALF * lda * 2, hstepB = (size_t)HALF * K * 2;
    const size_t tstepA = 2 * hstepA, tstepB = 2 * hstepB;
    const unsigned ldsw = (unsigned)wid * 1024u;
    const int aoff = lds_byte(wr * 64 + fr, fq * 8), boff = lds_byte(wc * 32 + fr, fq * 8);
#define PG8_SA(b, h) (((b) * 2 + (h)) * HTB)
#define PG8_SB(b, h) ((4 + (b) * 2 + (h)) * HTB)
#define PG8_STAGE(bufoff, gbase, voff) do { _Pragma("unroll") for (int _i = 0; _i < 2; ++_i) \
        __builtin_amdgcn_global_load_lds((const unsigned*)((const char*)(gbase) + (voff)[_i]), (LAS unsigned*)(lds + (bufoff) + ldsw + _i * 8192), 16, 0, 0); } while (0)
#define PG8_LDA(dst, b, h) do { _Pragma("unroll") for (int m = 0; m < 4; ++m) _Pragma("unroll") for (int k = 0; k < 2; ++k) dst[m][k] = *(const LAS bf16x8*)(lds + PG8_SA(b, h) + aoff + m * 2048 + k * 1024); } while (0)
#define PG8_LDB(dst, b, h) do { _Pragma("unroll") for (int n = 0; n < 2; ++n) _Pragma("unroll") for (int k = 0; k < 2; ++k) dst[n][k] = *(const LAS bf16x8*)(lds + PG8_SB(b, h) + boff + n * 2048 + k * 1024); } while (0)
#define PG8_MMA(ai, bj, At, Bt) do { __builtin_amdgcn_s_setprio(1); _Pragma("unroll") for (int m = 0; m < 4; ++m) _Pragma("unroll") for (int n = 0; n < 2; ++n) _Pragma("unroll") for (int k = 0; k < 2; ++k) \
        acc[ai][bj][m][n] = __builtin_amdgcn_mfma_f32_16x16x32_bf16(Bt[n][k], At[m][k], acc[ai][bj][m][n], 0, 0, 0); __builtin_amdgcn_s_setprio(0); } while (0)
#define PG8_WAIT_V(n) asm volatile("s_waitcnt vmcnt(" #n ")" ::: "memory")
#define PG8_WAIT_L(n) asm volatile("s_waitcnt lgkmcnt(" #n ")" ::: "memory")
#define PG8_BAR __builtin_amdgcn_s_barrier()
#define PG8_SCHED __builtin_amdgcn_sched_barrier(0)
    Unit cur, nxt; int ui = 0;
    if (!S.next(0, cur)) return;
    f32x4 acc[2][2][4][2];
#pragma unroll
    for (int a = 0; a < 2; ++a)
#pragma unroll
        for (int b = 0; b < 2; ++b)
#pragma unroll
            for (int m = 0; m < 4; ++m)
#pragma unroll
                for (int n = 0; n < 2; ++n) acc[a][b][m][n] = (f32x4){0.f, 0.f, 0.f, 0.f};
    bf16x8 At[4][2], B0[2][2], B1[2][2];
    const char* cA = (const char*)g.A + (size_t)cur.pm * tstepA + (size_t)cur.pn * g.a_pn_off * 2; const char* cB = (const char*)g.Bt + (size_t)cur.pn * tstepB;
    S.a_ready(cur, wid);
    PG8_STAGE(PG8_SB(0, 0), cB, voffB); PG8_STAGE(PG8_SB(0, 1), cB + hstepB, voffB); PG8_STAGE(PG8_SA(0, 0), cA, voffA); PG8_STAGE(PG8_SA(0, 1), cA + hstepA, voffA);
    if (wr == 1) PG8_BAR;
    PG8_WAIT_V(2); PG8_BAR;
    PG8_STAGE(PG8_SB(1, 0), cB + kstep, voffB); PG8_STAGE(PG8_SA(1, 0), cA + kstep, voffA); PG8_STAGE(PG8_SB(1, 1), cB + hstepB + kstep, voffB);
    PG8_WAIT_V(6); PG8_BAR;
    for (;;) {
        const bool has_next = S.next(ui + 1, nxt);
        const char* nA = has_next ? (const char*)g.A + (size_t)nxt.pm * tstepA + (size_t)nxt.pn * g.a_pn_off * 2 : cA; const char* nB = has_next ? (const char*)g.Bt + (size_t)nxt.pn * tstepB : cB;
        for (int t = 0; t < nt; t += 2) {
            const bool last = (t == nt - 2);
            const char* a1 = cA + (size_t)(t + 1) * kstep;
            const char* a2 = last ? nA : cA + (size_t)(t + 2) * kstep; const char* b2 = last ? nB : cB + (size_t)(t + 2) * kstep;
            const char* a3 = a2 + kstep; const char* b3 = b2 + kstep;
            if (last && has_next) S.a_ready(nxt, wid);
            PG8_LDB(B0, 0, 0); PG8_LDB(B1, 0, 1); PG8_SCHED; PG8_LDA(At, 0, 0); PG8_STAGE(PG8_SA(1, 1), a1 + hstepA, voffA);
            PG8_WAIT_V(8); PG8_WAIT_L(0); PG8_BAR; PG8_MMA(0, 0, At, B0); PG8_MMA(0, 1, At, B1); PG8_BAR; PG8_SCHED;
            PG8_LDA(At, 0, 1); PG8_STAGE(PG8_SB(0, 0), b2, voffB); PG8_STAGE(PG8_SB(0, 1), b2 + hstepB, voffB); PG8_STAGE(PG8_SA(0, 0), a2, voffA);
            PG8_WAIT_V(8); PG8_WAIT_L(0); PG8_BAR; PG8_MMA(1, 0, At, B0); PG8_MMA(1, 1, At, B1); PG8_BAR; PG8_SCHED;
            PG8_LDB(B0, 1, 0); PG8_LDB(B1, 1, 1); PG8_SCHED; PG8_LDA(At, 1, 0); PG8_STAGE(PG8_SA(0, 1), a2 + hstepA, voffA);
            PG8_WAIT_V(8); PG8_WAIT_L(0); PG8_BAR; PG8_MMA(0, 0, At, B0); PG8_MMA(0, 1, At, B1); PG8_BAR; PG8_SCHED;
            PG8_LDA(At, 1, 1); PG8_STAGE(PG8_SB(1, 0), b3, voffB); PG8_STAGE(PG8_SB(1, 1), b3 + hstepB, voffB); PG8_STAGE(PG8_SA(1, 0), a3, voffA);
            PG8_WAIT_V(8); PG8_WAIT_L(0); PG8_BAR; PG8_MMA(1, 0, At, B0); PG8_MMA(1, 1, At, B1); PG8_BAR; PG8_SCHED;
        }
        if constexpr (ALIGN_EPI) { if (wr == 0) PG8_BAR; }
        E(acc, cur, wr, wc, fr, fq); S.done(cur, lane);
        if (!has_next) break;
#pragma unroll
        for (int a = 0; a < 2; ++a)
#pragma unroll
            for (int b = 0; b < 2; ++b)
#pragma unroll
                for (int m = 0; m < 4; ++m)
#pragma unroll
                    for (int n = 0; n < 2; ++n) acc[a][b][m][n] = (f32x4){0.f, 0.f, 0.f, 0.f};
        cur = nxt; cA = nA; cB = nB; ++ui;
        if constexpr (ALIGN_EPI) { if (wr == 1) PG8_BAR; }
    }
    PG8_WAIT_V(0);
    if constexpr (!ALIGN_EPI) { if (wr == 0) PG8_BAR; }
    PG8_BAR;
#undef PG8_SA
#undef PG8_SB
#undef PG8_STAGE
#undef PG8_LDA
#undef PG8_LDB
#undef PG8_MMA
#undef PG8_WAIT_V
#undef PG8_WAIT_L
#undef PG8_BAR
#undef PG8_SCHED
}


template <bool XIN, int NA, bool HAS_SS> struct EpiRes {
    static constexpr bool PERM = true;
    LAS const unsigned char* xin_lds;
    rsrc_t rx, rw;
    int gate_id, g1_id, g2_id;
    __device__ __forceinline__ void operator()(const f32x4 (&acc)[2][2][4][2], const Unit& u, int wr, int wc, int fr, int fq) const {
        const unsigned gate = (unsigned)WS_T + (unsigned)gate_id * TV * 4, g1 = (unsigned)WS_T + (unsigned)g1_id * TV * 4, g2 = (unsigned)WS_T + (unsigned)g2_id * TV * 4;
        const unsigned colb = (unsigned)(u.pn * BM + wc * 32 + 8 * fq);
        const float* xo = nullptr;
        if (XIN) { const unsigned long long pv = ((const LAS unsigned long long*)xin_lds)[u.pm < MP / BM ? 0 : 1];
            xo = (const float*)(((unsigned long long)(unsigned)__builtin_amdgcn_readfirstlane((int)(pv >> 32)) << 32) | (unsigned)__builtin_amdgcn_readfirstlane((int)pv)); }
#pragma unroll
        for (int ai = 0; ai < 2; ++ai)
#pragma unroll
            for (int m = 0; m < 4; ++m) {
                const int row16 = u.pm * BM + ai * HALF + wr * 64 + m * 16, row = row16 + fr, b = batch_of(row16);
                const int rowc = row < MREAL ? row : MREAL - 1;
                const unsigned xoff = (unsigned)rowc * D + colb, ooff = (unsigned)row * D + colb, toff = (unsigned)b * D + colb;
                float ss = 0.f;
#pragma unroll
                for (int bj = 0; bj < 2; ++bj) {
                    const unsigned co = bj * HALF;
                    f32x4 xa, xb;
                    if (XIN) { xa = *(const f32x4*)(xo + xoff + co); xb = *(const f32x4*)(xo + xoff + co + 4); }
                    else { xa = ld16f(rx, (xoff + co) * 4); xb = ld16f(rx, (xoff + co + 4) * 4); }
                    const f32x4 ga = ld16f(rw, gate + (toff + co) * 4), gb = ld16f(rw, gate + (toff + co + 4) * 4);
                    const f32x4 na = xa + ga * acc[ai][bj][m][0], nb = xb + gb * acc[ai][bj][m][1];
                    if (row < MREAL) { st16f_wt(rx, (ooff + co) * 4, na); st16f_wt(rx, (ooff + co + 4) * 4, nb); }
                    if (HAS_SS) ss += ((na[0] * na[0] + na[1] * na[1]) + (na[2] * na[2] + na[3] * na[3])) + ((nb[0] * nb[0] + nb[1] * nb[1]) + (nb[2] * nb[2] + nb[3] * nb[3]));
                    if (NA >= 1) { const f32x4 pa = na * ld16f(rw, g1 + (toff + co) * 4), pb = nb * ld16f(rw, g1 + (toff + co + 4) * 4);
                        u32x4 w; w.x = pk_bf16(pa[0], pa[1]); w.y = pk_bf16(pa[2], pa[3]); w.z = pk_bf16(pb[0], pb[1]); w.w = pk_bf16(pb[2], pb[3]); st16_wt(rw, (unsigned)WS_AQ + (ooff + co) * 2, w); }
                    if (NA >= 2) { const f32x4 pa = na * ld16f(rw, g2 + (toff + co) * 4), pb = nb * ld16f(rw, g2 + (toff + co + 4) * 4);
                        u32x4 w; w.x = pk_bf16(pa[0], pa[1]); w.y = pk_bf16(pa[2], pa[3]); w.z = pk_bf16(pb[0], pb[1]); w.w = pk_bf16(pb[2], pb[3]); st16_wt(rw, (unsigned)WS_AB + (ooff + co) * 2, w); }
                    asm volatile("" ::: "memory");
                }
                if (HAS_SS) { ss += __shfl_xor(ss, 16); ss += __shfl_xor(ss, 32); if (fq == 0) st4_wt(rw, (unsigned)WS_SS + ((unsigned)row * 16 + u.pn * 4 + wc) * 4, ss); }
            }
    }
};

__device__ __forceinline__ float row_rstd(const float* SS, int row) {
    const f32x4* p = (const f32x4*)(SS + (unsigned)row * 16);
    const f32x4 a = p[0], b = p[1], c = p[2], d = p[3];
    const float s = ((a[0] + a[1]) + (a[2] + a[3])) + ((b[0] + b[1]) + (b[2] + b[3])) + ((c[0] + c[1]) + (c[2] + c[3])) + ((d[0] + d[1]) + (d[2] + d[3]));
    return 1.0f / sqrtf(s * (1.0f / D) + EPS);
}
__device__ __forceinline__ float silu_f(float g) { return g * __builtin_amdgcn_rcpf(1.0f + __builtin_amdgcn_exp2f(-1.4426950408889634f * g)); }

struct EpiSwiglu {
    static constexpr bool PERM = true;
    const float* SS; const float* bias;
    rsrc_t rw;
    __device__ __forceinline__ void operator()(const f32x4 (&acc)[2][2][4][2], const Unit& u, int wr, int wc, int fr, int fq) const {
        const int pc = u.pn * BM + wc * 32 + 8 * fq;
#pragma unroll
        for (int ai = 0; ai < 2; ++ai)
#pragma unroll
            for (int m = 0; m < 4; ++m) {
                const int row16 = u.pm * BM + ai * HALF + wr * 64 + m * 16, row = row16 + fr, b = batch_of(row16);
                const float rs = row_rstd(SS, row);
                const float* bp = bias + (size_t)b * NIN + pc;
                u32x4 w;
#pragma unroll
                for (int n = 0; n < 2; ++n) {
                    const f32x4 bg = *(const f32x4*)(bp + 4 * n), bu = *(const f32x4*)(bp + HALF + 4 * n);
                    const f32x4 gv = acc[ai][0][m][n] * rs + bg, uv = acc[ai][1][m][n] * rs + bu;
                    const float h0 = silu_f(gv[0]) * uv[0], h1 = silu_f(gv[1]) * uv[1], h2 = silu_f(gv[2]) * uv[2], h3 = silu_f(gv[3]) * uv[3];
                    if (n == 0) { w.x = pk_bf16(h0, h1); w.y = pk_bf16(h2, h3); } else { w.z = pk_bf16(h0, h1); w.w = pk_bf16(h2, h3); }
                }
                st16_wt(rw, (unsigned)WS_H + ((unsigned)row * DFF + u.pn * HALF + wc * 32 + 8 * fq) * 2, w);
                asm volatile("" ::: "memory");
            }
    }
};

template <int MODE> struct EpiHead {
    static constexpr bool PERM = true;
    const float* SS; const float* bias; int bias_stride; const float* gvec; float oscale;
    rsrc_t rw; float* fk_p; float* fv_p; float* fk_s; float* fv_s;
    __device__ __forceinline__ void operator()(const f32x4 (&acc)[2][2][4][2], const Unit& u, int wr, int wc, int fr, int fq) const {
        const bool isv = (MODE == 1) && (u.pn == 1);
        const int ldo = (MODE == 0) ? D : KVD;
        const int ocol = (MODE == 0 ? (4 * u.pn + wc) * HD : wc * HD) + 8 * fq;
        const unsigned Ob = (MODE == 0) ? (unsigned)WS_QO : (isv ? (unsigned)WS_VB : (unsigned)WS_KB);
#pragma unroll
        for (int ai = 0; ai < 2; ++ai)
#pragma unroll
            for (int m = 0; m < 4; ++m) {
                const int row16 = u.pm * BM + ai * HALF + wr * 64 + m * 16, row = row16 + fr, b = batch_of(row16);
                const float rs = row_rstd(SS, row);
                const float* bp = bias + (size_t)b * bias_stride + u.pn * BM + wc * 32 + 8 * fq;
                f32x4 v[2][2]; float ss = 0.f;
#pragma unroll
                for (int bj = 0; bj < 2; ++bj)
#pragma unroll
                    for (int n = 0; n < 2; ++n) { v[bj][n] = acc[ai][bj][m][n] * rs + *(const f32x4*)(bp + bj * HALF + 4 * n);
                        ss += (v[bj][n][0] * v[bj][n][0] + v[bj][n][1] * v[bj][n][1]) + (v[bj][n][2] * v[bj][n][2] + v[bj][n][3] * v[bj][n][3]); }
                ss += __shfl_xor(ss, 16); ss += __shfl_xor(ss, 32);
                const float hr = 1.0f / sqrtf(ss * (1.0f / HD) + EPS);
                if (!isv) {
#pragma unroll
                    for (int bj = 0; bj < 2; ++bj)
#pragma unroll
                        for (int n = 0; n < 2; ++n) v[bj][n] = v[bj][n] * (hr * oscale) * *(const f32x4*)(gvec + 32 * bj + 8 * fq + 4 * n);
                }
                float* ftail = nullptr;
                if (MODE == 1) {
                    if (row < MP) { const int t = row & (SEQ - 1); if (t >= SEQ - WIN) ftail = (isv ? fv_p : fk_p) + ((size_t)(row >> 13) * WIN + (t - (SEQ - WIN))) * KVD; }
                    else if (row < MREAL) { const int bs = (row - MP) >> 4, t = (row - MP) & 15; ftail = (isv ? fv_s : fk_s) + ((size_t)bs * WIN + (WIN - LS) + t) * KVD; }
                }
#pragma unroll
                for (int bj = 0; bj < 2; ++bj) {
                    u32x4 w; w.x = pk_bf16(v[bj][0][0], v[bj][0][1]); w.y = pk_bf16(v[bj][0][2], v[bj][0][3]); w.z = pk_bf16(v[bj][1][0], v[bj][1][1]); w.w = pk_bf16(v[bj][1][2], v[bj][1][3]);
                    st16_wt(rw, Ob + ((unsigned)row * ldo + ocol + 32 * bj) * 2, w);
                    if (MODE == 1) { if (ftail) { *(f32x4*)(ftail + ocol + 32 * bj) = v[bj][0]; *(f32x4*)(ftail + ocol + 32 * bj + 4) = v[bj][1]; } }
                }
                asm volatile("" ::: "memory");
            }
    }
};
}

namespace sk {
struct Gemm { const bf16_t* A; int lda; int a_grp; const bf16_t* Bt; int K; int headperm; };
struct Res { const float* xin_s; float* X; const float* gate; const float* g1; const float* g2; bf16_t* A1; bf16_t* A2; float* SS; };
struct Head { const float* SS; const float* bias; const float* gvec; float oscale; bf16_t* O; };

template <int KIND> __device__ __forceinline__ void run(LAS unsigned char* lds, int tid, int tile, const Gemm g, const Res R, const Head H) {
    const int lane = tid & 63, wid = __builtin_amdgcn_readfirstlane(tid >> 6), fr = lane & 15, fq = lane >> 4;
    const int rt = tile & 3, ct = tile >> 2, K = g.K, kw = K >> 3, nst = kw >> 5;
    const bf16_t* ap = g.A + (size_t)(MP + 32 * rt + fr) * g.lda + (g.a_grp ? 256 * (ct >> 2) : 0) + wid * kw + 8 * fq;
    const int brow0 = g.headperm ? 256 * (ct >> 2) + 32 * (ct & 3) : 64 * ct;
    const bf16_t* bp = g.Bt + (size_t)(brow0 + fr) * K + wid * kw + 8 * fq;
    const size_t bst1 = (size_t)16 * K, bst2 = g.headperm ? (size_t)128 * K : (size_t)32 * K;
    f32x4 acc[2][4];
#pragma unroll
    for (int mi = 0; mi < 2; ++mi)
#pragma unroll
        for (int ni = 0; ni < 4; ++ni) acc[mi][ni] = (f32x4){0.f, 0.f, 0.f, 0.f};
    for (int s0 = 0; s0 < nst; s0 += 4) {
        bf16x8 af[4][2], bf[4][4];
#pragma unroll
        for (int q = 0; q < 4; ++q) { const int s_ = (s0 + q < nst) ? s0 + q : s0;
#pragma unroll
            for (int mi = 0; mi < 2; ++mi) af[q][mi] = *(const bf16x8*)(ap + (size_t)(16 * mi) * g.lda + 32 * s_);
#pragma unroll
            for (int ni = 0; ni < 4; ++ni) bf[q][ni] = *(const bf16x8*)(bp + (ni & 1) * bst1 + (ni >> 1) * bst2 + 32 * s_); }
#pragma unroll
        for (int q = 0; q < 4; ++q) if (s0 + q < nst) {
#pragma unroll
            for (int mi = 0; mi < 2; ++mi)
#pragma unroll
                for (int ni = 0; ni < 4; ++ni) acc[mi][ni] = __builtin_amdgcn_mfma_f32_16x16x32_bf16(bf[q][ni], af[q][mi], acc[mi][ni], 0, 0, 0); }
    }
    LAS f32x4* red = (LAS f32x4*)lds;
#pragma unroll
    for (int mi = 0; mi < 2; ++mi)
#pragma unroll
        for (int ni = 0; ni < 4; ++ni) red[(wid * 8 + mi * 4 + ni) * 64 + lane] = acc[mi][ni];
    LDS_WAIT(); __syncthreads();
    const int rl = 4 * wid + (lane >> 4), c4 = lane & 15;
    f32x4 v = {0.f, 0.f, 0.f, 0.f};
    { const int idx = ((rl >> 4) * 4 + (c4 >> 2)) * 64 + (c4 & 3) * 16 + (rl & 15);
#pragma unroll
      for (int w = 0; w < 8; ++w) v += red[w * 512 + idx]; }
    const int srow = 32 * rt + rl, row = MP + srow, b = NBP + (srow >> 4), col = 64 * ct + 4 * c4;
    if (KIND == 0) {
        const f32x4 x4 = R.xin_s ? *(const f32x4*)(R.xin_s + (size_t)srow * D + col) : *(const f32x4*)(R.X + (size_t)row * D + col);
        const f32x4 xn = x4 + *(const f32x4*)(R.gate + b * D + col) * v;
        *(f32x4*)(R.X + (size_t)row * D + col) = xn;
        if (R.SS) { float ss = (xn[0] * xn[0] + xn[1] * xn[1]) + (xn[2] * xn[2] + xn[3] * xn[3]);
            ss += __shfl_xor(ss, 1); ss += __shfl_xor(ss, 2); ss += __shfl_xor(ss, 4); ss += __shfl_xor(ss, 8);
            if (c4 == 0) R.SS[(size_t)row * 16 + ct] = ss; }
        if (R.A1) { const f32x4 a = xn * *(const f32x4*)(R.g1 + b * D + col); u32x2 w; w.x = pk_bf16(a[0], a[1]); w.y = pk_bf16(a[2], a[3]); *(u32x2*)(R.A1 + (size_t)row * D + col) = w; }
        if (R.A2) { const f32x4 a = xn * *(const f32x4*)(R.g2 + b * D + col); u32x2 w; w.x = pk_bf16(a[0], a[1]); w.y = pk_bf16(a[2], a[3]); *(u32x2*)(R.A2 + (size_t)row * D + col) = w; }
    } else {
        const int d = 4 * c4, phys = 256 * (ct >> 2) + 32 * (ct & 3) + 128 * (d >> 5) + (d & 31);
        const float rs = pg8::row_rstd(H.SS, row);
        f32x4 q = v * rs + *(const f32x4*)(H.bias + (size_t)b * D + phys);
        float ss = (q[0] * q[0] + q[1] * q[1]) + (q[2] * q[2] + q[3] * q[3]);
        ss += __shfl_xor(ss, 1); ss += __shfl_xor(ss, 2); ss += __shfl_xor(ss, 4); ss += __shfl_xor(ss, 8);
        const float hr = 1.0f / sqrtf(ss * (1.0f / HD) + EPS);
        q = q * (hr * H.oscale) * *(const f32x4*)(H.gvec + d);
        u32x2 w; w.x = pk_bf16(q[0], q[1]); w.y = pk_bf16(q[2], q[3]); *(u32x2*)(H.O + (size_t)row * D + 64 * ct + d) = w;
    }
    LDS_WAIT(); __syncthreads();
}
}

namespace att {
constexpr int SLOTB = 8192;
constexpr int L_K = 0, L_V = 3 * SLOTB, L_WS = 6 * SLOTB, L_OST = L_WS + 8 * 256, L_BYTES = L_OST + 8 * 4096;
constexpr float LOG2E = 1.4426950408889634f, C2 = 0.125f * LOG2E, NEG = -1e30f;
__device__ __forceinline__ int crow(int r, int hi) { return (r & 3) + 8 * (r >> 2) + 4 * hi; }
typedef short v4i16_t __attribute__((ext_vector_type(4)));
__device__ __forceinline__ s16x4 vtr(const LAS unsigned char* p) { return __builtin_bit_cast(s16x4, __builtin_amdgcn_ds_read_tr16_b64_v4i16((LAS v4i16_t*)p)); }

__device__ __forceinline__ void attn_unit(LAS unsigned char* lds, const int tid, int bidx, int c, int g, const bf16_t* Q, bf16_t* O, const bf16_t* Kb, const bf16_t* Vb, const bf16_t* KC, const bf16_t* VC, const float* sinks, unsigned* cnt, int wseam, int pseam) {
    const int lane = tid & 63, r32 = lane & 31, hi = lane >> 5; const int wid = __builtin_amdgcn_readfirstlane(tid >> 6);
    int row0, nq; const bf16_t* kp[3]; const bf16_t* vp[3]; int nv[3];
    if (bidx < NBP) {
        row0 = bidx * SEQ + 64 * c; nq = 64;
#pragma unroll
        for (int s = 0; s < 3; ++s) { const int tc = c - 2 + s; nv[s] = tc >= 0 ? 64 : 0; const int tcc = tc >= 0 ? tc : 0; kp[s] = Kb + (size_t)(bidx * SEQ + 64 * tcc) * KVD; vp[s] = Vb + (size_t)(bidx * SEQ + 64 * tcc) * KVD; }
    } else {
        const int bs = bidx - NBP; row0 = MP + bs * LS; nq = LS;
        kp[0] = KC + (size_t)(bs * WIN) * KVD; kp[1] = kp[0] + 64 * KVD; kp[2] = Kb + (size_t)row0 * KVD;
        vp[0] = VC + (size_t)(bs * WIN) * KVD; vp[1] = vp[0] + 64 * KVD; vp[2] = Vb + (size_t)row0 * KVD;
        nv[0] = 64; nv[1] = 64; nv[2] = LS;
    }
    const int panel = row0 >> 8;
    if (wseam >= 0) {
        if (wid == 0) { pg8::dep_poll(cnt, wseam, panel, 32u); __builtin_amdgcn_fence(__ATOMIC_ACQUIRE, "agent"); asm volatile("s_waitcnt vmcnt(0)" ::: "memory"); }
        asm volatile("" ::: "memory"); __builtin_amdgcn_s_barrier(); asm volatile("" ::: "memory");
    }
#pragma unroll
    for (int s = 0; s < 3; ++s) if (nv[s] > 0) {
        const bf16_t* ks = kp[s] + (size_t)lane * KVD + g * HD + wid * 8;
        const bf16_t* vs = vp[s] + (size_t)(16 * (wid & 3) + (lane >> 2)) * KVD + g * HD + (wid >> 2) * 32 + (lane & 3) * 8;
        __builtin_amdgcn_global_load_lds((const unsigned*)ks, (LAS unsigned*)(lds + L_K + s * SLOTB + wid * 1024), 16, 0, 0);
        __builtin_amdgcn_global_load_lds((const unsigned*)vs, (LAS unsigned*)(lds + L_V + s * SLOTB + wid * 1024), 16, 0, 0);
    }
    const int head = 4 * g + (wid >> 1), qoff = 32 * (wid & 1);
    const bf16_t* Qw = Q + (size_t)(row0 + qoff + r32) * D + head * HD + hi * 8;
    bf16x8 qr[4];
#pragma unroll
    for (int d0 = 0; d0 < 4; ++d0) qr[d0] = *(const bf16x8*)(Qw + d0 * 16);
    const float sink2 = sinks[head] * LOG2E;
    asm volatile("s_waitcnt vmcnt(0)" ::: "memory"); __builtin_amdgcn_s_barrier(); asm volatile("" ::: "memory");
    f32x16 p[3][2];
    float mx = sink2;
#pragma unroll
    for (int s = 0; s < 3; ++s) if (nv[s] > 0) {
        const LAS unsigned char* kb = lds + L_K + s * SLOTB + hi * 1024 + r32 * 16;
        f32x16 p0 = {}, p1 = {};
#pragma unroll
        for (int d0 = 0; d0 < 4; ++d0) {
            const bf16x8 b0 = *(const LAS bf16x8*)(kb + d0 * 2048), b1 = *(const LAS bf16x8*)(kb + d0 * 2048 + 512);
            p0 = __builtin_amdgcn_mfma_f32_32x32x16_bf16(b0, qr[d0], p0, 0, 0, 0); p1 = __builtin_amdgcn_mfma_f32_32x32x16_bf16(b1, qr[d0], p1, 0, 0, 0);
        }
        if (nv[s] < 64) {
#pragma unroll
            for (int r = 0; r < 16; ++r) { const int kv = crow(r, hi); if (kv >= nv[s]) p0[r] = NEG; if (kv + 32 >= nv[s]) p1[r] = NEG; }
        }
#pragma unroll
        for (int r = 0; r < 16; ++r) mx = fmaxf(mx, fmaxf(p0[r], p1[r]));
        p[s][0] = p0; p[s][1] = p1;
    }
    mx = fmaxf(mx, __shfl_xor(mx, 32));
    float l = 0.f;
    u32x4 pw[3][4];
#pragma unroll
    for (int s = 0; s < 3; ++s) if (nv[s] > 0) {
#pragma unroll
        for (int h2 = 0; h2 < 2; ++h2) {
            f32x16 e;
#pragma unroll
            for (int r = 0; r < 16; ++r) { e[r] = __builtin_amdgcn_exp2f(p[s][h2][r] - mx); l += e[r]; }
#pragma unroll
            for (int q = 0; q < 2; ++q) { u32x4 w; w.x = pk_bf16(e[8 * q], e[8 * q + 1]); w.y = pk_bf16(e[8 * q + 2], e[8 * q + 3]); w.z = pk_bf16(e[8 * q + 4], e[8 * q + 5]); w.w = pk_bf16(e[8 * q + 6], e[8 * q + 7]); pw[s][2 * h2 + q] = w; }
        }
    }
    l += __shfl_xor(l, 32);
    l += __builtin_amdgcn_exp2f(sink2 - mx);
    f32x16 o[2]; o[0] = f32x16{}; o[1] = f32x16{};
    const LAS unsigned char* vb0 = lds + L_V + ((lane >> 4) & 1) * 32 + (lane & 3) * 8 + (4 * hi + ((lane & 15) >> 2)) * 64;
#pragma unroll
    for (int s = 0; s < 3; ++s) if (nv[s] > 0) {
#pragma unroll
        for (int ks = 0; ks < 4; ++ks) {
            const bf16x8 pa = __builtin_bit_cast(bf16x8, pw[s][ks]);
#pragma unroll
            for (int d0 = 0; d0 < 2; ++d0) {
                const s16x4 lo = vtr(vb0 + s * SLOTB + d0 * 4096 + ks * 1024), hh = vtr(vb0 + s * SLOTB + d0 * 4096 + ks * 1024 + 512);
                const bf16x8 vf = (bf16x8){lo[0], lo[1], lo[2], lo[3], hh[0], hh[1], hh[2], hh[3]};
                o[d0] = __builtin_amdgcn_mfma_f32_32x32x16_bf16(pa, vf, o[d0], 0, 0, 0);
            }
        }
        __builtin_amdgcn_sched_barrier(0);
    }
    LAS float* wsf = (LAS float*)(lds + L_WS) + wid * 64;
    if (hi == 0) wsf[r32] = l;
    LDS_WAIT();
    float rli[16];
#pragma unroll
    for (int r = 0; r < 16; ++r) rli[r] = __builtin_amdgcn_rcpf(wsf[crow(r, hi)]);
    LAS bf16_t* stg = (LAS bf16_t*)(lds + L_OST) + wid * 2048;
#pragma unroll
    for (int r = 0; r < 16; ++r) { const int orow = crow(r, hi);
#pragma unroll
        for (int d0 = 0; d0 < 2; ++d0) stg[orow * 64 + d0 * 32 + r32] = (bf16_t)(pk_bf16(o[d0][r] * rli[r], 0.f) & 0xffffu); }
    LDS_WAIT();
    const rsrc_t rw = mk_rsrc((const unsigned char*)O - WS_AB, (unsigned)WS_END);
#pragma unroll
    for (int i = 0; i < 4; ++i) { const int row = i * 8 + (lane >> 3), ch = lane & 7; const u32x4 v = *(const LAS u32x4*)(stg + row * 64 + ch * 8);
        if (qoff + row < nq) st16_wt(rw, (unsigned)WS_AB + ((unsigned)(row0 + qoff + row) * D + head * HD + ch * 8) * 2, v); }
    if (pseam >= 0) pg8::dep_publish(cnt, pseam, panel, lane);
    asm volatile("s_waitcnt lgkmcnt(0)" ::: "memory"); __builtin_amdgcn_s_barrier(); asm volatile("" ::: "memory");
}
}

constexpr int NWAVES = 8;
constexpr int RING_BYTES = 131072, LDSCTL_OFF = RING_BYTES, MISC_OFF = LDSCTL_OFF + 320, XIN_OFF = LDSCTL_OFF + 512, LDS_BYTES = 147456;

#define XB_TMO      128
#define XB_XCNT(j)  (256  + 64 * (j))
#define XB_XSUB(j)  (1280 + 64 * (j))
#define XB_XGEN(j)  (2304 + 64 * (j))
#define XB_TOP      3328
#define XB_TOPGEN   3392
#define XCD_BAR_WORDS 3456
#define XB_SPIN_CAP (1u << 18)
__device__ __forceinline__ unsigned xb_ld(unsigned* p)              { return __hip_atomic_load(p, __ATOMIC_RELAXED, __HIP_MEMORY_SCOPE_AGENT); }
__device__ __forceinline__ unsigned xb_add(unsigned* p, unsigned v) { return __hip_atomic_fetch_add(p, v, __ATOMIC_RELAXED, __HIP_MEMORY_SCOPE_AGENT); }
__device__ __forceinline__ unsigned xb_xcc_id() { return (unsigned)__builtin_amdgcn_s_getreg((3 << 11) | 20) & 0xFu; }
#define XB_SPIN(cond, bar) do { unsigned _sp = 0; while (cond) { __builtin_amdgcn_s_sleep(1); \
    if ((++_sp & 255u) == 0u) { if (xb_ld(&(bar)[XB_TMO])) break; if (_sp > XB_SPIN_CAP) { atomicAdd(&(bar)[XB_TMO], 1u); break; } } } } while (0)
struct XcdBarrier { unsigned* bar; unsigned x; volatile LAS unsigned* st; };
__device__ __forceinline__ XcdBarrier xcd_barrier_post(unsigned* bar, volatile LAS unsigned* st) {
    XcdBarrier b; b.bar = bar; b.x = xb_xcc_id(); b.st = st;
    if (threadIdx.x == 0) (void)xb_add(&bar[XB_XCNT(b.x)], 1u);
    return b;
}
__device__ __forceinline__ void xcd_barrier_complete(unsigned* bar, unsigned x, unsigned& nloc, unsigned& nx) {
    const unsigned G = gridDim.x * gridDim.y * gridDim.z;
    unsigned sum, cnt, mine, sp = 0u;
    for (;;) {
        sum = 0u; cnt = 0u; mine = 0u;
#pragma unroll
        for (unsigned j = 0; j < 16; ++j) { const unsigned c = xb_ld(&bar[XB_XCNT(j)]); sum += c; cnt += (c > 0u) ? 1u : 0u; mine = (j == x) ? c : mine; }
        if (sum == G) break;
        __builtin_amdgcn_s_sleep(1);
        if ((++sp & 255u) == 0u) { if (xb_ld(&bar[XB_TMO])) break; if (sp > XB_SPIN_CAP) { atomicAdd(&bar[XB_TMO], 1u); break; } }
    }
    nloc = mine > 0u ? mine : 1u; nx = cnt > 0u ? cnt : 1u;
}
__device__ __forceinline__ void xcd_barrier(const XcdBarrier& b, const int tid) {
    asm volatile("s_waitcnt vmcnt(0)" ::: "memory");
    __syncthreads();
    if (tid == 0) {
        unsigned* bar = b.bar;
        __builtin_amdgcn_s_waitcnt(0);
        unsigned nloc = b.st[0], nx = b.st[1];
        if (nloc == 0u) { xcd_barrier_complete(bar, b.x, nloc, nx); b.st[0] = nloc; b.st[1] = nx; }
        const unsigned old = xb_add(&bar[XB_XSUB(b.x)], 1u);
        const unsigned gen = old / nloc;
        if (old + 1u == (gen + 1u) * nloc) {
            __builtin_amdgcn_fence(__ATOMIC_RELEASE, "agent");
            asm volatile("s_waitcnt vmcnt(0)" ::: "memory");
            const unsigned og = xb_add(&bar[XB_TOP], 1u);
            const unsigned tg = og / nx;
            if (og + 1u == (tg + 1u) * nx) xb_add(&bar[XB_TOPGEN], 1u);
            else XB_SPIN(xb_ld(&bar[XB_TOPGEN]) == tg, bar);
            __builtin_amdgcn_fence(__ATOMIC_ACQUIRE, "agent");
            xb_add(&bar[XB_XGEN(b.x)], 1u);
            asm volatile("s_waitcnt vmcnt(0)" ::: "memory");
        } else {
            XB_SPIN(xb_ld(&bar[XB_XGEN(b.x)]) == gen, bar);
            __builtin_amdgcn_fence(__ATOMIC_ACQUIRE, "agent");
            asm volatile("s_waitcnt vmcnt(0)" ::: "memory");
        }
    }
    __syncthreads();
}

struct Args { const float* in[24]; float* out; unsigned char* ws; int ph_lo, ph_hi; };

struct Frame {
    LAS unsigned char* lds; int tid, lane, wave, vcu, G;
    float* out; unsigned char* ws;
};
#define FIN(i) (args.in[i])

__device__ __forceinline__ void transpose_item(const float* W, int ldn, int K, int k0, int s0, bf16_t* WT, int p0, LAS float* scr, int lane) {
    float wv[32];
    const float* wp = W + (size_t)(k0 + (lane >> 5)) * ldn + s0 + (lane & 31);
#pragma unroll
    for (int i = 0; i < 32; ++i) wv[i] = wp[(size_t)(2 * i) * ldn];
#pragma unroll
    for (int i = 0; i < 32; ++i) scr[(2 * i + (lane >> 5)) * 33 + (lane & 31)] = wv[i];
    LDS_WAIT(); asm volatile("" ::: "memory");
    const int c = lane & 7;
#pragma unroll
    for (int j = 0; j < 4; ++j) { const int n = (lane >> 3) + 8 * j; const LAS float* s = scr + (8 * c) * 33 + n;
        u32x4 o; o.x = pk_bf16(s[0 * 33], s[1 * 33]); o.y = pk_bf16(s[2 * 33], s[3 * 33]); o.z = pk_bf16(s[4 * 33], s[5 * 33]); o.w = pk_bf16(s[6 * 33], s[7 * 33]);
        *(u32x4*)(WT + (size_t)(p0 + n) * K + k0 + 8 * c) = o; }
    LDS_WAIT(); asm volatile("" ::: "memory");
}
__device__ __forceinline__ int headperm_src(int p0) { const int pn = p0 >> 8, bj = (p0 >> 7) & 1, wc = (p0 >> 5) & 3; return (4 * pn + wc) * HD + 32 * bj; }
__device__ __forceinline__ int swiglu_src(int p0) { const int pn = p0 >> 8, bj = (p0 >> 7) & 1, r = p0 & 127; return bj * DFF + 128 * pn + r; }

constexpr int CV_POOL = 2 * 4 * 4 * 8, CV_WQ = 2 * 16 * 32, CV_WO = 2 * 16 * 32, CV_WKV = 16 * 16, CV_WIN = 4 * 16 * 176, CV_WOUT = 4 * 44 * 32;
constexpr int CV_TOTAL = CV_POOL + CV_WQ + CV_WO + CV_WKV + CV_WIN + CV_WOUT;

__device__ __forceinline__ void convert_item(Frame& F, const Args& args, int it, LAS float* scr) {
    unsigned char* ws = F.ws;
    if (it < CV_POOL) {
        const int lg = it >> 5, r = it & 31, kb = r >> 3, nb = r & 7;
        transpose_item(FIN(11) + (size_t)lg * 65536, 256, 256, 64 * kb, 32 * nb, (bf16_t*)(ws + WS_WPOOL) + (size_t)lg * 65536, 32 * nb, scr, F.lane); return; }
    it -= CV_POOL;
    if (it < CV_WQ) { const int j = it >> 9, r = it & 511, kb = r >> 5, nb = r & 31;
        transpose_item(FIN(13) + (size_t)j * D * D, D, D, 64 * kb, headperm_src(32 * nb), (bf16_t*)(ws + WS_WQ) + (size_t)j * D * D, 32 * nb, scr, F.lane); return; }
    it -= CV_WQ;
    if (it < CV_WO) { const int j = it >> 9, r = it & 511, kb = r >> 5, nb = r & 31;
        transpose_item(FIN(16) + (size_t)j * D * D, D, D, 64 * kb, 32 * nb, (bf16_t*)(ws + WS_WO) + (size_t)j * D * D, 32 * nb, scr, F.lane); return; }
    it -= CV_WO;
    if (it < CV_WKV) { const int kb = it >> 4, nb = it & 15;
        transpose_item(FIN(20), 2 * KVD, D, 64 * kb, headperm_src(32 * nb), (bf16_t*)(ws + WS_WKV), 32 * nb, scr, F.lane); return; }
    it -= CV_WKV;
    if (it < CV_WIN) { const int l = it / (16 * 176), r = it % (16 * 176), kb = r / 176, nb = r % 176;
        transpose_item(FIN(22) + (size_t)l * D * NIN, NIN, D, 64 * kb, swiglu_src(32 * nb), (bf16_t*)(ws + WS_WIN) + (size_t)l * NIN * D, 32 * nb, scr, F.lane); return; }
    it -= CV_WIN;
    { const int l = it / (44 * 32), r = it % (44 * 32), kb = r >> 5, nb = r & 31;
        transpose_item(FIN(23) + (size_t)l * DFF * D, D, DFF, 64 * kb, 32 * nb, (bf16_t*)(ws + WS_WOUT) + (size_t)l * D * DFF, 32 * nb, scr, F.lane); }
}

constexpr int ADA_ITEMS = 4 * 48 + 16;
__device__ __forceinline__ void ada_item(Frame& F, const Args& args, int it) {
    LAS float* CA = (LAS float*)F.lds;
    LAS float* RED = (LAS float*)(F.lds + 49152);
    const float* W; const float* bias; float* out; int ldn, n0, ostride;
    if (it < 192) { const int l = it / 48; n0 = (it % 48) * 128; W = FIN(7) + (size_t)l * D * ADAW; ldn = ADAW; bias = FIN(8) + l * ADAW; out = (float*)(F.ws + WS_ADA) + (size_t)l * NBATCH * ADAW; ostride = ADAW; }
    else { n0 = (it - 192) * 128; W = FIN(18); ldn = 2 * D; bias = FIN(19); out = (float*)(F.ws + WS_ADAKV); ostride = 2 * D; }
    for (int idx = F.tid; idx < NBATCH * D; idx += NWAVES * 64) { const int b = idx >> 10, k = idx & 1023;
        const float c = b < NBP ? FIN(2)[b * D + k] : FIN(3)[(b - NBP) * D + k]; CA[k * 12 + b] = c / (1.0f + __expf(-c)); }
    LDS_WAIT(); __syncthreads();
    f32x2 acc[NBATCH];
#pragma unroll
    for (int b = 0; b < NBATCH; ++b) acc[b] = (f32x2){0.f, 0.f};
    const float* wp = W + (size_t)(F.wave * 128) * ldn + n0 + 2 * F.lane;
#pragma unroll 32
    for (int k = 0; k < 128; ++k) {
        const f32x2 wv = *(const f32x2*)(wp + (size_t)k * ldn);
        const LAS f32x4* cp = (const LAS f32x4*)(CA + (F.wave * 128 + k) * 12);
        const f32x4 c0 = cp[0], c1 = cp[1], c2 = cp[2];
        acc[0] += wv * c0[0]; acc[1] += wv * c0[1]; acc[2] += wv * c0[2]; acc[3] += wv * c0[3]; acc[4] += wv * c1[0];
        acc[5] += wv * c1[1]; acc[6] += wv * c1[2]; acc[7] += wv * c1[3]; acc[8] += wv * c2[0]; acc[9] += wv * c2[1];
    }
#pragma unroll
    for (int b = 0; b < NBATCH; ++b) *(LAS f32x2*)(RED + (F.wave * NBATCH + b) * 128 + 2 * F.lane) = acc[b];
    LDS_WAIT(); __syncthreads();
    for (int idx = F.tid; idx < NBATCH * 128; idx += NWAVES * 64) { const int b = idx >> 7, c = idx & 127; float s = bias[n0 + c];
#pragma unroll
        for (int w = 0; w < NWAVES; ++w) s += RED[(w * NBATCH + b) * 128 + c];
        out[(size_t)b * ostride + n0 + c] = s; }
    LDS_WAIT(); __syncthreads();
}

constexpr int BI_WIN = 4 * 44, BI_WQ = 2 * 8, BI_WKV = 4, BI_TOTAL = BI_WIN + BI_WQ + BI_WKV, SHP = D + 8;
__device__ __forceinline__ void bias_item(Frame& F, int it) {
    LAS bf16_t* SH = (LAS bf16_t*)F.lds;
    const bf16_t* W; const float* sh; int shs; float* out; int os, r0;
    if (it < BI_WIN) { const int l = it / 44; r0 = (it % 44) * 128; W = (const bf16_t*)(F.ws + WS_WIN) + (size_t)l * NIN * D; sh = (const float*)(F.ws + WS_ADA) + (size_t)l * NBATCH * ADAW + 3 * D; shs = ADAW;
        out = (float*)(F.ws + WS_BIN) + (size_t)l * NBATCH * NIN; os = NIN; }
    else if (it < BI_WIN + BI_WQ) { const int j = (it - BI_WIN) >> 3; r0 = ((it - BI_WIN) & 7) * 128; W = (const bf16_t*)(F.ws + WS_WQ) + (size_t)j * D * D; sh = (const float*)(F.ws + WS_ADA) + (size_t)(2 + j) * NBATCH * ADAW; shs = ADAW;
        out = (float*)(F.ws + WS_BQ) + (size_t)j * NBATCH * D; os = D; }
    else { r0 = (it - BI_WIN - BI_WQ) * 128; W = (const bf16_t*)(F.ws + WS_WKV); sh = (const float*)(F.ws + WS_ADAKV); shs = 2 * D; out = (float*)(F.ws + WS_BKV); os = 2 * KVD; }
    const bf16_t* wp = W + (size_t)(r0 + F.wave * 16 + (F.lane & 15)) * D + 8 * (F.lane >> 4);
    bf16x8 wf[32];
#pragma unroll
    for (int s_ = 0; s_ < 32; ++s_) wf[s_] = *(const bf16x8*)(wp + 32 * s_);
    for (int idx = F.tid; idx < 16 * D; idx += NWAVES * 64) { const int b = idx >> 10, k = idx & 1023; SH[b * SHP + k] = b < NBATCH ? (bf16_t)(pk_bf16(sh[(size_t)b * shs + k], 0.f) & 0xffffu) : (bf16_t)0; }
    LDS_WAIT(); __syncthreads();
    f32x4 acc = {0.f, 0.f, 0.f, 0.f};
    const LAS bf16_t* sp = SH + (F.lane & 15) * SHP + 8 * (F.lane >> 4);
#pragma unroll
    for (int s_ = 0; s_ < 32; ++s_) acc = __builtin_amdgcn_mfma_f32_16x16x32_bf16(*(const LAS bf16x8*)(sp + 32 * s_), wf[s_], acc, 0, 0, 0);
#pragma unroll
    for (int j = 0; j < 4; ++j) { const int b = 4 * (F.lane >> 4) + j; if (b < NBATCH) out[(size_t)b * os + r0 + F.wave * 16 + (F.lane & 15)] = acc[j]; }
    LDS_WAIT(); __syncthreads();
}

constexpr int PP_ITEMS = 2 * 128 + NBS;
__device__ __forceinline__ void pool_prep_item(Frame& F, const Args& args, int layer, int item, const float* xsrc_p, const float* xsrc_s, int pub_seam) {
    LAS float* RS = (LAS float*)F.lds;
    int bidx, t0, nrows, L, pos0, grow0; const float* xb; const float* hist; float* pout;
    if (item < 256) { bidx = item >> 7; t0 = (item & 127) * 64; nrows = 64; L = SEQ; pos0 = 0; grow0 = bidx * SEQ; xb = xsrc_p + (size_t)grow0 * D; hist = nullptr;
        pout = F.out + O_POOLP + (size_t)(layer * NBP + bidx) * PH * D; }
    else { const int bs = item - 256; bidx = NBP + bs; t0 = 0; nrows = LS; L = LS; pos0 = 4096; grow0 = MP + bs * LS; xb = xsrc_s + (size_t)(bs * LS) * D; hist = FIN(4) + (size_t)(layer * NBS + bs) * PH * D;
        pout = F.out + O_POOLS + (size_t)(layer * NBS + bs) * PH * D; }
    for (int e0 = F.wave; e0 < 15 + nrows; e0 += 5 * NWAVES) {
        f32x4 v[5][4];
#pragma unroll
        for (int q = 0; q < 5; ++q) { const int e = e0 + q * NWAVES, t = t0 - 15 + e; const bool ok = (e < 15 + nrows) && t >= 0; const f32x4* xr = (const f32x4*)(xb + (size_t)(ok ? t : t0) * D) + F.lane;
#pragma unroll
            for (int j = 0; j < 4; ++j) v[q][j] = xr[64 * j]; }
#pragma unroll
        for (int q = 0; q < 5; ++q) { const int e = e0 + q * NWAVES, t = t0 - 15 + e; float s_ = 0.f;
#pragma unroll
            for (int j = 0; j < 4; ++j) s_ += (v[q][j][0] * v[q][j][0] + v[q][j][1] * v[q][j][1]) + (v[q][j][2] * v[q][j][2] + v[q][j][3] * v[q][j][3]);
            s_ = wave_sum(s_); if (F.lane == 0 && e < 15 + nrows && t >= 0) RS[e] = 1.0f / sqrtf(s_ * (1.0f / D) + EPS); }
    }
    LDS_WAIT(); __syncthreads();
    const int g = F.wave & 3, rh = F.wave >> 2, w = 2 << g, col = 256 * g + 4 * F.lane;
    if (32 * rh < nrows) {
        const float* ada = (const float*)(F.ws + WS_ADA) + ((size_t)layer * NBATCH + bidx) * ADAW;
        const f32x4 gm = *(const f32x4*)(FIN(9) + layer * D + col) * (*(const f32x4*)(ada + D + col) + 1.0f);
        const f32x4 sh = *(const f32x4*)(ada + col);
        const int tb = t0 + 32 * rh;
        const rsrc_t rw = mk_rsrc(F.ws, (unsigned)WS_END);
        const unsigned dout = (unsigned)WS_AB + ((unsigned)grow0 * D + col) * 2;
        f32x4 ring[16];
        ring[0] = (f32x4){0.f, 0.f, 0.f, 0.f};
#pragma unroll
        for (int j = 1; j < 16; ++j) { const int t = tb - 16 + j;
            if (t >= 0) ring[j] = *(const f32x4*)(xb + (size_t)t * D + col) * RS[t - (t0 - 15)] * gm + sh;
            else if (hist) ring[j] = *(const f32x4*)(hist + (size_t)(15 + t) * D + col);
            else ring[j] = (f32x4){0.f, 0.f, 0.f, 0.f}; }
#pragma unroll
        for (int blk = 0; blk < 2; ++blk) if (32 * rh + 16 * blk < nrows) {
#pragma unroll
            for (int jj = 0; jj < 16; ++jj) { const int t = tb + 16 * blk + jj;
                const f32x4 h = *(const f32x4*)(xb + (size_t)t * D + col) * RS[t - (t0 - 15)] * gm + sh;
                ring[jj] = h;
                f32x4 s = ring[jj] + ring[(jj + 15) & 15];
                if (w > 2) { s += ring[(jj + 14) & 15] + ring[(jj + 13) & 15];
                    if (w > 4) { s += (ring[(jj + 12) & 15] + ring[(jj + 11) & 15]) + (ring[(jj + 10) & 15] + ring[(jj + 9) & 15]);
                        if (w > 8) s += ((ring[(jj + 8) & 15] + ring[(jj + 7) & 15]) + (ring[(jj + 6) & 15] + ring[(jj + 5) & 15])) + ((ring[(jj + 4) & 15] + ring[(jj + 3) & 15]) + (ring[(jj + 2) & 15] + ring[(jj + 1) & 15])); } }
                const int cnt = min(w, pos0 + t + 1);
                const f32x4 d = s * (1.0f / (float)cnt) - h;
                u32x2 o; o.x = pk_bf16(d[0], d[1]); o.y = pk_bf16(d[2], d[3]);
                st8_wt(rw, dout + (unsigned)t * D * 2, o);
                if (t >= L - PH) *(f32x4*)(pout + (size_t)(t - (L - PH)) * D + col) = h; }
        }
    }
    if (pub_seam >= 0) pg8::dep_publish((unsigned*)(F.ws + WS_CTL) + CW_CNT, pub_seam, (grow0 + t0) >> 8, F.lane);
    LDS_WAIT(); __syncthreads();
}

__device__ __forceinline__ void ttable_item(Frame& F, const Args& args, int id) {
    const float* ADA = (const float*)(F.ws + WS_ADA); const float* ADAKV = (const float*)(F.ws + WS_ADAKV);
    float* T = (float*)(F.ws + WS_T) + (size_t)id * TV;
    for (int idx = F.tid; idx < TV; idx += NWAVES * 64) { const int b = idx >> 10, c = idx & 1023; float v;
        if (id < T_GAINF) { const int l = id - T_GATE1; v = ADA[((size_t)l * NBATCH + b) * ADAW + 2 * D + c]; if (l < 2) v *= FIN(12)[l * D + c]; }
        else if (id < T_GATE2) { const int l = id - T_GAINF; v = FIN(10)[l * D + c] * (1.0f + ADA[((size_t)l * NBATCH + b) * ADAW + 4 * D + c]); }
        else if (id < T_GAINQ) { const int l = id - T_GATE2; v = ADA[((size_t)l * NBATCH + b) * ADAW + 5 * D + c]; }
        else if (id < T_GAINKV) { const int l = 2 + id - T_GAINQ; v = FIN(9)[l * D + c] * (1.0f + ADA[((size_t)l * NBATCH + b) * ADAW + D + c]); }
        else v = FIN(17)[c] * (1.0f + ADAKV[(size_t)b * 2 * D + D + c]);
        T[idx] = v; }
}

#ifndef PH_MASK
#define PH_MASK 0x7ffff
#endif
__global__ void __launch_bounds__(NWAVES * 64, 2) yoco_fwd(Args args) {
    extern __shared__ __attribute__((aligned(16))) unsigned char lds_raw[];
    Frame F;
    F.lds = (LAS unsigned char*)lds_raw;
    F.tid = 0; F.lane = 0; F.wave = __builtin_amdgcn_readfirstlane((int)threadIdx.x >> 6);
    F.G = gridDim.x; { const int bx = blockIdx.x; F.vcu = __builtin_amdgcn_readfirstlane((F.G % 8 == 0) ? (bx % 8) * (F.G / 8) + bx / 8 : bx); }
    F.out = args.out; F.ws = args.ws;
    for (int u = threadIdx.x; u < (LDS_BYTES - LDSCTL_OFF) / 4; u += NWAVES * 64) ((LAS unsigned*)(F.lds + LDSCTL_OFF))[u] = 0u;
    __syncthreads();
    if (threadIdx.x == 0) { ((LAS unsigned long long*)(F.lds + XIN_OFF))[0] = (unsigned long long)FIN(0); ((LAS unsigned long long*)(F.lds + XIN_OFF))[1] = (unsigned long long)(FIN(1) - (size_t)MP * D); }
    __syncthreads();
    const int lo = args.ph_lo, hi = args.ph_hi;
    XcdBarrier bar; bar.bar = (unsigned*)(args.ws + WS_CTL) + CW_BAR; bar.x = 0; bar.st = nullptr;
    if (hi - lo > 1) bar = xcd_barrier_post((unsigned*)(args.ws + WS_CTL) + CW_BAR, (volatile LAS unsigned*)(F.lds + MISC_OFF) + 8);
#define WSP(T_, off) ((T_*)(wsl + (off)))
#pragma unroll 1
    for (int ph = lo; ph < hi; ++ph) {
        unsigned char* wsl = F.ws; asm volatile("" : "+s"(wsl));
        int lanel; asm volatile("v_mbcnt_lo_u32_b32 %0, -1, 0\n\tv_mbcnt_hi_u32_b32 %0, -1, %0" : "=v"(lanel));
        const int tidl = F.wave * 64 + lanel;
        Frame Fp = F; Fp.tid = tidl; Fp.lane = lanel; Fp.ws = wsl;
        const int layer = ph < 6 ? 0 : ph < 10 ? 1 : ph < 15 ? 2 : 3;
        unsigned* cnt = WSP(unsigned, WS_CTL) + CW_CNT;
        const bool solo = true;
        const int krot = ph == 7 ? 19 : ph == 12 ? 6 : ph == 17 ? 25 : ph == 2 ? 1 : ph == 4 ? 2 : ph == 6 ? 3 : ph == 8 ? 4 : ph == 9 ? 5 : ph == 11 ? 6 : ph == 13 ? 7 : ph == 14 ? 8 : ph == 16 ? 9 : ph == 18 ? 10 : 0;
        const int crot = (int)blockIdx.x; (void)krot;
        pg8::DepOrder S; S.cnt = cnt; S.wseam = -1; S.pseam = -1; S.need_p = 0; S.need_s = 0; S.wait_next = 0; S.last_pm = -1;
#define PHQ(k) (ph == (k) && ((PH_MASK >> (k)) & 1))
        if (PHQ(0)) {
            for (int it = F.vcu; it < ADA_ITEMS; it += F.G) ada_item(Fp, args, it);
            LAS float* scr = (LAS float*)(Fp.lds + Fp.wave * 16384);
            const int gw = F.vcu * NWAVES + Fp.wave, NGW = F.G * NWAVES;
            for (int it = gw; it < CV_TOTAL; it += NGW) convert_item(Fp, args, it, scr);
            const int gt = F.vcu * NWAVES * 64 + Fp.tid, NGT = F.G * NWAVES * 64;
            for (int i = gt; i < 2 * NBS * WIN * KVD / 4; i += NGT) {
                const int which = i >= NBS * WIN * KVD / 4, j = which ? i - NBS * WIN * KVD / 4 : i;
                const f32x4 v = ((const f32x4*)(which ? FIN(6) : FIN(5)))[j];
                u32x2 o; o.x = pk_bf16(v[0], v[1]); o.y = pk_bf16(v[2], v[3]);
                (which ? WSP(u32x2, WS_VC) : WSP(u32x2, WS_KC))[j] = o;
                const int e = j * 4, bs = e / (WIN * KVD), r = (e / KVD) % WIN, cidx = e % KVD;
                if (r >= LS) *(f32x4*)(F.out + (which ? O_VS : O_KS) + ((size_t)bs * WIN + (r - LS)) * KVD + cidx) = v;
            }
        } else if (PHQ(1)) {
            for (int it = F.vcu; it < PP_ITEMS; it += F.G) pool_prep_item(Fp, args, 0, it, FIN(0), FIN(1), -1);
            for (int it = F.G - 1 - F.vcu; it < BI_TOTAL + T_NVEC; it += F.G) { if (it < BI_TOTAL) bias_item(Fp, it); else ttable_item(Fp, args, it - BI_TOTAL); }
        } else if (PHQ(5)) {
            for (int it = F.vcu; it < PP_ITEMS; it += F.G) pool_prep_item(Fp, args, 1, it, F.out, F.out + (size_t)MP * D, solo ? -1 : 5);
        } else if (PHQ(2)) {
            int kp = 256; asm volatile("" : "+s"(kp));
            const float* Tt = WSP(const float, WS_T);
            if (F.vcu < 64) { sk::Gemm sg{WSP(const bf16_t, WS_AB), D, 1, WSP(const bf16_t, WS_WPOOL), 256, 0};
                sk::Res sr{FIN(1), F.out, Tt + (T_GATE1 + 0) * TV, Tt + (T_GAINF + 0) * TV, nullptr, WSP(bf16_t, WS_AQ), nullptr, WSP(float, WS_SS)}; sk::Head sh{};
                sk::run<0>(Fp.lds, tidl, F.vcu, sg, sr, sh); }
            pg8::Gemm g{WSP(const bf16_t, WS_AB), WSP(const bf16_t, WS_WPOOL), D, 256, kp}; S.init(NTM - 1, 4, F.G, crot);
            if (!solo) S.pseam = 2;
            typedef pg8::EpiRes<true, 1, true> EP; EP E{Fp.lds + XIN_OFF, mk_rsrc(F.out, (unsigned)(O_END * 4)), mk_rsrc(wsl, (unsigned)WS_END), T_GATE1 + 0, T_GAINF + 0, 0};
            pg8::gemm_phase<EP, pg8::DepOrder, true>(Fp.lds, tidl, g, S, E);
        } else if (PHQ(6) || PHQ(11) || PHQ(16) || PHQ(13)) {
            pg8::Gemm g; int gate_id, g1_id;
            if (ph == 6) { g = pg8::Gemm{WSP(const bf16_t, WS_AB), WSP(const bf16_t, WS_WPOOL) + (size_t)D * 256, D, 256, 256}; gate_id = T_GATE1 + 1; g1_id = T_GAINF + 1;
                if (!solo) { S.wseam = 5; S.need_p = 32; S.need_s = 64; S.wait_next = 1; } }
            else if (ph == 13) { g = pg8::Gemm{WSP(const bf16_t, WS_H), WSP(const bf16_t, WS_WOUT) + (size_t)2 * D * DFF, DFF, 0, DFF}; gate_id = T_GATE2 + 2; g1_id = T_GAINQ + 1;
                if (!solo) { S.wseam = 12; S.need_p = S.need_s = 22 * 8; } }
            else { g = pg8::Gemm{WSP(const bf16_t, WS_AB), WSP(const bf16_t, WS_WO) + (size_t)(layer - 2) * D * D, D, 0, D}; gate_id = T_GATE1 + layer; g1_id = T_GAINF + layer;
                if (!solo) { S.wseam = ph - 1; S.need_p = 16 * 8; S.need_s = 32 * 8; } }
            if (!solo) S.pseam = ph;
            if (F.vcu < 64) { const float* Tt = WSP(const float, WS_T); sk::Gemm sg{g.A, g.lda, ph == 6 ? 1 : 0, g.Bt, g.K, 0};
                sk::Res sr{nullptr, F.out, Tt + gate_id * TV, Tt + g1_id * TV, nullptr, WSP(bf16_t, WS_AQ), nullptr, WSP(float, WS_SS)}; sk::Head sh{};
                sk::run<0>(Fp.lds, tidl, F.vcu, sg, sr, sh); }
            S.init(NTM - 1, 4, F.G, crot);
            typedef pg8::EpiRes<false, 1, true> EP; EP E{nullptr, mk_rsrc(F.out, (unsigned)(O_END * 4)), mk_rsrc(wsl, (unsigned)WS_END), gate_id, g1_id, 0};
            pg8::gemm_phase<EP, pg8::DepOrder, true>(Fp.lds, tidl, g, S, E);
        } else if (PHQ(8)) {
            pg8::Gemm g{WSP(const bf16_t, WS_H), WSP(const bf16_t, WS_WOUT) + (size_t)1 * D * DFF, DFF, 0, DFF}; S.init(NTM - 1, 4, F.G, crot);
            if (F.vcu < 64) { const float* Tt = WSP(const float, WS_T); sk::Gemm sg{g.A, g.lda, 0, g.Bt, g.K, 0};
                sk::Res sr{nullptr, F.out, Tt + (T_GATE2 + 1) * TV, Tt + (T_GAINQ + 0) * TV, Tt + T_GAINKV * TV, WSP(bf16_t, WS_AQ), WSP(bf16_t, WS_AB), WSP(float, WS_SS)}; sk::Head sh{};
                sk::run<0>(Fp.lds, tidl, F.vcu, sg, sr, sh); }
            if (!solo) { S.wseam = 7; S.need_p = S.need_s = 22 * 8; S.pseam = 8; }
            typedef pg8::EpiRes<false, 2, true> EP; EP E{nullptr, mk_rsrc(F.out, (unsigned)(O_END * 4)), mk_rsrc(wsl, (unsigned)WS_END), T_GATE2 + 1, T_GAINQ + 0, T_GAINKV};
            pg8::gemm_phase<EP, pg8::DepOrder, true>(Fp.lds, tidl, g, S, E);
        } else if (PHQ(4) || PHQ(18)) {
            pg8::Gemm g{WSP(const bf16_t, WS_H), WSP(const bf16_t, WS_WOUT) + (size_t)layer * D * DFF, DFF, 0, DFF}; S.init(NTM - 1, 4, F.G, crot);
            if (F.vcu < 64) { const float* Tt = WSP(const float, WS_T); sk::Gemm sg{g.A, g.lda, 0, g.Bt, g.K, 0};
                sk::Res sr{nullptr, F.out, Tt + (T_GATE2 + layer) * TV, nullptr, nullptr, nullptr, nullptr, nullptr}; sk::Head sh{};
                sk::run<0>(Fp.lds, tidl, F.vcu, sg, sr, sh); }
            if (!solo) { S.wseam = ph - 1; S.need_p = S.need_s = 22 * 8; }
            typedef pg8::EpiRes<false, 0, false> EP; EP E{nullptr, mk_rsrc(F.out, (unsigned)(O_END * 4)), mk_rsrc(wsl, (unsigned)WS_END), T_GATE2 + layer, 0, 0};
            pg8::gemm_phase<EP, pg8::DepOrder, true>(Fp.lds, tidl, g, S, E);
        } else if (PHQ(3) || PHQ(7) || PHQ(12) || PHQ(17)) {
            pg8::Gemm g{WSP(const bf16_t, WS_AQ), WSP(const bf16_t, WS_WIN) + (size_t)layer * NIN * D, D, 0, D}; S.init(NTM, NIN / 256, F.G, crot);
            if (!solo) { S.wseam = ph - 1; S.need_p = S.need_s = 4 * 8; S.pseam = ph; }
            pg8::EpiSwiglu E{WSP(const float, WS_SS), WSP(const float, WS_BIN) + (size_t)layer * NBATCH * NIN, mk_rsrc(wsl, (unsigned)WS_END)};
            pg8::gemm_phase<pg8::EpiSwiglu, pg8::DepOrder, true>(Fp.lds, tidl, g, S, E);
        } else if (PHQ(9) || PHQ(14)) {
            const int j = layer - 1;
            if (!solo) { S.wseam = ph - 1; S.need_p = S.need_s = 4 * 8; if (ph == 14) S.pseam = 14; }
            if (ph == 14 && F.vcu < 64) { sk::Gemm sg{WSP(const bf16_t, WS_AQ), D, 0, WSP(const bf16_t, WS_WQ) + (size_t)j * D * D, D, 1}; sk::Res sr{};
                sk::Head sh{WSP(const float, WS_SS), WSP(const float, WS_BQ) + (size_t)j * NBATCH * D, FIN(14) + j * HD, att::C2, WSP(bf16_t, WS_QO)};
                sk::run<1>(Fp.lds, tidl, F.vcu, sg, sr, sh); }
            { pg8::Gemm g{WSP(const bf16_t, WS_AQ), WSP(const bf16_t, WS_WQ) + (size_t)j * D * D, D, 0, D}; S.init(ph == 14 ? NTM - 1 : NTM, 4, F.G, crot);
              pg8::EpiHead<0> E{WSP(const float, WS_SS), WSP(const float, WS_BQ) + (size_t)j * NBATCH * D, D, FIN(14) + j * HD, att::C2, mk_rsrc(wsl, (unsigned)WS_END), nullptr, nullptr, nullptr, nullptr};
              pg8::gemm_phase<pg8::EpiHead<0>, pg8::DepOrder, true>(Fp.lds, tidl, g, S, E); }
            if (ph == 9) {
              pg8::Gemm g{WSP(const bf16_t, WS_AB), WSP(const bf16_t, WS_WKV), D, 0, D}; S.init(NTM, 2, F.G, F.G - 1 - crot); S.last_pm = -1;
              pg8::EpiHead<1> E{WSP(const float, WS_SS), WSP(const float, WS_BKV), 2 * KVD, FIN(21), 1.0f, mk_rsrc(wsl, (unsigned)WS_END), F.out + O_KP, F.out + O_VP, F.out + O_KS, F.out + O_VS};
              pg8::gemm_phase<pg8::EpiHead<1>, pg8::DepOrder, true>(Fp.lds, tidl, g, S, E); }
        } else if (PHQ(10) || PHQ(15)) {
            const int NU = NBP * 128 * NKV + NBS * NKV;
            const float* sk = FIN(15) + (layer - 2) * NH;
            const int ws_ = (!solo && ph == 15) ? 14 : -1, ps_ = solo ? -1 : ph;
            for (int u = F.vcu; u < NU; u += F.G) {
                int bidx, c, g;
                if (u < NBP * 128 * NKV) { g = u & 3; c = (u >> 2) & 127; bidx = u >> 9; } else { const int v = u - NBP * 128 * NKV; g = v & 3; c = 0; bidx = NBP + (v >> 2); }
                att::attn_unit(Fp.lds, tidl, bidx, c, g, WSP(const bf16_t, WS_QO), WSP(bf16_t, WS_AB), WSP(const bf16_t, WS_KB), WSP(const bf16_t, WS_VB), WSP(const bf16_t, WS_KC), WSP(const bf16_t, WS_VC), sk, cnt, ws_, ps_);
            }
        }
        if (ph + 1 < hi) xcd_barrier(bar, tidl);
    }
}

extern "C" void kernel_launch(void* const* d_in, const int* in_sizes, int n_in, void* d_out, int out_size, void* d_ws, size_t ws_size, hipStream_t stream) {
    static int grid = 0;
    if (grid == 0) {
        if (n_in != 24 || (size_t)out_size != O_END || ws_size < WS_END) { fprintf(stderr, "kernel_launch: unexpected sizes n_in %d out %d ws %zu\n", n_in, out_size, ws_size); grid = -1; return; }
        int dev = 0, cus = 0, per_cu = 0;
        if (hipGetDevice(&dev) != hipSuccess || hipDeviceGetAttribute(&cus, hipDeviceAttributeMultiprocessorCount, dev) != hipSuccess) { grid = -1; return; }
        if (hipFuncSetAttribute((const void*)yoco_fwd, hipFuncAttributeMaxDynamicSharedMemorySize, LDS_BYTES) != hipSuccess) { fprintf(stderr, "kernel_launch: hipFuncSetAttribute failed\n"); grid = -1; return; }
        if (hipOccupancyMaxActiveBlocksPerMultiprocessor(&per_cu, (const void*)yoco_fwd, NWAVES * 64, LDS_BYTES) != hipSuccess || per_cu < 1) { fprintf(stderr, "kernel_launch: occupancy query reports %d blocks per CU\n", per_cu); grid = -1; (void)hipGetLastError(); return; }
        grid = cus;
    }
    if (grid < 0) return;
    (void)hipMemsetAsync((char*)d_ws + WS_CTL, 0, CTL_ZERO_BYTES, stream);
    Args a{};
    for (int i = 0; i < 24; ++i) a.in[i] = (const float*)d_in[i];
    a.out = (float*)d_out; a.ws = (unsigned char*)d_ws;
#if MK_ONE_LAUNCH
    a.ph_lo = 0; a.ph_hi = NPHASE;
    hipLaunchKernelGGL(yoco_fwd, dim3(grid), dim3(NWAVES * 64), LDS_BYTES, stream, a);
#else
#ifndef DUP_MASK
#define DUP_MASK 0
#endif
    for (int p = 0; p < NPHASE; ++p) { a.ph_lo = p; a.ph_hi = p + 1; hipLaunchKernelGGL(yoco_fwd, dim3(grid), dim3(NWAVES * 64), LDS_BYTES, stream, a);
        if ((DUP_MASK >> p) & 1) hipLaunchKernelGGL(yoco_fwd, dim3(grid), dim3(NWAVES * 64), LDS_BYTES, stream, a); }
#endif
}
```

```cpp
#include <hip/hip_runtime.h>
#include <cstdio>
#include <cstdint>

#define LAS __attribute__((address_space(3)))
typedef unsigned short bf16_t;
typedef short bf16x8 __attribute__((ext_vector_type(8)));
typedef short s16x4 __attribute__((ext_vector_type(4)));
typedef float f32x2 __attribute__((ext_vector_type(2)));
typedef float f32x4 __attribute__((ext_vector_type(4)));
typedef float f32x16 __attribute__((ext_vector_type(16)));
typedef unsigned u32x2 __attribute__((ext_vector_type(2)));
typedef unsigned u32x4 __attribute__((ext_vector_type(4)));
typedef __bf16 bf16x2_t __attribute__((ext_vector_type(2)));

#ifndef MK_ONE_LAUNCH
#define MK_ONE_LAUNCH 1
#define WT_AUX 0
#endif

constexpr int D = 1024, SEQ = 8192, NBP = 2, NBS = 8, LS = 16, NBATCH = 10;
constexpr int MP = NBP * SEQ, MS = NBS * LS, MREAL = MP + MS, NTM = 65, MPAD = NTM * 256;
constexpr int DFF = 2816, NIN = 2 * DFF, HD = 64, NH = 16, NKV = 4, KVD = NKV * HD, WIN = 128, PH = 15;
constexpr int ADAW = 6 * D;
constexpr float EPS = 1e-6f;
constexpr int NPHASE = 19;

constexpr size_t O_Y = 0, O_POOLP = (size_t)MREAL * D, O_KP = O_POOLP + 2 * NBP * PH * D, O_VP = O_KP + (size_t)NBP * WIN * KVD,
                 O_POOLS = O_VP + (size_t)NBP * WIN * KVD, O_KS = O_POOLS + 2 * NBS * PH * D, O_VS = O_KS + (size_t)NBS * WIN * KVD, O_END = O_VS + (size_t)NBS * WIN * KVD;

constexpr size_t MiB = 1u << 20;
constexpr size_t WS_CTL = 0, CTL_ZERO_BYTES = 1 * MiB;
constexpr size_t WS_ADA = 1 * MiB, WS_ADAKV = 2 * MiB, WS_BIN = 3 * MiB, WS_BQ = 4 * MiB, WS_BKV = 4 * MiB + 128 * 1024, WS_SS = 5 * MiB, WS_T = 7 * MiB;
constexpr int T_GATE1 = 0, T_GAINF = 4, T_GATE2 = 8, T_GAINQ = 12, T_GAINKV = 14, T_NVEC = 15, TV = NBATCH * D;
constexpr size_t WS_WPOOL = 8 * MiB, WS_WQ = 9 * MiB, WS_WO = 13 * MiB, WS_WKV = 17 * MiB, WS_WIN = 18 * MiB, WS_WOUT = 62 * MiB;
constexpr size_t WS_KC = 84 * MiB, WS_VC = 84 * MiB + 512 * 1024, WS_KB = 85 * MiB, WS_VB = 94 * MiB;
constexpr size_t WS_AQ = 104 * MiB, WS_AB = 137 * MiB, WS_QO = 170 * MiB, WS_H = 203 * MiB, WS_END = 293 * MiB;
constexpr int RSS_N = 7;
static_assert((size_t)(RSS_N + 1) * MPAD * 4 <= 2 * MiB, "rss"); static_assert((size_t)MPAD * D * 2 <= 33 * MiB && (size_t)MPAD * DFF * 2 <= 90 * MiB && (size_t)MPAD * KVD * 2 <= 9 * MiB && (size_t)MPAD * 16 * 4 <= 3 * MiB, "ws map");
constexpr int CW_BAR = 4096, CW_CNT = 8192;

__device__ __forceinline__ unsigned pk_bf16(float lo, float hi) { f32x2 v = {lo, hi}; bf16x2_t b = __builtin_convertvector(v, bf16x2_t); return __builtin_bit_cast(unsigned, b); }
__device__ __forceinline__ float bf_lo(unsigned u) { return __uint_as_float(u << 16); }
__device__ __forceinline__ float bf_hi(unsigned u) { return __uint_as_float(u & 0xffff0000u); }
__device__ __forceinline__ float shx(float v, int mask, int lane) { return __int_as_float(__builtin_amdgcn_ds_bpermute((lane ^ mask) << 2, __float_as_int(v))); }
__device__ __forceinline__ float wave_sum(float v, int lane) {
#pragma unroll
    for (int o = 1; o < 64; o <<= 1) v += shx(v, o, lane);
    return v;
}
__device__ __forceinline__ int batch_of(int row16) { return row16 < MP ? (row16 >> 13) : min(2 + ((row16 - MP) >> 4), NBATCH - 1); }
#ifndef WT_AUX
#define WT_AUX 16
#endif
typedef __amdgpu_buffer_rsrc_t rsrc_t;
__device__ __forceinline__ rsrc_t mk_rsrc(const void* p, unsigned bytes) { return __builtin_amdgcn_make_buffer_rsrc((void*)p, 0, (int)bytes, 0x00020000); }
__device__ __forceinline__ void st16_wt(rsrc_t r, unsigned off, u32x4 v) { __builtin_amdgcn_raw_buffer_store_b128(v, r, (int)off, 0, WT_AUX); }
__device__ __forceinline__ void st16f_wt(rsrc_t r, unsigned off, f32x4 v) { __builtin_amdgcn_raw_buffer_store_b128(__builtin_bit_cast(u32x4, v), r, (int)off, 0, WT_AUX); }
__device__ __forceinline__ void st8_wt(rsrc_t r, unsigned off, u32x2 v) { __builtin_amdgcn_raw_buffer_store_b64(v, r, (int)off, 0, WT_AUX); }
__device__ __forceinline__ void st4_wt(rsrc_t r, unsigned off, float v) { __builtin_amdgcn_raw_buffer_store_b32(__float_as_uint(v), r, (int)off, 0, WT_AUX); }
__device__ __forceinline__ f32x4 ld16f(rsrc_t r, unsigned off) { return __builtin_bit_cast(f32x4, __builtin_amdgcn_raw_buffer_load_b128(r, (int)off, 0, 0)); }
#define LDS_WAIT() asm volatile("s_waitcnt lgkmcnt(0)" ::: "memory")
#define VM_WAIT() asm volatile("s_waitcnt vmcnt(0)" ::: "memory")

namespace pg8 {
constexpr int BM = 256, BK = 64, HALF = 128, HTB = HALF * BK * 2, STAGE_BYTES = 8 * HTB, NXCD = 8, WGM = 8;
__host__ __device__ __forceinline__ int lds_byte(int r, int c) { const int st = (r >> 4) * 2 + (c >> 5), rr = r & 15, cc = c & 31, ob = rr * 64 + cc * 2; return st * 1024 + (ob ^ (((ob >> 9) & 1) << 5)); }
__host__ __device__ __forceinline__ void stage_rc(int b, int& R, int& C) { const int st = b / 1024, sb = b % 1024, swz = sb ^ (((sb >> 9) & 1) << 5); R = (st >> 1) * 16 + swz / 64; C = (st & 1) * 32 + (swz % 64) / 2; }
__host__ __device__ __forceinline__ int perm32(int rho) { const int n = rho >> 4, i = rho & 15; return 8 * (i >> 2) + 4 * n + (i & 3); }

struct Unit { int pm, pn; };
struct Gemm { const bf16_t* A; const bf16_t* Bt; int lda; int a_pn_off; int K; };

struct StaticOrder {
    int nM, nN, nwg, G, c;
    __host__ __device__ void init(int nM_, int nN_, int G_, int c_) { nM = nM_; nN = nN_; nwg = nM * nN; G = G_; c = c_; }
    __host__ __device__ bool next(int i, Unit& u) const {
        const long L = (long)i * G + c; if (L >= nwg) return false;
        int wgid = (int)L; { const int q = nwg / NXCD, r = nwg % NXCD, xcd = wgid % NXCD, off = wgid / NXCD; wgid = (xcd < r ? xcd * (q + 1) : r * (q + 1) + (xcd - r) * q) + off; }
        const int nig = WGM * nN, gid = wgid / nig, fm = gid * WGM, gsz = (nM - fm) < WGM ? (nM - fm) : WGM;
        u.pm = fm + ((wgid % nig) % gsz); u.pn = (wgid % nig) / gsz; return true;
    }
};
constexpr int NPAN = 65;
__device__ __forceinline__ void dep_publish(unsigned* cnt, int seam, int pm, int lane) {
    asm volatile("s_waitcnt vmcnt(0)" ::: "memory");
    if (lane == 0) __hip_atomic_fetch_add(cnt + (size_t)(seam * NPAN + pm) * 64, 1u, __ATOMIC_RELAXED, __HIP_MEMORY_SCOPE_AGENT);
}
__device__ __forceinline__ void dep_poll(unsigned* cnt, int seam, int pm, unsigned need) {
    unsigned* p = cnt + (size_t)(seam * NPAN + pm) * 64;
    const unsigned long long t0 = __builtin_amdgcn_s_memrealtime();
    while ((unsigned)__builtin_amdgcn_readfirstlane(__hip_atomic_load(p, __ATOMIC_RELAXED, __HIP_MEMORY_SCOPE_AGENT)) < need) {
        if (__builtin_amdgcn_s_memrealtime() - t0 > 2000000ull) break;
        __builtin_amdgcn_s_sleep(2); }
}
struct DepOrder : StaticOrder {
    unsigned* cnt; int wseam, pseam; unsigned need_p, need_s; int wait_next; int last_pm;
    __device__ __forceinline__ void a_ready(const Unit& u, int wid) {
        if (wseam < 0 || u.pm == last_pm) return;
        if (wid == 0) {
            dep_poll(cnt, wseam, u.pm, u.pm == NPAN - 1 ? need_s : need_p);
            if (wait_next && u.pm + 1 < NPAN) dep_poll(cnt, wseam, u.pm + 1, u.pm + 1 == NPAN - 1 ? need_s : need_p);
            __builtin_amdgcn_fence(__ATOMIC_ACQUIRE, "agent");
            asm volatile("s_waitcnt vmcnt(0)" ::: "memory");
        }
        asm volatile("" ::: "memory"); __builtin_amdgcn_s_barrier(); asm volatile("" ::: "memory");
        last_pm = u.pm;
    }
    __device__ __forceinline__ void done(const Unit& u, int lane) const { if (pseam >= 0) dep_publish(cnt, pseam, u.pm, lane); }
};

template <class Epi, class Sched, bool ALIGN_EPI = false>
__device__ __forceinline__ void gemm_phase(LAS unsigned char* lds, const int tid, const Gemm g, Sched& S, const Epi& E) {
    const int wid = __builtin_amdgcn_readfirstlane(tid >> 6), lane = tid & 63, wr = wid >> 2, wc = wid & 3, fr = lane & 15, fq = lane >> 4;
    const int K = g.K, nt = K / BK, lda = g.lda;
    unsigned voffA[2], voffB[2];
#pragma unroll
    for (int i = 0; i < 2; ++i) { int R, C; stage_rc(tid * 16 + i * 8192, R, C); const int Rb = Epi::PERM ? ((R & ~31) + perm32(R & 31)) : R;
        voffA[i] = (unsigned)(R * lda + C) * 2u; voffB[i] = (unsigned)(Rb * K + C) * 2u; }
    const size_t kstep = (size_t)(BK * 2);
    const size_t hstepA = (size_t)HALF * lda * 2, hstepB = (size_t)HALF * K * 2;
    const size_t tstepA = 2 * hstepA, tstepB = 2 * hstepB;
    const unsigned ldsw = (unsigned)wid * 1024u;
    const int aoff = lds_byte(wr * 64 + fr, fq * 8), boff = lds_byte(wc * 32 + fr, fq * 8);
#define PG8_SA(b, h) (((b) * 2 + (h)) * HTB)
#define PG8_SB(b, h) ((4 + (b) * 2 + (h)) * HTB)
#define PG8_STAGE(bufoff, gbase, voff) do { _Pragma("unroll") for (int _i = 0; _i < 2; ++_i) \
        __builtin_amdgcn_global_load_lds((const unsigned*)((const char*)(gbase) + (voff)[_i]), (LAS unsigned*)(lds + (bufoff) + ldsw + _i * 8192), 16, 0, 0); } while (0)
#define PG8_LDA(dst, b, h) do { _Pragma("unroll") for (int m = 0; m < 4; ++m) _Pragma("unroll") for (int k = 0; k < 2; ++k) dst[m][k] = *(const LAS bf16x8*)(lds + PG8_SA(b, h) + aoff + m * 2048 + k * 1024); } while (0)
#define PG8_LDB(dst, b, h) do { _Pragma("unroll") for (int n = 0; n < 2; ++n) _Pragma("unroll") for (int k = 0; k < 2; ++k) dst[n][k] = *(const LAS bf16x8*)(lds + PG8_SB(b, h) + boff + n * 2048 + k * 1024); } while (0)
#define PG8_MMA(ai, bj, At, Bt) do { __builtin_amdgcn_s_setprio(1); _Pragma("unroll") for (int m = 0; m < 4; ++m) _Pragma("unroll") for (int n = 0; n < 2; ++n) _Pragma("unroll") for (int k = 0; k < 2; ++k) \
        acc[ai][bj][m][n] = __builtin_amdgcn_mfma_f32_16x16x32_bf16(Bt[n][k], At[m][k], acc[ai][bj][m][n], 0, 0, 0); __builtin_amdgcn_s_setprio(0); } while (0)
#define PG8_WAIT_V(n) asm volatile("s_waitcnt vmcnt(" #n ")" ::: "memory")
#define PG8_WAIT_L(n) asm volatile("s_waitcnt lgkmcnt(" #n ")" ::: "memory")
#define PG8_BAR __builtin_amdgcn_s_barrier()
#define PG8_SCHED __builtin_amdgcn_sched_barrier(0)
    Unit cur, nxt; int ui = 0;
    if (!S.next(0, cur)) return;
    f32x4 acc[2][2][4][2];
    const float zf = __int_as_float(tid >> 12);
#pragma unroll
    for (int a = 0; a < 2; ++a)
#pragma unroll
        for (int b = 0; b < 2; ++b)
#pragma unroll
            for (int m = 0; m < 4; ++m)
#pragma unroll
                for (int n = 0; n < 2; ++n) acc[a][b][m][n] = (f32x4){zf, zf, zf, zf};
    bf16x8 At[4][2], B0[2][2], B1[2][2];
    const char* cA = (const char*)g.A + (size_t)cur.pm * tstepA + (size_t)cur.pn * g.a_pn_off * 2; const char* cB = (const char*)g.Bt + (size_t)cur.pn * tstepB;
    S.a_ready(cur, wid);
    PG8_STAGE(PG8_SB(0, 0), cB, voffB); PG8_STAGE(PG8_SB(0, 1), cB + hstepB, voffB); PG8_STAGE(PG8_SA(0, 0), cA, voffA); PG8_STAGE(PG8_SA(0, 1), cA + hstepA, voffA);
    if (wr == 1) PG8_BAR;
    PG8_WAIT_V(2); PG8_BAR;
    PG8_STAGE(PG8_SB(1, 0), cB + kstep, voffB); PG8_STAGE(PG8_SA(1, 0), cA + kstep, voffA); PG8_STAGE(PG8_SB(1, 1), cB + hstepB + kstep, voffB);
    PG8_WAIT_V(6); PG8_BAR;
    for (;;) {
        const bool has_next = S.next(ui + 1, nxt);
        const char* nA = has_next ? (const char*)g.A + (size_t)nxt.pm * tstepA + (size_t)nxt.pn * g.a_pn_off * 2 : cA; const char* nB = has_next ? (const char*)g.Bt + (size_t)nxt.pn * tstepB : cB;
        for (int t = 0; t < nt; t += 2) {
            const bool last = (t == nt - 2);
            const char* a1 = cA + (size_t)(t + 1) * kstep;
            const char* a2 = last ? nA : cA + (size_t)(t + 2) * kstep; const char* b2 = last ? nB : cB + (size_t)(t + 2) * kstep;
            const char* a3 = a2 + kstep; const char* b3 = b2 + kstep;
            if (last && has_next) S.a_ready(nxt, wid);
            PG8_LDB(B0, 0, 0); PG8_LDB(B1, 0, 1); PG8_SCHED; PG8_LDA(At, 0, 0); PG8_STAGE(PG8_SA(1, 1), a1 + hstepA, voffA);
            PG8_WAIT_V(8); PG8_WAIT_L(0); PG8_BAR; PG8_MMA(0, 0, At, B0); PG8_MMA(0, 1, At, B1); PG8_BAR; PG8_SCHED;
            PG8_LDA(At, 0, 1); PG8_STAGE(PG8_SB(0, 0), b2, voffB); PG8_STAGE(PG8_SB(0, 1), b2 + hstepB, voffB); PG8_STAGE(PG8_SA(0, 0), a2, voffA);
            PG8_WAIT_V(8); PG8_WAIT_L(0); PG8_BAR; PG8_MMA(1, 0, At, B0); PG8_MMA(1, 1, At, B1); PG8_BAR; PG8_SCHED;
            PG8_LDB(B0, 1, 0); PG8_LDB(B1, 1, 1); PG8_SCHED; PG8_LDA(At, 1, 0); PG8_STAGE(PG8_SA(0, 1), a2 + hstepA, voffA);
            PG8_WAIT_V(8); PG8_WAIT_L(0); PG8_BAR; PG8_MMA(0, 0, At, B0); PG8_MMA(0, 1, At, B1); PG8_BAR; PG8_SCHED;
            PG8_LDA(At, 1, 1); PG8_STAGE(PG8_SB(1, 0), b3, voffB); PG8_STAGE(PG8_SB(1, 1), b3 + hstepB, voffB); PG8_STAGE(PG8_SA(1, 0), a3, voffA);
            PG8_WAIT_V(8); PG8_WAIT_L(0); PG8_BAR; PG8_MMA(1, 0, At, B0); PG8_MMA(1, 1, At, B1); PG8_BAR; PG8_SCHED;
        }
        if constexpr (ALIGN_EPI) { if (wr == 0) PG8_BAR; }
        E(acc, cur, wr, wc, fr, fq); S.done(cur, lane);
        if (!has_next) break;
#pragma unroll
        for (int a = 0; a < 2; ++a)
#pragma unroll
            for (int b = 0; b < 2; ++b)
#pragma unroll
                for (int m = 0; m < 4; ++m)
#pragma unroll
                    for (int n = 0; n < 2; ++n) acc[a][b][m][n] = (f32x4){zf, zf, zf, zf};
        cur = nxt; cA = nA; cB = nB; ++ui;
        if constexpr (ALIGN_EPI) { if (wr == 1) PG8_BAR; }
    }
    PG8_WAIT_V(0);
    if constexpr (!ALIGN_EPI) { if (wr == 0) PG8_BAR; }
    PG8_BAR;
#undef PG8_SA
#undef PG8_SB
#undef PG8_STAGE
#undef PG8_LDA
#undef PG8_LDB
#undef PG8_MMA
#undef PG8_WAIT_V
#undef PG8_WAIT_L
#undef PG8_BAR
#undef PG8_SCHED
}


template <bool XIN, int NA, bool HAS_SS> struct EpiRes {
    static constexpr bool PERM = true;
    LAS const unsigned char* xin_lds;
    rsrc_t rx, rw;
    int gate_id, g1_id, g2_id; float* rss;
    __device__ __forceinline__ void operator()(const f32x4 (&acc)[2][2][4][2], const Unit& u, int wr, int wc, int fr, int fq) const {
        const unsigned colb = (unsigned)(u.pn * BM + wc * 32 + 8 * fq), toff = (unsigned)(u.pm >> 5) * D + colb;
        const unsigned gate = (unsigned)WS_T + ((unsigned)gate_id * TV + toff) * 4, g1 = (unsigned)WS_T + ((unsigned)g1_id * TV + toff) * 4, g2 = (unsigned)WS_T + ((unsigned)g2_id * TV + toff) * 4;
        const float* xo = nullptr;
        if (XIN) { const unsigned long long pv = ((const LAS unsigned long long*)xin_lds)[0];
            xo = (const float*)(((unsigned long long)(unsigned)__builtin_amdgcn_readfirstlane((int)(pv >> 32)) << 32) | (unsigned)__builtin_amdgcn_readfirstlane((int)pv)); }
        const unsigned row0 = (unsigned)(u.pm * BM + wr * 64 + fr);
        float ssq[8];
#pragma unroll
        for (int g_ = 0; g_ < 8; ++g_) ssq[g_] = 0.f;
#define E1_LOADX(dst, g_, bj_) do { const unsigned xoff_ = (row0 + ((g_) >> 2) * HALF + ((g_) & 3) * 16) * D + colb + (bj_) * HALF; \
            _Pragma("unroll") for (int n = 0; n < 2; ++n) { if (XIN) dst[n] = *(const f32x4*)(xo + xoff_ + 4 * n); else dst[n] = ld16f(rx, (xoff_ + 4 * n) * 4); } } while (0)
#pragma unroll
        for (int bj = 0; bj < 2; ++bj) {
            f32x4 gt[2], ga[2], gb[2], xc[2], xn_[2];
#pragma unroll
            for (int n = 0; n < 2; ++n) { gt[n] = ld16f(rw, gate + (bj * HALF + 4 * n) * 4);
                if (NA >= 1) ga[n] = ld16f(rw, g1 + (bj * HALF + 4 * n) * 4);
                if (NA >= 2) gb[n] = ld16f(rw, g2 + (bj * HALF + 4 * n) * 4); }
            E1_LOADX(xc, 0, bj);
#pragma unroll
            for (int g_ = 0; g_ < 8; ++g_) {
                const int ai = g_ >> 2, m = g_ & 3;
                if (g_ < 7) E1_LOADX(xn_, g_ + 1, bj);
                const unsigned ooff = (row0 + ai * HALF + m * 16) * D + colb + bj * HALF;
                const f32x4 na = xc[0] + gt[0] * acc[ai][bj][m][0], nb = xc[1] + gt[1] * acc[ai][bj][m][1];
                st16f_wt(rx, ooff * 4, na); st16f_wt(rx, (ooff + 4) * 4, nb);
                if (HAS_SS) ssq[g_] += ((na[0] * na[0] + na[1] * na[1]) + (na[2] * na[2] + na[3] * na[3])) + ((nb[0] * nb[0] + nb[1] * nb[1]) + (nb[2] * nb[2] + nb[3] * nb[3]));
                if (NA >= 1) { const f32x4 pa = na * ga[0], pb = nb * ga[1];
                    u32x4 w; w.x = pk_bf16(pa[0], pa[1]); w.y = pk_bf16(pa[2], pa[3]); w.z = pk_bf16(pb[0], pb[1]); w.w = pk_bf16(pb[2], pb[3]); st16_wt(rw, (unsigned)WS_AQ + ooff * 2, w); }
                if (NA >= 2) { const f32x4 pa = na * gb[0], pb = nb * gb[1];
                    u32x4 w; w.x = pk_bf16(pa[0], pa[1]); w.y = pk_bf16(pa[2], pa[3]); w.z = pk_bf16(pb[0], pb[1]); w.w = pk_bf16(pb[2], pb[3]); st16_wt(rw, (unsigned)WS_AB + ooff * 2, w); }
                asm volatile("" ::: "memory");
                xc[0] = xn_[0]; xc[1] = xn_[1];
            }
        }
        if (HAS_SS) {
#pragma unroll
            for (int g_ = 0; g_ < 8; ++g_) { float ss = ssq[g_]; ss += shx(ss, 16, fq * 16 + fr); ss += shx(ss, 32, fq * 16 + fr); if (fq == 0) unsafeAtomicAdd(rss + row0 + (g_ >> 2) * HALF + (g_ & 3) * 16, ss); }
        }
#undef E1_LOADX
    }
};

__device__ __forceinline__ float rstd_of(float sumsq) { return 1.0f / sqrtf(sumsq * (1.0f / D) + EPS); }
__device__ __forceinline__ float silu_f(float g) { return g * __builtin_amdgcn_rcpf(1.0f + __builtin_amdgcn_exp2f(-1.4426950408889634f * g)); }

struct EpiSwiglu {
    static constexpr bool PERM = true;
    const float* rss; const float* bias;
    rsrc_t rw;
    __device__ __forceinline__ void operator()(const f32x4 (&acc)[2][2][4][2], const Unit& u, int wr, int wc, int fr, int fq) const {
        const int pc = u.pn * BM + wc * 32 + 8 * fq;
        const bool prompt = u.pm < MP / BM;
        const unsigned row0 = (unsigned)(u.pm * BM + wr * 64 + fr);
        float rs[8];
#pragma unroll
        for (int g_ = 0; g_ < 8; ++g_) rs[g_] = rss[row0 + (g_ >> 2) * HALF + (g_ & 3) * 16];
        f32x4 bg[2], bu[2];
        { const float* bp = bias + (size_t)(prompt ? (u.pm >> 5) : NBP) * NIN + pc;
#pragma unroll
          for (int n = 0; n < 2; ++n) { bg[n] = *(const f32x4*)(bp + 4 * n); bu[n] = *(const f32x4*)(bp + HALF + 4 * n); } }
#pragma unroll
        for (int g_ = 0; g_ < 8; ++g_) {
            const int ai = g_ >> 2, m = g_ & 3;
            const unsigned row = row0 + ai * HALF + m * 16;
            if (!prompt) { const float* bp = bias + (size_t)batch_of((int)(row - fr)) * NIN + pc;
#pragma unroll
                for (int n = 0; n < 2; ++n) { bg[n] = *(const f32x4*)(bp + 4 * n); bu[n] = *(const f32x4*)(bp + HALF + 4 * n); } }
            const float r = rstd_of(rs[g_]);
            u32x4 w;
#pragma unroll
            for (int n = 0; n < 2; ++n) {
                const f32x4 gv = acc[ai][0][m][n] * r + bg[n], uv = acc[ai][1][m][n] * r + bu[n];
                const float h0 = silu_f(gv[0]) * uv[0], h1 = silu_f(gv[1]) * uv[1], h2 = silu_f(gv[2]) * uv[2], h3 = silu_f(gv[3]) * uv[3];
                if (n == 0) { w.x = pk_bf16(h0, h1); w.y = pk_bf16(h2, h3); } else { w.z = pk_bf16(h0, h1); w.w = pk_bf16(h2, h3); }
            }
            st16_wt(rw, (unsigned)WS_H + (row * DFF + u.pn * HALF + wc * 32 + 8 * fq) * 2, w);
        }
    }
};

template <int MODE> struct EpiHead {
    static constexpr bool PERM = true;
    const float* rss; const float* bias; int bias_stride; const float* gvec; float oscale;
    rsrc_t rw; float* fk_p; float* fv_p; float* fk_s; float* fv_s;
    __device__ __forceinline__ void operator()(const f32x4 (&acc)[2][2][4][2], const Unit& u, int wr, int wc, int fr, int fq) const {
        const bool isv = (MODE == 1) && (u.pn == 1);
        const int ldo = (MODE == 0) ? D : KVD;
        const int ocol = (MODE == 0 ? (4 * u.pn + wc) * HD : wc * HD) + 8 * fq;
        const unsigned Ob = (MODE == 0) ? (unsigned)WS_QO : (isv ? (unsigned)WS_VB : (unsigned)WS_KB);
        const bool prompt = u.pm < MP / BM;
        float rsv[8];
#pragma unroll
        for (int g_ = 0; g_ < 8; ++g_) rsv[g_] = rss[u.pm * BM + wr * 64 + fr + (g_ >> 2) * HALF + (g_ & 3) * 16];
        f32x4 bv[2][2];
        { const float* bp = bias + (size_t)(prompt ? (u.pm >> 5) : NBP) * bias_stride + u.pn * BM + wc * 32 + 8 * fq;
#pragma unroll
          for (int bj = 0; bj < 2; ++bj)
#pragma unroll
              for (int n = 0; n < 2; ++n) bv[bj][n] = *(const f32x4*)(bp + bj * HALF + 4 * n); }
#pragma unroll
        for (int ai = 0; ai < 2; ++ai)
#pragma unroll
            for (int m = 0; m < 4; ++m) {
                const int row16 = u.pm * BM + ai * HALF + wr * 64 + m * 16, row = row16 + fr;
                const float rs = rstd_of(rsv[ai * 4 + m]);
                if (!prompt) { const float* bp = bias + (size_t)batch_of(row16) * bias_stride + u.pn * BM + wc * 32 + 8 * fq;
#pragma unroll
                    for (int bj = 0; bj < 2; ++bj)
#pragma unroll
                        for (int n = 0; n < 2; ++n) bv[bj][n] = *(const f32x4*)(bp + bj * HALF + 4 * n); }
                f32x4 v[2][2]; float ss = 0.f;
#pragma unroll
                for (int bj = 0; bj < 2; ++bj)
#pragma unroll
                    for (int n = 0; n < 2; ++n) { v[bj][n] = acc[ai][bj][m][n] * rs + bv[bj][n];
                        ss += (v[bj][n][0] * v[bj][n][0] + v[bj][n][1] * v[bj][n][1]) + (v[bj][n][2] * v[bj][n][2] + v[bj][n][3] * v[bj][n][3]); }
                ss += shx(ss, 16, fq * 16 + fr); ss += shx(ss, 32, fq * 16 + fr);
                const float hr = 1.0f / sqrtf(ss * (1.0f / HD) + EPS);
                if (!isv) {
#pragma unroll
                    for (int bj = 0; bj < 2; ++bj)
#pragma unroll
                        for (int n = 0; n < 2; ++n) v[bj][n] = v[bj][n] * (hr * oscale) * *(const f32x4*)(gvec + 32 * bj + 8 * fq + 4 * n);
                }
                float* ftail = nullptr;
                if (MODE == 1) {
                    if (row < MP) { const int t = row & (SEQ - 1); if (t >= SEQ - WIN) ftail = (isv ? fv_p : fk_p) + ((size_t)(row >> 13) * WIN + (t - (SEQ - WIN))) * KVD; }
                    else if (row < MREAL) { const int bs = (row - MP) >> 4, t = (row - MP) & 15; ftail = (isv ? fv_s : fk_s) + ((size_t)bs * WIN + (WIN - LS) + t) * KVD; }
                }
#pragma unroll
                for (int bj = 0; bj < 2; ++bj) {
                    u32x4 w; w.x = pk_bf16(v[bj][0][0], v[bj][0][1]); w.y = pk_bf16(v[bj][0][2], v[bj][0][3]); w.z = pk_bf16(v[bj][1][0], v[bj][1][1]); w.w = pk_bf16(v[bj][1][2], v[bj][1][3]);
                    st16_wt(rw, Ob + ((unsigned)row * ldo + ocol + 32 * bj) * 2, w);
                    if (MODE == 1) { if (ftail) { *(f32x4*)(ftail + ocol + 32 * bj) = v[bj][0]; *(f32x4*)(ftail + ocol + 32 * bj + 4) = v[bj][1]; } }
                }
                asm volatile("" ::: "memory");
            }
    }
};
}

namespace sk {
struct Gemm { const bf16_t* A; int lda; int a_grp; const bf16_t* Bt; int K; int headperm; };
struct Res { const float* xin_s; float* X; const float* gate; const float* g1; const float* g2; bf16_t* A1; bf16_t* A2; float* SS; };
struct Head { const float* SS; const float* bias; const float* gvec; float oscale; bf16_t* O; };

template <int KIND> __device__ __forceinline__ void run(LAS unsigned char* lds, int tid, int tile, const Gemm g, const Res R, const Head H) {
    const int lane = tid & 63, wid = __builtin_amdgcn_readfirstlane(tid >> 6), fr = lane & 15, fq = lane >> 4;
    const int rt = tile & 3, ct = tile >> 2, K = g.K, kw = K >> 3, nst = kw >> 5;
    const bf16_t* ap = g.A + (size_t)(MP + 32 * rt + fr) * g.lda + (g.a_grp ? 256 * (ct >> 2) : 0) + wid * kw + 8 * fq;
    const int brow0 = g.headperm ? 256 * (ct >> 2) + 32 * (ct & 3) : 64 * ct;
    const bf16_t* bp = g.Bt + (size_t)(brow0 + fr) * K + wid * kw + 8 * fq;
    const size_t bst1 = (size_t)16 * K, bst2 = g.headperm ? (size_t)128 * K : (size_t)32 * K;
    f32x4 acc[2][4];
#pragma unroll
    for (int mi = 0; mi < 2; ++mi)
#pragma unroll
        for (int ni = 0; ni < 4; ++ni) acc[mi][ni] = (f32x4){0.f, 0.f, 0.f, 0.f};
    for (int s0 = 0; s0 < nst; s0 += 4) {
        bf16x8 af[4][2], bf[4][4];
#pragma unroll
        for (int q = 0; q < 4; ++q) { const int s_ = (s0 + q < nst) ? s0 + q : s0;
#pragma unroll
            for (int mi = 0; mi < 2; ++mi) af[q][mi] = *(const bf16x8*)(ap + (size_t)(16 * mi) * g.lda + 32 * s_);
#pragma unroll
            for (int ni = 0; ni < 4; ++ni) bf[q][ni] = *(const bf16x8*)(bp + (ni & 1) * bst1 + (ni >> 1) * bst2 + 32 * s_); }
#pragma unroll
        for (int q = 0; q < 4; ++q) if (s0 + q < nst) {
#pragma unroll
            for (int mi = 0; mi < 2; ++mi)
#pragma unroll
                for (int ni = 0; ni < 4; ++ni) acc[mi][ni] = __builtin_amdgcn_mfma_f32_16x16x32_bf16(bf[q][ni], af[q][mi], acc[mi][ni], 0, 0, 0); }
    }
    LAS f32x4* red = (LAS f32x4*)lds;
#pragma unroll
    for (int mi = 0; mi < 2; ++mi)
#pragma unroll
        for (int ni = 0; ni < 4; ++ni) red[(wid * 8 + mi * 4 + ni) * 64 + lane] = acc[mi][ni];
    LDS_WAIT(); __syncthreads();
    const int rl = 4 * wid + (lane >> 4), c4 = lane & 15;
    f32x4 v = {0.f, 0.f, 0.f, 0.f};
    { const int idx = ((rl >> 4) * 4 + (c4 >> 2)) * 64 + (c4 & 3) * 16 + (rl & 15);
#pragma unroll
      for (int w = 0; w < 8; ++w) v += red[w * 512 + idx]; }
    const int srow = 32 * rt + rl, row = MP + srow, b = NBP + (srow >> 4), col = 64 * ct + 4 * c4;
    if (KIND == 0) {
        const f32x4 x4 = R.xin_s ? *(const f32x4*)(R.xin_s + (size_t)srow * D + col) : *(const f32x4*)(R.X + (size_t)row * D + col);
        const f32x4 xn = x4 + *(const f32x4*)(R.gate + b * D + col) * v;
        *(f32x4*)(R.X + (size_t)row * D + col) = xn;
        if (R.SS) { float ss = (xn[0] * xn[0] + xn[1] * xn[1]) + (xn[2] * xn[2] + xn[3] * xn[3]);
            ss += shx(ss, 1, lane); ss += shx(ss, 2, lane); ss += shx(ss, 4, lane); ss += shx(ss, 8, lane);
            if (c4 == 0) unsafeAtomicAdd(R.SS + row, ss); }
        if (R.A1) { const f32x4 a = xn * *(const f32x4*)(R.g1 + b * D + col); u32x2 w; w.x = pk_bf16(a[0], a[1]); w.y = pk_bf16(a[2], a[3]); *(u32x2*)(R.A1 + (size_t)row * D + col) = w; }
        if (R.A2) { const f32x4 a = xn * *(const f32x4*)(R.g2 + b * D + col); u32x2 w; w.x = pk_bf16(a[0], a[1]); w.y = pk_bf16(a[2], a[3]); *(u32x2*)(R.A2 + (size_t)row * D + col) = w; }
    } else {
        const int d = 4 * c4, phys = 256 * (ct >> 2) + 32 * (ct & 3) + 128 * (d >> 5) + (d & 31);
        const float rs = pg8::rstd_of(H.SS[row]);
        f32x4 q = v * rs + *(const f32x4*)(H.bias + (size_t)b * D + phys);
        float ss = (q[0] * q[0] + q[1] * q[1]) + (q[2] * q[2] + q[3] * q[3]);
        ss += shx(ss, 1, lane); ss += shx(ss, 2, lane); ss += shx(ss, 4, lane); ss += shx(ss, 8, lane);
        const float hr = 1.0f / sqrtf(ss * (1.0f / HD) + EPS);
        q = q * (hr * H.oscale) * *(const f32x4*)(H.gvec + d);
        u32x2 w; w.x = pk_bf16(q[0], q[1]); w.y = pk_bf16(q[2], q[3]); *(u32x2*)(H.O + (size_t)row * D + 64 * ct + d) = w;
    }
    LDS_WAIT(); __syncthreads();
}
}

namespace att {
constexpr int SLOTB = 8192;
constexpr int L_K = 0, L_V = 3 * SLOTB, L_WS = 6 * SLOTB, L_OST = L_WS + 8 * 256, L_BYTES = L_OST + 8 * 4096;
constexpr float LOG2E = 1.4426950408889634f, C2 = 0.125f * LOG2E, NEG = -1e30f;
__device__ __forceinline__ int crow(int r, int hi) { return (r & 3) + 8 * (r >> 2) + 4 * hi; }
typedef short v4i16_t __attribute__((ext_vector_type(4)));
__device__ __forceinline__ s16x4 vtr(const LAS unsigned char* p) { return __builtin_bit_cast(s16x4, __builtin_amdgcn_ds_read_tr16_b64_v4i16((LAS v4i16_t*)p)); }

__device__ __forceinline__ void attn_unit(LAS unsigned char* lds, const int tid, int bidx, int c, int g, const bf16_t* Q, bf16_t* O, const bf16_t* Kb, const bf16_t* Vb, const bf16_t* KC, const bf16_t* VC, const float* sinks, unsigned* cnt, int wseam, int pseam) {
    const int lane = tid & 63, r32 = lane & 31, hi = lane >> 5; const int wid = __builtin_amdgcn_readfirstlane(tid >> 6);
    int row0, nq; const bf16_t* kp[3]; const bf16_t* vp[3]; int nv[3];
    if (bidx < NBP) {
        row0 = bidx * SEQ + 64 * c; nq = 64;
#pragma unroll
        for (int s = 0; s < 3; ++s) { const int tc = c - 2 + s; nv[s] = tc >= 0 ? 64 : 0; const int tcc = tc >= 0 ? tc : 0; kp[s] = Kb + (size_t)(bidx * SEQ + 64 * tcc) * KVD; vp[s] = Vb + (size_t)(bidx * SEQ + 64 * tcc) * KVD; }
    } else {
        const int bs = bidx - NBP; row0 = MP + bs * LS; nq = LS;
        kp[0] = KC + (size_t)(bs * WIN) * KVD; kp[1] = kp[0] + 64 * KVD; kp[2] = Kb + (size_t)row0 * KVD;
        vp[0] = VC + (size_t)(bs * WIN) * KVD; vp[1] = vp[0] + 64 * KVD; vp[2] = Vb + (size_t)row0 * KVD;
        nv[0] = 64; nv[1] = 64; nv[2] = LS;
    }
    const int panel = row0 >> 8;
    if (wseam >= 0) {
        if (wid == 0) { pg8::dep_poll(cnt, wseam, panel, 32u); __builtin_amdgcn_fence(__ATOMIC_ACQUIRE, "agent"); asm volatile("s_waitcnt vmcnt(0)" ::: "memory"); }
        asm volatile("" ::: "memory"); __builtin_amdgcn_s_barrier(); asm volatile("" ::: "memory");
    }
#pragma unroll
    for (int s = 0; s < 3; ++s) if (nv[s] > 0) {
        const bf16_t* ks = kp[s] + (size_t)lane * KVD + g * HD + wid * 8;
        const bf16_t* vs = vp[s] + (size_t)(16 * (wid & 3) + (lane >> 2)) * KVD + g * HD + (wid >> 2) * 32 + (lane & 3) * 8;
        __builtin_amdgcn_global_load_lds((const unsigned*)ks, (LAS unsigned*)(lds + L_K + s * SLOTB + wid * 1024), 16, 0, 0);
        __builtin_amdgcn_global_load_lds((const unsigned*)vs, (LAS unsigned*)(lds + L_V + s * SLOTB + wid * 1024), 16, 0, 0);
    }
    const int head = 4 * g + (wid >> 1), qoff = 32 * (wid & 1);
    const bf16_t* Qw = Q + (size_t)(row0 + qoff + r32) * D + head * HD + hi * 8;
    bf16x8 qr[4];
#pragma unroll
    for (int d0 = 0; d0 < 4; ++d0) qr[d0] = *(const bf16x8*)(Qw + d0 * 16);
    const float sink2 = sinks[head] * LOG2E;
    asm volatile("s_waitcnt vmcnt(0)" ::: "memory"); __builtin_amdgcn_s_barrier(); asm volatile("" ::: "memory");
    f32x16 p[3][2];
    float mx = sink2;
#pragma unroll
    for (int s = 0; s < 3; ++s) if (nv[s] > 0) {
        const LAS unsigned char* kb = lds + L_K + s * SLOTB + hi * 1024 + r32 * 16;
        f32x16 p0 = {}, p1 = {};
#pragma unroll
        for (int d0 = 0; d0 < 4; ++d0) {
            const bf16x8 b0 = *(const LAS bf16x8*)(kb + d0 * 2048), b1 = *(const LAS bf16x8*)(kb + d0 * 2048 + 512);
            p0 = __builtin_amdgcn_mfma_f32_32x32x16_bf16(b0, qr[d0], p0, 0, 0, 0); p1 = __builtin_amdgcn_mfma_f32_32x32x16_bf16(b1, qr[d0], p1, 0, 0, 0);
        }
        if (nv[s] < 64) {
#pragma unroll
            for (int r = 0; r < 16; ++r) { const int kv = crow(r, hi); if (kv >= nv[s]) p0[r] = NEG; if (kv + 32 >= nv[s]) p1[r] = NEG; }
        }
#pragma unroll
        for (int r = 0; r < 16; ++r) mx = fmaxf(mx, fmaxf(p0[r], p1[r]));
        p[s][0] = p0; p[s][1] = p1;
    }
    mx = fmaxf(mx, shx(mx, 32, lane));
    float l = 0.f;
    u32x4 pw[3][4];
#pragma unroll
    for (int s = 0; s < 3; ++s) if (nv[s] > 0) {
#pragma unroll
        for (int h2 = 0; h2 < 2; ++h2) {
            f32x16 e;
#pragma unroll
            for (int r = 0; r < 16; ++r) { e[r] = __builtin_amdgcn_exp2f(p[s][h2][r] - mx); l += e[r]; }
#pragma unroll
            for (int q = 0; q < 2; ++q) { u32x4 w; w.x = pk_bf16(e[8 * q], e[8 * q + 1]); w.y = pk_bf16(e[8 * q + 2], e[8 * q + 3]); w.z = pk_bf16(e[8 * q + 4], e[8 * q + 5]); w.w = pk_bf16(e[8 * q + 6], e[8 * q + 7]); pw[s][2 * h2 + q] = w; }
        }
    }
    l += shx(l, 32, lane);
    l += __builtin_amdgcn_exp2f(sink2 - mx);
    f32x16 o[2]; o[0] = f32x16{}; o[1] = f32x16{};
    const LAS unsigned char* vb0 = lds + L_V + ((lane >> 4) & 1) * 32 + (lane & 3) * 8 + (4 * hi + ((lane & 15) >> 2)) * 64;
#pragma unroll
    for (int s = 0; s < 3; ++s) if (nv[s] > 0) {
#pragma unroll
        for (int ks = 0; ks < 4; ++ks) {
            const bf16x8 pa = __builtin_bit_cast(bf16x8, pw[s][ks]);
#pragma unroll
            for (int d0 = 0; d0 < 2; ++d0) {
                const s16x4 lo = vtr(vb0 + s * SLOTB + d0 * 4096 + ks * 1024), hh = vtr(vb0 + s * SLOTB + d0 * 4096 + ks * 1024 + 512);
                const bf16x8 vf = (bf16x8){lo[0], lo[1], lo[2], lo[3], hh[0], hh[1], hh[2], hh[3]};
                o[d0] = __builtin_amdgcn_mfma_f32_32x32x16_bf16(pa, vf, o[d0], 0, 0, 0);
            }
        }
        __builtin_amdgcn_sched_barrier(0);
    }
    LAS float* wsf = (LAS float*)(lds + L_WS) + wid * 64;
    if (hi == 0) wsf[r32] = l;
    LDS_WAIT();
    float rli[16];
#pragma unroll
    for (int r = 0; r < 16; ++r) rli[r] = __builtin_amdgcn_rcpf(wsf[crow(r, hi)]);
    LAS bf16_t* stg = (LAS bf16_t*)(lds + L_OST) + wid * 2048;
#pragma unroll
    for (int r = 0; r < 16; ++r) { const int orow = crow(r, hi);
#pragma unroll
        for (int d0 = 0; d0 < 2; ++d0) stg[orow * 64 + d0 * 32 + r32] = (bf16_t)(pk_bf16(o[d0][r] * rli[r], 0.f) & 0xffffu); }
    LDS_WAIT();
    const rsrc_t rw = mk_rsrc((const unsigned char*)O - WS_AB, (unsigned)WS_END);
#pragma unroll
    for (int i = 0; i < 4; ++i) { const int row = i * 8 + (lane >> 3), ch = lane & 7; const u32x4 v = *(const LAS u32x4*)(stg + row * 64 + ch * 8);
        if (qoff + row < nq) st16_wt(rw, (unsigned)WS_AB + ((unsigned)(row0 + qoff + row) * D + head * HD + ch * 8) * 2, v); }
    if (pseam >= 0) pg8::dep_publish(cnt, pseam, panel, lane);
    asm volatile("s_waitcnt lgkmcnt(0)" ::: "memory"); __builtin_amdgcn_s_barrier(); asm volatile("" ::: "memory");
}
}

constexpr int NWAVES = 8;
constexpr int RING_BYTES = 131072, LDSCTL_OFF = RING_BYTES, MISC_OFF = LDSCTL_OFF + 320, XIN_OFF = LDSCTL_OFF + 512, LDS_BYTES = 147456;

#define XB_TMO      128
#define XB_XCNT(j)  (256  + 64 * (j))
#define XB_XSUB(j)  (1280 + 64 * (j))
#define XB_XGEN(j)  (2304 + 64 * (j))
#define XB_TOP      3328
#define XB_TOPGEN   3392
#define XCD_BAR_WORDS 3456
#define XB_SPIN_CAP (1u << 18)
__device__ __forceinline__ unsigned xb_ld(unsigned* p)              { return __hip_atomic_load(p, __ATOMIC_RELAXED, __HIP_MEMORY_SCOPE_AGENT); }
__device__ __forceinline__ unsigned xb_add(unsigned* p, unsigned v) { return __hip_atomic_fetch_add(p, v, __ATOMIC_RELAXED, __HIP_MEMORY_SCOPE_AGENT); }
__device__ __forceinline__ unsigned xb_xcc_id() { return (unsigned)__builtin_amdgcn_s_getreg((3 << 11) | 20) & 0xFu; }
#define XB_SPIN(cond, bar) do { unsigned _sp = 0; while (cond) { __builtin_amdgcn_s_sleep(1); \
    if ((++_sp & 255u) == 0u) { if (xb_ld(&(bar)[XB_TMO])) break; if (_sp > XB_SPIN_CAP) { atomicAdd(&(bar)[XB_TMO], 1u); break; } } } } while (0)
struct XcdBarrier { unsigned* bar; unsigned x; volatile LAS unsigned* st; };
__device__ __forceinline__ XcdBarrier xcd_barrier_post(unsigned* bar, volatile LAS unsigned* st) {
    XcdBarrier b; b.bar = bar; b.x = xb_xcc_id(); b.st = st;
    if (threadIdx.x == 0) (void)xb_add(&bar[XB_XCNT(b.x)], 1u);
    return b;
}
__device__ __forceinline__ void xcd_barrier_complete(unsigned* bar, unsigned x, unsigned& nloc, unsigned& nx) {
    const unsigned G = gridDim.x * gridDim.y * gridDim.z;
    unsigned sum, cnt, mine, sp = 0u;
    for (;;) {
        sum = 0u; cnt = 0u; mine = 0u;
#pragma unroll
        for (unsigned j = 0; j < 16; ++j) { const unsigned c = xb_ld(&bar[XB_XCNT(j)]); sum += c; cnt += (c > 0u) ? 1u : 0u; mine = (j == x) ? c : mine; }
        if (sum == G) break;
        __builtin_amdgcn_s_sleep(1);
        if ((++sp & 255u) == 0u) { if (xb_ld(&bar[XB_TMO])) break; if (sp > XB_SPIN_CAP) { atomicAdd(&bar[XB_TMO], 1u); break; } }
    }
    nloc = mine > 0u ? mine : 1u; nx = cnt > 0u ? cnt : 1u;
}
__device__ __forceinline__ void xcd_barrier(const XcdBarrier& b, const int tid) {
    asm volatile("s_waitcnt vmcnt(0)" ::: "memory");
    __syncthreads();
    if (tid == 0) {
        unsigned* bar = b.bar;
        __builtin_amdgcn_s_waitcnt(0);
        unsigned nloc = b.st[0], nx = b.st[1];
        if (nloc == 0u) { xcd_barrier_complete(bar, b.x, nloc, nx); b.st[0] = nloc; b.st[1] = nx; }
        const unsigned old = xb_add(&bar[XB_XSUB(b.x)], 1u);
        const unsigned gen = old / nloc;
        if (old + 1u == (gen + 1u) * nloc) {
            __builtin_amdgcn_fence(__ATOMIC_RELEASE, "agent");
            asm volatile("s_waitcnt vmcnt(0)" ::: "memory");
            const unsigned og = xb_add(&bar[XB_TOP], 1u);
            const unsigned tg = og / nx;
            if (og + 1u == (tg + 1u) * nx) xb_add(&bar[XB_TOPGEN], 1u);
            else XB_SPIN(xb_ld(&bar[XB_TOPGEN]) == tg, bar);
            __builtin_amdgcn_fence(__ATOMIC_ACQUIRE, "agent");
            xb_add(&bar[XB_XGEN(b.x)], 1u);
            asm volatile("s_waitcnt vmcnt(0)" ::: "memory");
        } else {
            XB_SPIN(xb_ld(&bar[XB_XGEN(b.x)]) == gen, bar);
            __builtin_amdgcn_fence(__ATOMIC_ACQUIRE, "agent");
            asm volatile("s_waitcnt vmcnt(0)" ::: "memory");
        }
    }
    __syncthreads();
}

struct Args { const float* in[24]; float* out; unsigned char* ws; int ph_lo, ph_hi; };

struct Frame {
    LAS unsigned char* lds; int tid, lane, wave, vcu, G;
    float* out; unsigned char* ws;
};
#define FIN(i) (args.in[i])

__device__ __forceinline__ void transpose_item(const float* W, int ldn, int K, int k0, int s0, bf16_t* WT, int p0, LAS float* scr, int lane) {
    float wv[32];
    const float* wp = W + (size_t)(k0 + (lane >> 5)) * ldn + s0 + (lane & 31);
#pragma unroll
    for (int i = 0; i < 32; ++i) wv[i] = wp[(size_t)(2 * i) * ldn];
#pragma unroll
    for (int i = 0; i < 32; ++i) scr[(2 * i + (lane >> 5)) * 33 + (lane & 31)] = wv[i];
    LDS_WAIT(); asm volatile("" ::: "memory");
    const int c = lane & 7;
#pragma unroll
    for (int j = 0; j < 4; ++j) { const int n = (lane >> 3) + 8 * j; const LAS float* s = scr + (8 * c) * 33 + n;
        u32x4 o; o.x = pk_bf16(s[0 * 33], s[1 * 33]); o.y = pk_bf16(s[2 * 33], s[3 * 33]); o.z = pk_bf16(s[4 * 33], s[5 * 33]); o.w = pk_bf16(s[6 * 33], s[7 * 33]);
        *(u32x4*)(WT + (size_t)(p0 + n) * K + k0 + 8 * c) = o; }
    LDS_WAIT(); asm volatile("" ::: "memory");
}
__device__ __forceinline__ int headperm_src(int p0) { const int pn = p0 >> 8, bj = (p0 >> 7) & 1, wc = (p0 >> 5) & 3; return (4 * pn + wc) * HD + 32 * bj; }
__device__ __forceinline__ int swiglu_src(int p0) { const int pn = p0 >> 8, bj = (p0 >> 7) & 1, r = p0 & 127; return bj * DFF + 128 * pn + r; }

constexpr int CV_POOL = 2 * 4 * 4 * 8, CV_WQ = 2 * 16 * 32, CV_WO = 2 * 16 * 32, CV_WKV = 16 * 16, CV_WIN = 4 * 16 * 176, CV_WOUT = 4 * 44 * 32;
constexpr int CV_TOTAL = CV_POOL + CV_WQ + CV_WO + CV_WKV + CV_WIN + CV_WOUT;

__device__ __forceinline__ void convert_item(Frame& F, const Args& args, int it, LAS float* scr) {
    unsigned char* ws = F.ws;
    if (it < CV_POOL) {
        const int lg = it >> 5, r = it & 31, kb = r >> 3, nb = r & 7;
        transpose_item(FIN(11) + (size_t)lg * 65536, 256, 256, 64 * kb, 32 * nb, (bf16_t*)(ws + WS_WPOOL) + (size_t)lg * 65536, 32 * nb, scr, F.lane); return; }
    it -= CV_POOL;
    if (it < CV_WQ) { const int j = it >> 9, r = it & 511, kb = r >> 5, nb = r & 31;
        transpose_item(FIN(13) + (size_t)j * D * D, D, D, 64 * kb, headperm_src(32 * nb), (bf16_t*)(ws + WS_WQ) + (size_t)j * D * D, 32 * nb, scr, F.lane); return; }
    it -= CV_WQ;
    if (it < CV_WO) { const int j = it >> 9, r = it & 511, kb = r >> 5, nb = r & 31;
        transpose_item(FIN(16) + (size_t)j * D * D, D, D, 64 * kb, 32 * nb, (bf16_t*)(ws + WS_WO) + (size_t)j * D * D, 32 * nb, scr, F.lane); return; }
    it -= CV_WO;
    if (it < CV_WKV) { const int kb = it >> 4, nb = it & 15;
        transpose_item(FIN(20), 2 * KVD, D, 64 * kb, headperm_src(32 * nb), (bf16_t*)(ws + WS_WKV), 32 * nb, scr, F.lane); return; }
    it -= CV_WKV;
    if (it < CV_WIN) { const int l = it / (16 * 176), r = it % (16 * 176), kb = r / 176, nb = r % 176;
        transpose_item(FIN(22) + (size_t)l * D * NIN, NIN, D, 64 * kb, swiglu_src(32 * nb), (bf16_t*)(ws + WS_WIN) + (size_t)l * NIN * D, 32 * nb, scr, F.lane); return; }
    it -= CV_WIN;
    { const int l = it / (44 * 32), r = it % (44 * 32), kb = r >> 5, nb = r & 31;
        transpose_item(FIN(23) + (size_t)l * DFF * D, D, DFF, 64 * kb, 32 * nb, (bf16_t*)(ws + WS_WOUT) + (size_t)l * D * DFF, 32 * nb, scr, F.lane); }
}

constexpr int ADA_ITEMS = 4 * 48 + 16;
__device__ __forceinline__ void ada_item(Frame& F, const Args& args, int it) {
    LAS float* CA = (LAS float*)F.lds;
    LAS float* RED = (LAS float*)(F.lds + 49152);
    const float* W; const float* bias; float* out; int ldn, n0, ostride;
    if (it < 192) { const int l = it / 48; n0 = (it % 48) * 128; W = FIN(7) + (size_t)l * D * ADAW; ldn = ADAW; bias = FIN(8) + l * ADAW; out = (float*)(F.ws + WS_ADA) + (size_t)l * NBATCH * ADAW; ostride = ADAW; }
    else { n0 = (it - 192) * 128; W = FIN(18); ldn = 2 * D; bias = FIN(19); out = (float*)(F.ws + WS_ADAKV); ostride = 2 * D; }
    for (int idx = F.tid; idx < NBATCH * D; idx += NWAVES * 64) { const int b = idx >> 10, k = idx & 1023;
        const float c = b < NBP ? FIN(2)[b * D + k] : FIN(3)[(b - NBP) * D + k]; CA[k * 12 + b] = c / (1.0f + __expf(-c)); }
    LDS_WAIT(); __syncthreads();
    f32x2 acc[NBATCH];
#pragma unroll
    for (int b = 0; b < NBATCH; ++b) acc[b] = (f32x2){0.f, 0.f};
    const float* wp = W + (size_t)(F.wave * 128) * ldn + n0 + 2 * F.lane;
#pragma unroll 32
    for (int k = 0; k < 128; ++k) {
        const f32x2 wv = *(const f32x2*)(wp + (size_t)k * ldn);
        const LAS f32x4* cp = (const LAS f32x4*)(CA + (F.wave * 128 + k) * 12);
        const f32x4 c0 = cp[0], c1 = cp[1], c2 = cp[2];
        acc[0] += wv * c0[0]; acc[1] += wv * c0[1]; acc[2] += wv * c0[2]; acc[3] += wv * c0[3]; acc[4] += wv * c1[0];
        acc[5] += wv * c1[1]; acc[6] += wv * c1[2]; acc[7] += wv * c1[3]; acc[8] += wv * c2[0]; acc[9] += wv * c2[1];
    }
#pragma unroll
    for (int b = 0; b < NBATCH; ++b) *(LAS f32x2*)(RED + (F.wave * NBATCH + b) * 128 + 2 * F.lane) = acc[b];
    LDS_WAIT(); __syncthreads();
    for (int idx = F.tid; idx < NBATCH * 128; idx += NWAVES * 64) { const int b = idx >> 7, c = idx & 127; float s = bias[n0 + c];
#pragma unroll
        for (int w = 0; w < NWAVES; ++w) s += RED[(w * NBATCH + b) * 128 + c];
        out[(size_t)b * ostride + n0 + c] = s; }
    LDS_WAIT(); __syncthreads();
}

constexpr int BI_WIN = 4 * 44, BI_WQ = 2 * 8, BI_WKV = 4, BI_TOTAL = BI_WIN + BI_WQ + BI_WKV, SHP = D + 8;
__device__ __forceinline__ void bias_item(Frame& F, int it) {
    LAS bf16_t* SH = (LAS bf16_t*)F.lds;
    const bf16_t* W; const float* sh; int shs; float* out; int os, r0;
    if (it < BI_WIN) { const int l = it / 44; r0 = (it % 44) * 128; W = (const bf16_t*)(F.ws + WS_WIN) + (size_t)l * NIN * D; sh = (const float*)(F.ws + WS_ADA) + (size_t)l * NBATCH * ADAW + 3 * D; shs = ADAW;
        out = (float*)(F.ws + WS_BIN) + (size_t)l * NBATCH * NIN; os = NIN; }
    else if (it < BI_WIN + BI_WQ) { const int j = (it - BI_WIN) >> 3; r0 = ((it - BI_WIN) & 7) * 128; W = (const bf16_t*)(F.ws + WS_WQ) + (size_t)j * D * D; sh = (const float*)(F.ws + WS_ADA) + (size_t)(2 + j) * NBATCH * ADAW; shs = ADAW;
        out = (float*)(F.ws + WS_BQ) + (size_t)j * NBATCH * D; os = D; }
    else { r0 = (it - BI_WIN - BI_WQ) * 128; W = (const bf16_t*)(F.ws + WS_WKV); sh = (const float*)(F.ws + WS_ADAKV); shs = 2 * D; out = (float*)(F.ws + WS_BKV); os = 2 * KVD; }
    const bf16_t* wp = W + (size_t)(r0 + F.wave * 16 + (F.lane & 15)) * D + 8 * (F.lane >> 4);
    bf16x8 wf[32];
#pragma unroll
    for (int s_ = 0; s_ < 32; ++s_) wf[s_] = *(const bf16x8*)(wp + 32 * s_);
    for (int idx = F.tid; idx < 16 * D; idx += NWAVES * 64) { const int b = idx >> 10, k = idx & 1023; SH[b * SHP + k] = b < NBATCH ? (bf16_t)(pk_bf16(sh[(size_t)b * shs + k], 0.f) & 0xffffu) : (bf16_t)0; }
    LDS_WAIT(); __syncthreads();
    f32x4 acc = {0.f, 0.f, 0.f, 0.f};
    const LAS bf16_t* sp = SH + (F.lane & 15) * SHP + 8 * (F.lane >> 4);
#pragma unroll
    for (int s_ = 0; s_ < 32; ++s_) acc = __builtin_amdgcn_mfma_f32_16x16x32_bf16(*(const LAS bf16x8*)(sp + 32 * s_), wf[s_], acc, 0, 0, 0);
#pragma unroll
    for (int j = 0; j < 4; ++j) { const int b = 4 * (F.lane >> 4) + j; if (b < NBATCH) out[(size_t)b * os + r0 + F.wave * 16 + (F.lane & 15)] = acc[j]; }
    LDS_WAIT(); __syncthreads();
}

constexpr int PP_ITEMS = 2 * 128 + NBS;
__device__ __forceinline__ void pool_prep_item(Frame& F, const Args& args, int layer, int item, const float* xsrc_p, const float* xsrc_s, int pub_seam) {
    LAS float* RS = (LAS float*)F.lds;
    int bidx, t0, nrows, L, pos0, grow0; const float* xb; const float* hist; float* pout;
    if (item < 256) { bidx = item >> 7; t0 = (item & 127) * 64; nrows = 64; L = SEQ; pos0 = 0; grow0 = bidx * SEQ; xb = xsrc_p + (size_t)grow0 * D; hist = nullptr;
        pout = F.out + O_POOLP + (size_t)(layer * NBP + bidx) * PH * D; }
    else { const int bs = item - 256; bidx = NBP + bs; t0 = 0; nrows = LS; L = LS; pos0 = 4096; grow0 = MP + bs * LS; xb = xsrc_s + (size_t)(bs * LS) * D; hist = FIN(4) + (size_t)(layer * NBS + bs) * PH * D;
        pout = F.out + O_POOLS + (size_t)(layer * NBS + bs) * PH * D; }
    if (layer == 1) {
        const float* rss = (const float*)(F.ws + WS_SS) + (size_t)1 * MPAD + grow0;
        for (int e = F.tid; e < 15 + nrows; e += NWAVES * 64) { const int t = t0 - 15 + e; if (t >= 0) RS[e] = 1.0f / sqrtf(rss[t] * (1.0f / D) + EPS); }
    } else
    for (int e0 = F.wave; e0 < 15 + nrows; e0 += 5 * NWAVES) {
        f32x4 v[5][4];
#pragma unroll
        for (int q = 0; q < 5; ++q) { const int e = e0 + q * NWAVES, t = t0 - 15 + e; const bool ok = (e < 15 + nrows) && t >= 0; const f32x4* xr = (const f32x4*)(xb + (size_t)(ok ? t : t0) * D) + F.lane;
#pragma unroll
            for (int j = 0; j < 4; ++j) v[q][j] = xr[64 * j]; }
#pragma unroll
        for (int q = 0; q < 5; ++q) { const int e = e0 + q * NWAVES, t = t0 - 15 + e; float s_ = 0.f;
#pragma unroll
            for (int j = 0; j < 4; ++j) s_ += (v[q][j][0] * v[q][j][0] + v[q][j][1] * v[q][j][1]) + (v[q][j][2] * v[q][j][2] + v[q][j][3] * v[q][j][3]);
            s_ = wave_sum(s_, F.lane); if (F.lane == 0 && e < 15 + nrows && t >= 0) RS[e] = 1.0f / sqrtf(s_ * (1.0f / D) + EPS); }
    }
    LDS_WAIT(); __syncthreads();
    const int g = F.wave & 3, rh = F.wave >> 2, w = 2 << g, col = 256 * g + 4 * F.lane;
    if (32 * rh < nrows) {
        const float* ada = (const float*)(F.ws + WS_ADA) + ((size_t)layer * NBATCH + bidx) * ADAW;
        const f32x4 gm = *(const f32x4*)(FIN(9) + layer * D + col) * (*(const f32x4*)(ada + D + col) + 1.0f);
        const f32x4 sh = *(const f32x4*)(ada + col);
        const int tb = t0 + 32 * rh;
        const rsrc_t rw = mk_rsrc(F.ws, (unsigned)WS_END);
        const unsigned dout = (unsigned)WS_AB + ((unsigned)grow0 * D + col) * 2;
        f32x4 ring[16];
        ring[0] = (f32x4){0.f, 0.f, 0.f, 0.f};
#pragma unroll
        for (int j = 1; j < 16; ++j) { const int t = tb - 16 + j;
            if (t >= 0) ring[j] = *(const f32x4*)(xb + (size_t)t * D + col) * RS[t - (t0 - 15)] * gm + sh;
            else if (hist) ring[j] = *(const f32x4*)(hist + (size_t)(15 + t) * D + col);
            else ring[j] = (f32x4){0.f, 0.f, 0.f, 0.f}; }
#pragma unroll
        for (int blk = 0; blk < 2; ++blk) if (32 * rh + 16 * blk < nrows) {
#pragma unroll
            for (int jj = 0; jj < 16; ++jj) { const int t = tb + 16 * blk + jj;
                const f32x4 h = *(const f32x4*)(xb + (size_t)t * D + col) * RS[t - (t0 - 15)] * gm + sh;
                ring[jj] = h;
                f32x4 s = ring[jj] + ring[(jj + 15) & 15];
                if (w > 2) { s += ring[(jj + 14) & 15] + ring[(jj + 13) & 15];
                    if (w > 4) { s += (ring[(jj + 12) & 15] + ring[(jj + 11) & 15]) + (ring[(jj + 10) & 15] + ring[(jj + 9) & 15]);
                        if (w > 8) s += ((ring[(jj + 8) & 15] + ring[(jj + 7) & 15]) + (ring[(jj + 6) & 15] + ring[(jj + 5) & 15])) + ((ring[(jj + 4) & 15] + ring[(jj + 3) & 15]) + (ring[(jj + 2) & 15] + ring[(jj + 1) & 15])); } }
                const int cnt = min(w, pos0 + t + 1);
                const f32x4 d = s * (1.0f / (float)cnt) - h;
                u32x2 o; o.x = pk_bf16(d[0], d[1]); o.y = pk_bf16(d[2], d[3]);
                st8_wt(rw, dout + (unsigned)t * D * 2, o);
                if (t >= L - PH) *(f32x4*)(pout + (size_t)(t - (L - PH)) * D + col) = h; }
        }
    }
    if (pub_seam >= 0) pg8::dep_publish((unsigned*)(F.ws + WS_CTL) + CW_CNT, pub_seam, (grow0 + t0) >> 8, F.lane);
    LDS_WAIT(); __syncthreads();
}

__device__ __forceinline__ void ttable_item(Frame& F, const Args& args, int id) {
    const float* ADA = (const float*)(F.ws + WS_ADA); const float* ADAKV = (const float*)(F.ws + WS_ADAKV);
    float* T = (float*)(F.ws + WS_T) + (size_t)id * TV;
    for (int idx = F.tid; idx < TV; idx += NWAVES * 64) { const int b = idx >> 10, c = idx & 1023; float v;
        if (id < T_GAINF) { const int l = id - T_GATE1; v = ADA[((size_t)l * NBATCH + b) * ADAW + 2 * D + c]; if (l < 2) v *= FIN(12)[l * D + c]; }
        else if (id < T_GATE2) { const int l = id - T_GAINF; v = FIN(10)[l * D + c] * (1.0f + ADA[((size_t)l * NBATCH + b) * ADAW + 4 * D + c]); }
        else if (id < T_GAINQ) { const int l = id - T_GATE2; v = ADA[((size_t)l * NBATCH + b) * ADAW + 5 * D + c]; }
        else if (id < T_GAINKV) { const int l = 2 + id - T_GAINQ; v = FIN(9)[l * D + c] * (1.0f + ADA[((size_t)l * NBATCH + b) * ADAW + D + c]); }
        else v = FIN(17)[c] * (1.0f + ADAKV[(size_t)b * 2 * D + D + c]);
        T[idx] = v; }
}

#ifndef PH_MASK
#define PH_MASK 0x7ffff
#endif
__global__ void __launch_bounds__(NWAVES * 64, 2) yoco_fwd(Args args) {
    extern __shared__ __attribute__((aligned(16))) unsigned char lds_raw[];
    Frame F;
    F.lds = (LAS unsigned char*)lds_raw;
    F.tid = 0; F.lane = 0; F.wave = __builtin_amdgcn_readfirstlane((int)threadIdx.x >> 6);
    F.G = gridDim.x; { const int bx = blockIdx.x; int v_ = ((F.G & 7) == 0) ? (bx & 7) * (F.G >> 3) + (bx >> 3) : bx; asm volatile("" : "+s"(v_)); F.vcu = v_; }
    F.out = args.out; F.ws = args.ws;
    for (int u = threadIdx.x; u < (LDS_BYTES - LDSCTL_OFF) / 4; u += NWAVES * 64) ((LAS unsigned*)(F.lds + LDSCTL_OFF))[u] = 0u;
    __syncthreads();
    if (threadIdx.x == 0) { ((LAS unsigned long long*)(F.lds + XIN_OFF))[0] = (unsigned long long)FIN(0); ((LAS unsigned long long*)(F.lds + XIN_OFF))[1] = (unsigned long long)(FIN(1) - (size_t)MP * D); }
    __syncthreads();
    const int lo = args.ph_lo, hi = args.ph_hi;
    XcdBarrier bar; bar.bar = (unsigned*)(args.ws + WS_CTL) + CW_BAR; bar.x = 0; bar.st = nullptr;
    if (hi - lo > 1) bar = xcd_barrier_post((unsigned*)(args.ws + WS_CTL) + CW_BAR, (volatile LAS unsigned*)(F.lds + MISC_OFF) + 8);
#define WSP(T_, off) ((T_*)(wsl + (off)))
#pragma unroll 1
    for (int ph = lo; ph < hi; ++ph) {
        unsigned char* wsl = F.ws; asm volatile("" : "+s"(wsl));
        int lanel; asm volatile("v_mbcnt_lo_u32_b32 %0, -1, 0\n\tv_mbcnt_hi_u32_b32 %0, -1, %0" : "=v"(lanel));
        const int tidl = F.wave * 64 + lanel;
        Frame Fp = F; Fp.tid = tidl; Fp.lane = lanel; Fp.ws = wsl;
        const int layer = ph < 6 ? 0 : ph < 10 ? 1 : ph < 15 ? 2 : 3;
        int Gp = F.G; asm volatile("" : "+s"(Gp));
        unsigned* cnt = WSP(unsigned, WS_CTL) + CW_CNT;
        const bool solo = true;
        const int krot = ph == 7 ? 19 : ph == 12 ? 6 : ph == 17 ? 25 : ph == 2 ? 1 : ph == 4 ? 2 : ph == 6 ? 3 : ph == 8 ? 4 : ph == 9 ? 5 : ph == 11 ? 6 : ph == 13 ? 7 : ph == 14 ? 8 : ph == 16 ? 9 : ph == 18 ? 10 : 0;
        int crot = (int)blockIdx.x; asm volatile("" : "+s"(crot)); (void)krot;
        pg8::DepOrder S; S.cnt = cnt; S.wseam = -1; S.pseam = -1; S.need_p = 0; S.need_s = 0; S.wait_next = 0; S.last_pm = -1;
#define PHQ(k) (ph == (k) && ((PH_MASK >> (k)) & 1))
        if (PHQ(0)) {
            for (int it = F.vcu; it < ADA_ITEMS; it += F.G) ada_item(Fp, args, it);
            LAS float* scr = (LAS float*)(Fp.lds + Fp.wave * 16384);
            const int gw = F.vcu * NWAVES + Fp.wave, NGW = F.G * NWAVES;
            for (int it = gw; it < CV_TOTAL; it += NGW) convert_item(Fp, args, it, scr);
            const int gt = F.vcu * NWAVES * 64 + Fp.tid, NGT = F.G * NWAVES * 64;
            for (int i = gt; i < (RSS_N + 1) * MPAD / 4; i += NGT) WSP(f32x4, WS_SS)[i] = (f32x4){0.f, 0.f, 0.f, 0.f};
            for (int i = gt; i < 2 * NBS * WIN * KVD / 4; i += NGT) {
                const int which = i >= NBS * WIN * KVD / 4, j = which ? i - NBS * WIN * KVD / 4 : i;
                const f32x4 v = ((const f32x4*)(which ? FIN(6) : FIN(5)))[j];
                u32x2 o; o.x = pk_bf16(v[0], v[1]); o.y = pk_bf16(v[2], v[3]);
                (which ? WSP(u32x2, WS_VC) : WSP(u32x2, WS_KC))[j] = o;
                const int e = j * 4, bs = e / (WIN * KVD), r = (e / KVD) % WIN, cidx = e % KVD;
                if (r >= LS) *(f32x4*)(F.out + (which ? O_VS : O_KS) + ((size_t)bs * WIN + (r - LS)) * KVD + cidx) = v;
            }
        } else if (PHQ(1)) {
            for (int it = F.vcu; it < PP_ITEMS; it += F.G) pool_prep_item(Fp, args, 0, it, FIN(0), FIN(1), -1);
            for (int it = F.G - 1 - F.vcu; it < BI_TOTAL + T_NVEC; it += F.G) { if (it < BI_TOTAL) bias_item(Fp, it); else ttable_item(Fp, args, it - BI_TOTAL); }
        } else if (PHQ(5)) {
            for (int it = F.vcu; it < PP_ITEMS; it += F.G) pool_prep_item(Fp, args, 1, it, F.out, F.out + (size_t)MP * D, solo ? -1 : 5);
        } else if (PHQ(2)) {
            int kp = 256; asm volatile("" : "+s"(kp));
            const float* Tt = WSP(const float, WS_T);
            if (F.vcu < 64) { sk::Gemm sg{WSP(const bf16_t, WS_AB), D, 1, WSP(const bf16_t, WS_WPOOL), 256, 0};
                sk::Res sr{FIN(1), F.out, Tt + (T_GATE1 + 0) * TV, Tt + (T_GAINF + 0) * TV, nullptr, WSP(bf16_t, WS_AQ), nullptr, WSP(float, WS_SS) + (size_t)(0) * MPAD}; sk::Head sh{};
                sk::run<0>(Fp.lds, tidl, F.vcu, sg, sr, sh); }
            pg8::Gemm g{WSP(const bf16_t, WS_AB), WSP(const bf16_t, WS_WPOOL), D, 256, kp}; S.init(NTM - 1, 4, Gp, crot);
            if (!solo) S.pseam = 2;
            typedef pg8::EpiRes<true, 1, true> EP; EP E{Fp.lds + XIN_OFF, mk_rsrc(F.out, (unsigned)(O_END * 4)), mk_rsrc(wsl, (unsigned)WS_END), T_GATE1 + 0, T_GAINF + 0, 0, WSP(float, WS_SS) + (size_t)(0) * MPAD};
            pg8::gemm_phase<EP, pg8::DepOrder, true>(Fp.lds, tidl, g, S, E);
        } else if (PHQ(6)) {
            int kp = 256; asm volatile("" : "+s"(kp));
            if (F.vcu < 64) { const float* Tt = WSP(const float, WS_T); sk::Gemm sg{WSP(const bf16_t, WS_AB), D, 1, WSP(const bf16_t, WS_WPOOL) + (size_t)D * 256, 256, 0};
                sk::Res sr{nullptr, F.out, Tt + (T_GATE1 + 1) * TV, Tt + (T_GAINF + 1) * TV, nullptr, WSP(bf16_t, WS_AQ), nullptr, WSP(float, WS_SS) + (size_t)2 * MPAD}; sk::Head sh{};
                sk::run<0>(Fp.lds, tidl, F.vcu, sg, sr, sh); }
            pg8::Gemm g{WSP(const bf16_t, WS_AB), WSP(const bf16_t, WS_WPOOL) + (size_t)D * 256, D, 256, kp}; S.init(NTM - 1, 4, Gp, crot);
            typedef pg8::EpiRes<false, 1, true> EP; EP E{nullptr, mk_rsrc(F.out, (unsigned)(O_END * 4)), mk_rsrc(wsl, (unsigned)WS_END), T_GATE1 + 1, T_GAINF + 1, 0, WSP(float, WS_SS) + (size_t)2 * MPAD};
            pg8::gemm_phase<EP, pg8::DepOrder, true>(Fp.lds, tidl, g, S, E);
        } else if (PHQ(11) || PHQ(16)) {
            const bf16_t* Bw = WSP(const bf16_t, WS_WO) + (size_t)(layer - 2) * D * D; float* rssp = WSP(float, WS_SS) + (size_t)(2 * layer) * MPAD;
            if (F.vcu < 64) { const float* Tt = WSP(const float, WS_T); sk::Gemm sg{WSP(const bf16_t, WS_AB), D, 0, Bw, D, 0};
                sk::Res sr{nullptr, F.out, Tt + (T_GATE1 + layer) * TV, Tt + (T_GAINF + layer) * TV, nullptr, WSP(bf16_t, WS_AQ), nullptr, rssp}; sk::Head sh{};
                sk::run<0>(Fp.lds, tidl, F.vcu, sg, sr, sh); }
            pg8::Gemm g{WSP(const bf16_t, WS_AB), Bw, D, 0, D}; S.init(NTM - 1, 4, Gp, crot);
            typedef pg8::EpiRes<false, 1, true> EP; EP E{nullptr, mk_rsrc(F.out, (unsigned)(O_END * 4)), mk_rsrc(wsl, (unsigned)WS_END), T_GATE1 + layer, T_GAINF + layer, 0, rssp};
            pg8::gemm_phase<EP, pg8::DepOrder, true>(Fp.lds, tidl, g, S, E);
        } else if (PHQ(13)) {
            const bf16_t* Bw = WSP(const bf16_t, WS_WOUT) + (size_t)2 * D * DFF;
            if (F.vcu < 64) { const float* Tt = WSP(const float, WS_T); sk::Gemm sg{WSP(const bf16_t, WS_H), DFF, 0, Bw, DFF, 0};
                sk::Res sr{nullptr, F.out, Tt + (T_GATE2 + 2) * TV, Tt + (T_GAINQ + 1) * TV, nullptr, WSP(bf16_t, WS_AQ), nullptr, WSP(float, WS_SS) + (size_t)5 * MPAD}; sk::Head sh{};
                sk::run<0>(Fp.lds, tidl, F.vcu, sg, sr, sh); }
            pg8::Gemm g{WSP(const bf16_t, WS_H), Bw, DFF, 0, DFF}; S.init(NTM - 1, 4, Gp, crot);
            typedef pg8::EpiRes<false, 1, true> EP; EP E{nullptr, mk_rsrc(F.out, (unsigned)(O_END * 4)), mk_rsrc(wsl, (unsigned)WS_END), T_GATE2 + 2, T_GAINQ + 1, 0, WSP(float, WS_SS) + (size_t)5 * MPAD};
            pg8::gemm_phase<EP, pg8::DepOrder, true>(Fp.lds, tidl, g, S, E);
        } else if (PHQ(8)) {
            pg8::Gemm g{WSP(const bf16_t, WS_H), WSP(const bf16_t, WS_WOUT) + (size_t)1 * D * DFF, DFF, 0, DFF}; S.init(NTM - 1, 4, Gp, crot);
            if (F.vcu < 64) { const float* Tt = WSP(const float, WS_T); sk::Gemm sg{g.A, g.lda, 0, g.Bt, g.K, 0};
                sk::Res sr{nullptr, F.out, Tt + (T_GATE2 + 1) * TV, Tt + (T_GAINQ + 0) * TV, Tt + T_GAINKV * TV, WSP(bf16_t, WS_AQ), WSP(bf16_t, WS_AB), WSP(float, WS_SS) + (size_t)(3) * MPAD}; sk::Head sh{};
                sk::run<0>(Fp.lds, tidl, F.vcu, sg, sr, sh); }
            if (!solo) { S.wseam = 7; S.need_p = S.need_s = 22 * 8; S.pseam = 8; }
            typedef pg8::EpiRes<false, 2, true> EP; EP E{nullptr, mk_rsrc(F.out, (unsigned)(O_END * 4)), mk_rsrc(wsl, (unsigned)WS_END), T_GATE2 + 1, T_GAINQ + 0, T_GAINKV, WSP(float, WS_SS) + (size_t)(3) * MPAD};
            pg8::gemm_phase<EP, pg8::DepOrder, true>(Fp.lds, tidl, g, S, E);
        } else if (PHQ(4) || PHQ(18)) {
            pg8::Gemm g{WSP(const bf16_t, WS_H), WSP(const bf16_t, WS_WOUT) + (size_t)layer * D * DFF, DFF, 0, DFF}; S.init(NTM - 1, 4, Gp, crot);
            if (F.vcu < 64) { const float* Tt = WSP(const float, WS_T); sk::Gemm sg{g.A, g.lda, 0, g.Bt, g.K, 0};
                sk::Res sr{nullptr, F.out, Tt + (T_GATE2 + layer) * TV, nullptr, nullptr, nullptr, nullptr, ph == 4 ? WSP(float, WS_SS) + (size_t)1 * MPAD : nullptr}; sk::Head sh{};
                sk::run<0>(Fp.lds, tidl, F.vcu, sg, sr, sh); }
            if (!solo) { S.wseam = ph - 1; S.need_p = S.need_s = 22 * 8; }
            typedef pg8::EpiRes<false, 0, true> EP; EP E{nullptr, mk_rsrc(F.out, (unsigned)(O_END * 4)), mk_rsrc(wsl, (unsigned)WS_END), T_GATE2 + layer, 0, 0, WSP(float, WS_SS) + (size_t)(ph == 4 ? 1 : RSS_N) * MPAD};
            pg8::gemm_phase<EP, pg8::DepOrder, true>(Fp.lds, tidl, g, S, E);
        } else if (PHQ(3) || PHQ(7) || PHQ(12) || PHQ(17)) {
            pg8::Gemm g{WSP(const bf16_t, WS_AQ), WSP(const bf16_t, WS_WIN) + (size_t)layer * NIN * D, D, 0, D}; S.init(NTM, NIN / 256, Gp, crot);
            if (!solo) { S.wseam = ph - 1; S.need_p = S.need_s = 4 * 8; S.pseam = ph; }
            pg8::EpiSwiglu E{WSP(const float, WS_SS) + (size_t)(2 * layer) * MPAD, WSP(const float, WS_BIN) + (size_t)layer * NBATCH * NIN, mk_rsrc(wsl, (unsigned)WS_END)};
            pg8::gemm_phase<pg8::EpiSwiglu, pg8::DepOrder, true>(Fp.lds, tidl, g, S, E);
        } else if (PHQ(9) || PHQ(14)) {
            const int j = layer - 1;
            if (!solo) { S.wseam = ph - 1; S.need_p = S.need_s = 4 * 8; if (ph == 14) S.pseam = 14; }
            if (ph == 14 && F.vcu < 64) { sk::Gemm sg{WSP(const bf16_t, WS_AQ), D, 0, WSP(const bf16_t, WS_WQ) + (size_t)j * D * D, D, 1}; sk::Res sr{};
                sk::Head sh{WSP(const float, WS_SS) + (size_t)5 * MPAD, WSP(const float, WS_BQ) + (size_t)j * NBATCH * D, FIN(14) + j * HD, att::C2, WSP(bf16_t, WS_QO)};
                sk::run<1>(Fp.lds, tidl, F.vcu, sg, sr, sh); }
            { pg8::Gemm g{WSP(const bf16_t, WS_AQ), WSP(const bf16_t, WS_WQ) + (size_t)j * D * D, D, 0, D}; S.init(ph == 14 ? NTM - 1 : NTM, 4, Gp, crot);
              pg8::EpiHead<0> E{WSP(const float, WS_SS) + (size_t)(ph == 9 ? 3 : 5) * MPAD, WSP(const float, WS_BQ) + (size_t)j * NBATCH * D, D, FIN(14) + j * HD, att::C2, mk_rsrc(wsl, (unsigned)WS_END), nullptr, nullptr, nullptr, nullptr};
              pg8::gemm_phase<pg8::EpiHead<0>, pg8::DepOrder, true>(Fp.lds, tidl, g, S, E); }
            if (ph == 9) {
              pg8::Gemm g{WSP(const bf16_t, WS_AB), WSP(const bf16_t, WS_WKV), D, 0, D}; S.init(NTM, 2, Gp, Gp - 1 - crot); S.last_pm = -1;
              pg8::EpiHead<1> E{WSP(const float, WS_SS) + (size_t)3 * MPAD, WSP(const float, WS_BKV), 2 * KVD, FIN(21), 1.0f, mk_rsrc(wsl, (unsigned)WS_END), F.out + O_KP, F.out + O_VP, F.out + O_KS, F.out + O_VS};
              pg8::gemm_phase<pg8::EpiHead<1>, pg8::DepOrder, true>(Fp.lds, tidl, g, S, E); }
        } else if (PHQ(10) || PHQ(15)) {
            const int NU = NBP * 128 * NKV + NBS * NKV;
            const float* sk = FIN(15) + (layer - 2) * NH;
            const int ws_ = (!solo && ph == 15) ? 14 : -1, ps_ = solo ? -1 : ph;
            for (int u = F.vcu; u < NU; u += F.G) {
                int bidx, c, g;
                if (u < NBP * 128 * NKV) { g = u & 3; c = (u >> 2) & 127; bidx = u >> 9; } else { const int v = u - NBP * 128 * NKV; g = v & 3; c = 0; bidx = NBP + (v >> 2); }
                att::attn_unit(Fp.lds, tidl, bidx, c, g, WSP(const bf16_t, WS_QO), WSP(bf16_t, WS_AB), WSP(const bf16_t, WS_KB), WSP(const bf16_t, WS_VB), WSP(const bf16_t, WS_KC), WSP(const bf16_t, WS_VC), sk, cnt, ws_, ps_);
            }
        }
        if (ph + 1 < hi) xcd_barrier(bar, tidl);
    }
}

extern "C" void kernel_launch(void* const* d_in, const int* in_sizes, int n_in, void* d_out, int out_size, void* d_ws, size_t ws_size, hipStream_t stream) {
    static int grid = 0;
    if (grid == 0) {
        if (n_in != 24 || (size_t)out_size != O_END || ws_size < WS_END) { fprintf(stderr, "kernel_launch: unexpected sizes n_in %d out %d ws %zu\n", n_in, out_size, ws_size); grid = -1; return; }
        int dev = 0, cus = 0, per_cu = 0;
        if (hipGetDevice(&dev) != hipSuccess || hipDeviceGetAttribute(&cus, hipDeviceAttributeMultiprocessorCount, dev) != hipSuccess) { grid = -1; return; }
        if (hipFuncSetAttribute((const void*)yoco_fwd, hipFuncAttributeMaxDynamicSharedMemorySize, LDS_BYTES) != hipSuccess) { fprintf(stderr, "kernel_launch: hipFuncSetAttribute failed\n"); grid = -1; return; }
        if (hipOccupancyMaxActiveBlocksPerMultiprocessor(&per_cu, (const void*)yoco_fwd, NWAVES * 64, LDS_BYTES) != hipSuccess || per_cu < 1) { fprintf(stderr, "kernel_launch: occupancy query reports %d blocks per CU\n", per_cu); grid = -1; (void)hipGetLastError(); return; }
        grid = cus;
    }
    if (grid < 0) return;
    (void)hipMemsetAsync((char*)d_ws + WS_CTL, 0, CTL_ZERO_BYTES, stream);
    Args a{};
    for (int i = 0; i < 24; ++i) a.in[i] = (const float*)d_in[i];
    a.out = (float*)d_out; a.ws = (unsigned char*)d_ws;
#if MK_ONE_LAUNCH
    a.ph_lo = 0; a.ph_hi = NPHASE;
    hipLaunchKernelGGL(yoco_fwd, dim3(grid), dim3(NWAVES * 64), LDS_BYTES, stream, a);
#else
#ifndef DUP_MASK
#define DUP_MASK 0
#endif
    for (int p = 0; p < NPHASE; ++p) { a.ph_lo = p; a.ph_hi = p + 1; hipLaunchKernelGGL(yoco_fwd, dim3(grid), dim3(NWAVES * 64), LDS_BYTES, stream, a);
        if ((DUP_MASK >> p) & 1) hipLaunchKernelGGL(yoco_fwd, dim3(grid), dim3(NWAVES * 64), LDS_BYTES, stream, a); }
#endif
}
```

```cpp
#include <hip/hip_runtime.h>
#include <cstdio>
#include <cstdint>

#define LAS __attribute__((address_space(3)))
typedef unsigned short bf16_t;
typedef short bf16x8 __attribute__((ext_vector_type(8)));
typedef short s16x4 __attribute__((ext_vector_type(4)));
typedef float f32x2 __attribute__((ext_vector_type(2)));
typedef float f32x4 __attribute__((ext_vector_type(4)));
typedef float f32x16 __attribute__((ext_vector_type(16)));
typedef unsigned u32x2 __attribute__((ext_vector_type(2)));
typedef unsigned u32x4 __attribute__((ext_vector_type(4)));
typedef __bf16 bf16x2_t __attribute__((ext_vector_type(2)));
typedef _Float16 h16x4 __attribute__((ext_vector_type(4)));
typedef _Float16 h16x8 __attribute__((ext_vector_type(8)));
typedef float f32x8 __attribute__((ext_vector_type(8)));

#ifndef MK_ONE_LAUNCH
#define MK_ONE_LAUNCH 1
#define WT_AUX 0
#endif

constexpr int D = 1024, SEQ = 8192, NBP = 2, NBS = 8, LS = 16, NBATCH = 10;
constexpr int MP = NBP * SEQ, MS = NBS * LS, MREAL = MP + MS, NTM = 65, MPAD = NTM * 256;
constexpr int DFF = 2816, NIN = 2 * DFF, HD = 64, NH = 16, NKV = 4, KVD = NKV * HD, WIN = 128, PH = 15;
constexpr int ADAW = 6 * D;
constexpr float EPS = 1e-6f;
constexpr int NPHASE = 19;

constexpr size_t O_Y = 0, O_POOLP = (size_t)MREAL * D, O_KP = O_POOLP + 2 * NBP * PH * D, O_VP = O_KP + (size_t)NBP * WIN * KVD,
                 O_POOLS = O_VP + (size_t)NBP * WIN * KVD, O_KS = O_POOLS + 2 * NBS * PH * D, O_VS = O_KS + (size_t)NBS * WIN * KVD, O_END = O_VS + (size_t)NBS * WIN * KVD;

constexpr size_t MiB = 1u << 20;
constexpr size_t WS_CTL = 0, CTL_ZERO_BYTES = 1 * MiB;
constexpr size_t WS_ADA = 1 * MiB, WS_ADAKV = 2 * MiB, WS_BIN = 3 * MiB, WS_BQ = 4 * MiB, WS_BKV = 4 * MiB + 128 * 1024, WS_SS = 5 * MiB, WS_T = 7 * MiB;
constexpr int T_GATE1 = 0, T_GAINF = 4, T_GATE2 = 8, T_GAINQ = 12, T_GAINKV = 14, T_NVEC = 15, TV = NBATCH * D;
constexpr size_t WS_WPOOL = 8 * MiB, WS_WQ = 9 * MiB, WS_WO = 13 * MiB, WS_WKV = 17 * MiB, WS_WIN = 18 * MiB, WS_WOUT = 62 * MiB;
constexpr size_t WS_KC = 84 * MiB, WS_VC = 84 * MiB + 512 * 1024, WS_KB = 85 * MiB, WS_VB = 94 * MiB;
constexpr size_t WS_AQ = 104 * MiB, WS_AB = 137 * MiB, WS_QO = 170 * MiB, WS_H = 203 * MiB, WS_XH = 293 * MiB, WS_END = 326 * MiB;
constexpr int RSS_N = 7;
static_assert((size_t)(RSS_N + 1) * MPAD * 4 <= 2 * MiB, "rss"); static_assert((size_t)MPAD * D * 2 <= 33 * MiB && (size_t)MPAD * DFF * 2 <= 90 * MiB && (size_t)MPAD * KVD * 2 <= 9 * MiB && (size_t)MPAD * 16 * 4 <= 3 * MiB, "ws map");
constexpr int CW_BAR = 4096, CW_CNT = 8192;

__device__ __forceinline__ unsigned pk_bf16(float lo, float hi) { f32x2 v = {lo, hi}; bf16x2_t b = __builtin_convertvector(v, bf16x2_t); return __builtin_bit_cast(unsigned, b); }
__device__ __forceinline__ float bf_lo(unsigned u) { return __uint_as_float(u << 16); }
__device__ __forceinline__ float bf_hi(unsigned u) { return __uint_as_float(u & 0xffff0000u); }
__device__ __forceinline__ float shx(float v, int mask, int lane) { return __int_as_float(__builtin_amdgcn_ds_bpermute((lane ^ mask) << 2, __float_as_int(v))); }
__device__ __forceinline__ float wave_sum(float v, int lane) {
#pragma unroll
    for (int o = 1; o < 64; o <<= 1) v += shx(v, o, lane);
    return v;
}
__device__ __forceinline__ int batch_of(int row16) { return row16 < MP ? (row16 >> 13) : min(2 + ((row16 - MP) >> 4), NBATCH - 1); }
#ifndef WT_AUX
#define WT_AUX 16
#endif
typedef __amdgpu_buffer_rsrc_t rsrc_t;
__device__ __forceinline__ rsrc_t mk_rsrc(const void* p, unsigned bytes) { return __builtin_amdgcn_make_buffer_rsrc((void*)p, 0, (int)bytes, 0x00020000); }
__device__ __forceinline__ void st16_wt(rsrc_t r, unsigned off, u32x4 v) { __builtin_amdgcn_raw_buffer_store_b128(v, r, (int)off, 0, WT_AUX); }
__device__ __forceinline__ void st16f_wt(rsrc_t r, unsigned off, f32x4 v) { __builtin_amdgcn_raw_buffer_store_b128(__builtin_bit_cast(u32x4, v), r, (int)off, 0, WT_AUX); }
__device__ __forceinline__ void st8_wt(rsrc_t r, unsigned off, u32x2 v) { __builtin_amdgcn_raw_buffer_store_b64(v, r, (int)off, 0, WT_AUX); }
__device__ __forceinline__ void st4_wt(rsrc_t r, unsigned off, float v) { __builtin_amdgcn_raw_buffer_store_b32(__float_as_uint(v), r, (int)off, 0, WT_AUX); }
__device__ __forceinline__ u32x4 ld16u(rsrc_t r, unsigned off) { return __builtin_amdgcn_raw_buffer_load_b128(r, (int)off, 0, 0); }
__device__ __forceinline__ f32x4 ld16f(rsrc_t r, unsigned off) { return __builtin_bit_cast(f32x4, __builtin_amdgcn_raw_buffer_load_b128(r, (int)off, 0, 0)); }
#define LDS_WAIT() asm volatile("s_waitcnt lgkmcnt(0)" ::: "memory")
#define VM_WAIT() asm volatile("s_waitcnt vmcnt(0)" ::: "memory")

namespace pg8 {
constexpr int BM = 256, BK = 64, HALF = 128, HTB = HALF * BK * 2, STAGE_BYTES = 8 * HTB, NXCD = 8, WGM = 8;
__host__ __device__ __forceinline__ int lds_byte(int r, int c) { const int st = (r >> 4) * 2 + (c >> 5), rr = r & 15, cc = c & 31, ob = rr * 64 + cc * 2; return st * 1024 + (ob ^ (((ob >> 9) & 1) << 5)); }
__host__ __device__ __forceinline__ void stage_rc(int b, int& R, int& C) { const int st = b / 1024, sb = b % 1024, swz = sb ^ (((sb >> 9) & 1) << 5); R = (st >> 1) * 16 + swz / 64; C = (st & 1) * 32 + (swz % 64) / 2; }
__host__ __device__ __forceinline__ int perm32(int rho) { const int n = rho >> 4, i = rho & 15; return 8 * (i >> 2) + 4 * n + (i & 3); }

struct Unit { int pm, pn; };
struct Gemm { const bf16_t* A; const bf16_t* Bt; int lda; int a_pn_off; int K; };

struct StaticOrder {
    int nM, nN, nwg, G, c;
    __host__ __device__ void init(int nM_, int nN_, int G_, int c_) { nM = nM_; nN = nN_; nwg = nM * nN; G = G_; c = c_; }
    __host__ __device__ bool next(int i, Unit& u) const {
        const long L = (long)i * G + c; if (L >= nwg) return false;
        int wgid = (int)L; { const int q = nwg / NXCD, r = nwg % NXCD, xcd = wgid % NXCD, off = wgid / NXCD; wgid = (xcd < r ? xcd * (q + 1) : r * (q + 1) + (xcd - r) * q) + off; }
        const int nig = WGM * nN, gid = wgid / nig, fm = gid * WGM, gsz = (nM - fm) < WGM ? (nM - fm) : WGM;
        u.pm = fm + ((wgid % nig) % gsz); u.pn = (wgid % nig) / gsz; return true;
    }
};
constexpr int NPAN = 65;
__device__ __forceinline__ void dep_publish(unsigned* cnt, int seam, int pm, int lane) {
    asm volatile("s_waitcnt vmcnt(0)" ::: "memory");
    if (lane == 0) __hip_atomic_fetch_add(cnt + (size_t)(seam * NPAN + pm) * 64, 1u, __ATOMIC_RELAXED, __HIP_MEMORY_SCOPE_AGENT);
}
__device__ __forceinline__ void dep_poll(unsigned* cnt, int seam, int pm, unsigned need) {
    unsigned* p = cnt + (size_t)(seam * NPAN + pm) * 64;
    const unsigned long long t0 = __builtin_amdgcn_s_memrealtime();
    while ((unsigned)__builtin_amdgcn_readfirstlane(__hip_atomic_load(p, __ATOMIC_RELAXED, __HIP_MEMORY_SCOPE_AGENT)) < need) {
        if (__builtin_amdgcn_s_memrealtime() - t0 > 2000000ull) break;
        __builtin_amdgcn_s_sleep(2); }
}
struct DepOrder : StaticOrder {
    unsigned* cnt; int wseam, pseam; unsigned need_p, need_s; int wait_next; int last_pm;
    __device__ __forceinline__ void a_ready(const Unit& u, int wid) {
        if (wseam < 0 || u.pm == last_pm) return;
        if (wid == 0) {
            dep_poll(cnt, wseam, u.pm, u.pm == NPAN - 1 ? need_s : need_p);
            if (wait_next && u.pm + 1 < NPAN) dep_poll(cnt, wseam, u.pm + 1, u.pm + 1 == NPAN - 1 ? need_s : need_p);
            __builtin_amdgcn_fence(__ATOMIC_ACQUIRE, "agent");
            asm volatile("s_waitcnt vmcnt(0)" ::: "memory");
        }
        asm volatile("" ::: "memory"); __builtin_amdgcn_s_barrier(); asm volatile("" ::: "memory");
        last_pm = u.pm;
    }
    __device__ __forceinline__ void done(const Unit& u, int lane) const { if (pseam >= 0) dep_publish(cnt, pseam, u.pm, lane); }
};

template <class Epi, class Sched, bool ALIGN_EPI = false>
__device__ __forceinline__ void gemm_phase(LAS unsigned char* lds, const int tid, const Gemm g, Sched& S, const Epi& E) {
    const int wid = __builtin_amdgcn_readfirstlane(tid >> 6), lane = tid & 63, wr = wid >> 2, wc = wid & 3, fr = lane & 15, fq = lane >> 4;
    const int K = g.K, nt = K / BK, lda = g.lda;
    unsigned voffA[2], voffB[2];
#pragma unroll
    for (int i = 0; i < 2; ++i) { int R, C; stage_rc(tid * 16 + i * 8192, R, C); const int Rb = Epi::PERM ? ((R & ~31) + perm32(R & 31)) : R;
        voffA[i] = (unsigned)(R * lda + C) * 2u; voffB[i] = (unsigned)(Rb * K + C) * 2u; }
    const size_t kstep = (size_t)(BK * 2);
    const size_t hstepA = (size_t)HALF * lda * 2, hstepB = (size_t)HALF * K * 2;
    const size_t tstepA = 2 * hstepA, tstepB = 2 * hstepB;
    const unsigned ldsw = (unsigned)wid * 1024u;
    const int aoff = lds_byte(wr * 64 + fr, fq * 8), boff = lds_byte(wc * 32 + fr, fq * 8);
#define PG8_SA(b, h) (((b) * 2 + (h)) * HTB)
#define PG8_SB(b, h) ((4 + (b) * 2 + (h)) * HTB)
#define PG8_STAGE(bufoff, gbase, voff) do { _Pragma("unroll") for (int _i = 0; _i < 2; ++_i) \
        __builtin_amdgcn_global_load_lds((const unsigned*)((const char*)(gbase) + (voff)[_i]), (LAS unsigned*)(lds + (bufoff) + ldsw + _i * 8192), 16, 0, 0); } while (0)
#define PG8_LDA(dst, b, h) do { _Pragma("unroll") for (int m = 0; m < 4; ++m) _Pragma("unroll") for (int k = 0; k < 2; ++k) dst[m][k] = *(const LAS bf16x8*)(lds + PG8_SA(b, h) + aoff + m * 2048 + k * 1024); } while (0)
#define PG8_LDB(dst, b, h) do { _Pragma("unroll") for (int n = 0; n < 2; ++n) _Pragma("unroll") for (int k = 0; k < 2; ++k) dst[n][k] = *(const LAS bf16x8*)(lds + PG8_SB(b, h) + boff + n * 2048 + k * 1024); } while (0)
#define PG8_MMA(ai, bj, At, Bt) do { __builtin_amdgcn_s_setprio(1); _Pragma("unroll") for (int m = 0; m < 4; ++m) _Pragma("unroll") for (int n = 0; n < 2; ++n) _Pragma("unroll") for (int k = 0; k < 2; ++k) \
        acc[ai][bj][m][n] = __builtin_amdgcn_mfma_f32_16x16x32_bf16(Bt[n][k], At[m][k], acc[ai][bj][m][n], 0, 0, 0); __builtin_amdgcn_s_setprio(0); } while (0)
#define PG8_WAIT_V(n) asm volatile("s_waitcnt vmcnt(" #n ")" ::: "memory")
#define PG8_WAIT_L(n) asm volatile("s_waitcnt lgkmcnt(" #n ")" ::: "memory")
#define PG8_BAR __builtin_amdgcn_s_barrier()
#define PG8_SCHED __builtin_amdgcn_sched_barrier(0)
    Unit cur, nxt; int ui = 0;
    if (!S.next(0, cur)) return;
    f32x4 acc[2][2][4][2];
    const float zf = __int_as_float(tid >> 12);
#pragma unroll
    for (int a = 0; a < 2; ++a)
#pragma unroll
        for (int b = 0; b < 2; ++b)
#pragma unroll
            for (int m = 0; m < 4; ++m)
#pragma unroll
                for (int n = 0; n < 2; ++n) acc[a][b][m][n] = (f32x4){zf, zf, zf, zf};
    bf16x8 At[4][2], B0[2][2], B1[2][2];
    const char* cA = (const char*)g.A + (size_t)cur.pm * tstepA + (size_t)cur.pn * g.a_pn_off * 2; const char* cB = (const char*)g.Bt + (size_t)cur.pn * tstepB;
    S.a_ready(cur, wid);
    PG8_STAGE(PG8_SB(0, 0), cB, voffB); PG8_STAGE(PG8_SB(0, 1), cB + hstepB, voffB); PG8_STAGE(PG8_SA(0, 0), cA, voffA); PG8_STAGE(PG8_SA(0, 1), cA + hstepA, voffA);
    if (wr == 1) PG8_BAR;
    PG8_WAIT_V(2); PG8_BAR;
    PG8_STAGE(PG8_SB(1, 0), cB + kstep, voffB); PG8_STAGE(PG8_SA(1, 0), cA + kstep, voffA); PG8_STAGE(PG8_SB(1, 1), cB + hstepB + kstep, voffB);
    PG8_WAIT_V(6); PG8_BAR;
    for (;;) {
        const bool has_next = S.next(ui + 1, nxt);
        const char* nA = has_next ? (const char*)g.A + (size_t)nxt.pm * tstepA + (size_t)nxt.pn * g.a_pn_off * 2 : cA; const char* nB = has_next ? (const char*)g.Bt + (size_t)nxt.pn * tstepB : cB;
        for (int t = 0; t < nt; t += 2) {
            const bool last = (t == nt - 2);
            const char* a1 = cA + (size_t)(t + 1) * kstep;
            const char* a2 = last ? nA : cA + (size_t)(t + 2) * kstep; const char* b2 = last ? nB : cB + (size_t)(t + 2) * kstep;
            const char* a3 = a2 + kstep; const char* b3 = b2 + kstep;
            if (last && has_next) S.a_ready(nxt, wid);
            PG8_LDB(B0, 0, 0); PG8_LDB(B1, 0, 1); PG8_SCHED; PG8_LDA(At, 0, 0); PG8_STAGE(PG8_SA(1, 1), a1 + hstepA, voffA);
            PG8_WAIT_V(8); PG8_WAIT_L(0); PG8_BAR; PG8_MMA(0, 0, At, B0); PG8_MMA(0, 1, At, B1); PG8_BAR; PG8_SCHED;
            PG8_LDA(At, 0, 1); PG8_STAGE(PG8_SB(0, 0), b2, voffB); PG8_STAGE(PG8_SB(0, 1), b2 + hstepB, voffB); PG8_STAGE(PG8_SA(0, 0), a2, voffA);
            PG8_WAIT_V(8); PG8_WAIT_L(0); PG8_BAR; PG8_MMA(1, 0, At, B0); PG8_MMA(1, 1, At, B1); PG8_BAR; PG8_SCHED;
            PG8_LDB(B0, 1, 0); PG8_LDB(B1, 1, 1); PG8_SCHED; PG8_LDA(At, 1, 0); PG8_STAGE(PG8_SA(0, 1), a2 + hstepA, voffA);
            PG8_WAIT_V(8); PG8_WAIT_L(0); PG8_BAR; PG8_MMA(0, 0, At, B0); PG8_MMA(0, 1, At, B1); PG8_BAR; PG8_SCHED;
            PG8_LDA(At, 1, 1); PG8_STAGE(PG8_SB(1, 0), b3, voffB); PG8_STAGE(PG8_SB(1, 1), b3 + hstepB, voffB); PG8_STAGE(PG8_SA(1, 0), a3, voffA);
            PG8_WAIT_V(8); PG8_WAIT_L(0); PG8_BAR; PG8_MMA(1, 0, At, B0); PG8_MMA(1, 1, At, B1); PG8_BAR; PG8_SCHED;
        }
        if constexpr (ALIGN_EPI) { if (wr == 0) PG8_BAR; }
        E(acc, cur, wr, wc, fr, fq); S.done(cur, lane);
        if (!has_next) break;
#pragma unroll
        for (int a = 0; a < 2; ++a)
#pragma unroll
            for (int b = 0; b < 2; ++b)
#pragma unroll
                for (int m = 0; m < 4; ++m)
#pragma unroll
                    for (int n = 0; n < 2; ++n) acc[a][b][m][n] = (f32x4){zf, zf, zf, zf};
        cur = nxt; cA = nA; cB = nB; ++ui;
        if constexpr (ALIGN_EPI) { if (wr == 1) PG8_BAR; }
    }
    PG8_WAIT_V(0);
    if constexpr (!ALIGN_EPI) { if (wr == 0) PG8_BAR; }
    PG8_BAR;
#undef PG8_SA
#undef PG8_SB
#undef PG8_STAGE
#undef PG8_LDA
#undef PG8_LDB
#undef PG8_MMA
#undef PG8_WAIT_V
#undef PG8_WAIT_L
#undef PG8_BAR
#undef PG8_SCHED
}


template <bool XIN, int NA, bool HAS_SS, bool FINAL = false> struct EpiRes {
    static constexpr bool PERM = true;
    LAS const unsigned char* xin_lds;
    rsrc_t rx, rw;
    int gate_id, g1_id, g2_id; float* rss;
    __device__ __forceinline__ void operator()(const f32x4 (&acc)[2][2][4][2], const Unit& u, int wr, int wc, int fr, int fq) const {
        const unsigned colb = (unsigned)(u.pn * BM + wc * 32 + 8 * fq), toff = (unsigned)(u.pm >> 5) * D + colb;
        const unsigned gate = (unsigned)WS_T + ((unsigned)gate_id * TV + toff) * 4, g1 = (unsigned)WS_T + ((unsigned)g1_id * TV + toff) * 4, g2 = (unsigned)WS_T + ((unsigned)g2_id * TV + toff) * 4;
        const float* xo = nullptr;
        if (XIN) { const unsigned long long pv = ((const LAS unsigned long long*)xin_lds)[0];
            xo = (const float*)(((unsigned long long)(unsigned)__builtin_amdgcn_readfirstlane((int)(pv >> 32)) << 32) | (unsigned)__builtin_amdgcn_readfirstlane((int)pv)); }
        const unsigned row0 = (unsigned)(u.pm * BM + wr * 64 + fr);
        float ssq[8];
#pragma unroll
        for (int g_ = 0; g_ < 8; ++g_) ssq[g_] = 0.f;
#define E1_LOADX(dst, g_, bj_) do { const unsigned xoff_ = (row0 + ((g_) >> 2) * HALF + ((g_) & 3) * 16) * D + colb + (bj_) * HALF; \
            if (XIN) { const f32x4 t0_ = *(const f32x4*)(xo + xoff_), t1_ = *(const f32x4*)(xo + xoff_ + 4); dst = (f32x8){t0_[0], t0_[1], t0_[2], t0_[3], t1_[0], t1_[1], t1_[2], t1_[3]}; } \
            else dst = __builtin_convertvector(__builtin_bit_cast(h16x8, ld16u(rw, (unsigned)WS_XH + xoff_ * 2)), f32x8); } while (0)
#pragma unroll
        for (int bj = 0; bj < 2; ++bj) {
            f32x4 gt[2], ga[2], gb[2]; f32x8 xc, xn_;
#pragma unroll
            for (int n = 0; n < 2; ++n) { gt[n] = ld16f(rw, gate + (bj * HALF + 4 * n) * 4);
                if (NA >= 1) ga[n] = ld16f(rw, g1 + (bj * HALF + 4 * n) * 4);
                if (NA >= 2) gb[n] = ld16f(rw, g2 + (bj * HALF + 4 * n) * 4); }
            E1_LOADX(xc, 0, bj);
#pragma unroll
            for (int g_ = 0; g_ < 8; ++g_) {
                const int ai = g_ >> 2, m = g_ & 3;
                if (g_ < 7) E1_LOADX(xn_, g_ + 1, bj);
                const unsigned ooff = (row0 + ai * HALF + m * 16) * D + colb + bj * HALF;
                const f32x4 na = (f32x4){xc[0], xc[1], xc[2], xc[3]} + gt[0] * acc[ai][bj][m][0], nb = (f32x4){xc[4], xc[5], xc[6], xc[7]} + gt[1] * acc[ai][bj][m][1];
                if (FINAL) { st16f_wt(rx, ooff * 4, na); st16f_wt(rx, (ooff + 4) * 4, nb); }
                else { const h16x8 hv = __builtin_convertvector((f32x8){na[0], na[1], na[2], na[3], nb[0], nb[1], nb[2], nb[3]}, h16x8); st16_wt(rw, (unsigned)WS_XH + ooff * 2, __builtin_bit_cast(u32x4, hv)); }
                if (HAS_SS) ssq[g_] += ((na[0] * na[0] + na[1] * na[1]) + (na[2] * na[2] + na[3] * na[3])) + ((nb[0] * nb[0] + nb[1] * nb[1]) + (nb[2] * nb[2] + nb[3] * nb[3]));
                if (NA >= 1) { const f32x4 pa = na * ga[0], pb = nb * ga[1];
                    u32x4 w; w.x = pk_bf16(pa[0], pa[1]); w.y = pk_bf16(pa[2], pa[3]); w.z = pk_bf16(pb[0], pb[1]); w.w = pk_bf16(pb[2], pb[3]); st16_wt(rw, (unsigned)WS_AQ + ooff * 2, w); }
                if (NA >= 2) { const f32x4 pa = na * gb[0], pb = nb * gb[1];
                    u32x4 w; w.x = pk_bf16(pa[0], pa[1]); w.y = pk_bf16(pa[2], pa[3]); w.z = pk_bf16(pb[0], pb[1]); w.w = pk_bf16(pb[2], pb[3]); st16_wt(rw, (unsigned)WS_AB + ooff * 2, w); }
                asm volatile("" ::: "memory");
                xc = xn_;
            }
        }
        if (HAS_SS) {
#pragma unroll
            for (int g_ = 0; g_ < 8; ++g_) { float ss = ssq[g_]; ss += shx(ss, 16, fq * 16 + fr); ss += shx(ss, 32, fq * 16 + fr); if (fq == 0) unsafeAtomicAdd(rss + row0 + (g_ >> 2) * HALF + (g_ & 3) * 16, ss); }
        }
#undef E1_LOADX
    }
};

__device__ __forceinline__ float rstd_of(float sumsq) { return 1.0f / sqrtf(sumsq * (1.0f / D) + EPS); }
__device__ __forceinline__ float silu_f(float g) { return g * __builtin_amdgcn_rcpf(1.0f + __builtin_amdgcn_exp2f(-1.4426950408889634f * g)); }

struct EpiSwiglu {
    static constexpr bool PERM = true;
    const float* rss; const float* bias;
    rsrc_t rw;
    __device__ __forceinline__ void operator()(const f32x4 (&acc)[2][2][4][2], const Unit& u, int wr, int wc, int fr, int fq) const {
        const int pc = u.pn * BM + wc * 32 + 8 * fq;
        const bool prompt = u.pm < MP / BM;
        const unsigned row0 = (unsigned)(u.pm * BM + wr * 64 + fr);
        float rs[8];
#pragma unroll
        for (int g_ = 0; g_ < 8; ++g_) rs[g_] = rss[row0 + (g_ >> 2) * HALF + (g_ & 3) * 16];
        f32x4 bg[2], bu[2];
        { const float* bp = bias + (size_t)(prompt ? (u.pm >> 5) : NBP) * NIN + pc;
#pragma unroll
          for (int n = 0; n < 2; ++n) { bg[n] = *(const f32x4*)(bp + 4 * n); bu[n] = *(const f32x4*)(bp + HALF + 4 * n); } }
#pragma unroll
        for (int g_ = 0; g_ < 8; ++g_) {
            const int ai = g_ >> 2, m = g_ & 3;
            const unsigned row = row0 + ai * HALF + m * 16;
            if (!prompt) { const float* bp = bias + (size_t)batch_of((int)(row - fr)) * NIN + pc;
#pragma unroll
                for (int n = 0; n < 2; ++n) { bg[n] = *(const f32x4*)(bp + 4 * n); bu[n] = *(const f32x4*)(bp + HALF + 4 * n); } }
            const float r = rstd_of(rs[g_]);
            u32x4 w;
#pragma unroll
            for (int n = 0; n < 2; ++n) {
                const f32x4 gv = acc[ai][0][m][n] * r + bg[n], uv = acc[ai][1][m][n] * r + bu[n];
                const float h0 = silu_f(gv[0]) * uv[0], h1 = silu_f(gv[1]) * uv[1], h2 = silu_f(gv[2]) * uv[2], h3 = silu_f(gv[3]) * uv[3];
                if (n == 0) { w.x = pk_bf16(h0, h1); w.y = pk_bf16(h2, h3); } else { w.z = pk_bf16(h0, h1); w.w = pk_bf16(h2, h3); }
            }
            st16_wt(rw, (unsigned)WS_H + (row * DFF + u.pn * HALF + wc * 32 + 8 * fq) * 2, w);
        }
    }
};

template <int MODE> struct EpiHead {
    static constexpr bool PERM = true;
    const float* rss; const float* bias; int bias_stride; const float* gvec; float oscale;
    rsrc_t rw; float* fk_p; float* fv_p; float* fk_s; float* fv_s;
    __device__ __forceinline__ void operator()(const f32x4 (&acc)[2][2][4][2], const Unit& u, int wr, int wc, int fr, int fq) const {
        const bool isv = (MODE == 1) && (u.pn == 1);
        const int ldo = (MODE == 0) ? D : KVD;
        const int ocol = (MODE == 0 ? (4 * u.pn + wc) * HD : wc * HD) + 8 * fq;
        const unsigned Ob = (MODE == 0) ? (unsigned)WS_QO : (isv ? (unsigned)WS_VB : (unsigned)WS_KB);
        const bool prompt = u.pm < MP / BM;
        float rsv[8];
#pragma unroll
        for (int g_ = 0; g_ < 8; ++g_) rsv[g_] = rss[u.pm * BM + wr * 64 + fr + (g_ >> 2) * HALF + (g_ & 3) * 16];
        f32x4 bv[2][2];
        { const float* bp = bias + (size_t)(prompt ? (u.pm >> 5) : NBP) * bias_stride + u.pn * BM + wc * 32 + 8 * fq;
#pragma unroll
          for (int bj = 0; bj < 2; ++bj)
#pragma unroll
              for (int n = 0; n < 2; ++n) bv[bj][n] = *(const f32x4*)(bp + bj * HALF + 4 * n); }
#pragma unroll
        for (int ai = 0; ai < 2; ++ai)
#pragma unroll
            for (int m = 0; m < 4; ++m) {
                const int row16 = u.pm * BM + ai * HALF + wr * 64 + m * 16, row = row16 + fr;
                const float rs = rstd_of(rsv[ai * 4 + m]);
                if (!prompt) { const float* bp = bias + (size_t)batch_of(row16) * bias_stride + u.pn * BM + wc * 32 + 8 * fq;
#pragma unroll
                    for (int bj = 0; bj < 2; ++bj)
#pragma unroll
                        for (int n = 0; n < 2; ++n) bv[bj][n] = *(const f32x4*)(bp + bj * HALF + 4 * n); }
                f32x4 v[2][2]; float ss = 0.f;
#pragma unroll
                for (int bj = 0; bj < 2; ++bj)
#pragma unroll
                    for (int n = 0; n < 2; ++n) { v[bj][n] = acc[ai][bj][m][n] * rs + bv[bj][n];
                        ss += (v[bj][n][0] * v[bj][n][0] + v[bj][n][1] * v[bj][n][1]) + (v[bj][n][2] * v[bj][n][2] + v[bj][n][3] * v[bj][n][3]); }
                ss += shx(ss, 16, fq * 16 + fr); ss += shx(ss, 32, fq * 16 + fr);
                const float hr = 1.0f / sqrtf(ss * (1.0f / HD) + EPS);
                if (!isv) {
#pragma unroll
                    for (int bj = 0; bj < 2; ++bj)
#pragma unroll
                        for (int n = 0; n < 2; ++n) v[bj][n] = v[bj][n] * (hr * oscale) * *(const f32x4*)(gvec + 32 * bj + 8 * fq + 4 * n);
                }
                float* ftail = nullptr;
                if (MODE == 1) {
                    if (row < MP) { const int t = row & (SEQ - 1); if (t >= SEQ - WIN) ftail = (isv ? fv_p : fk_p) + ((size_t)(row >> 13) * WIN + (t - (SEQ - WIN))) * KVD; }
                    else if (row < MREAL) { const int bs = (row - MP) >> 4, t = (row - MP) & 15; ftail = (isv ? fv_s : fk_s) + ((size_t)bs * WIN + (WIN - LS) + t) * KVD; }
                }
#pragma unroll
                for (int bj = 0; bj < 2; ++bj) {
                    u32x4 w; w.x = pk_bf16(v[bj][0][0], v[bj][0][1]); w.y = pk_bf16(v[bj][0][2], v[bj][0][3]); w.z = pk_bf16(v[bj][1][0], v[bj][1][1]); w.w = pk_bf16(v[bj][1][2], v[bj][1][3]);
                    st16_wt(rw, Ob + ((unsigned)row * ldo + ocol + 32 * bj) * 2, w);
                    if (MODE == 1) { if (ftail) { *(f32x4*)(ftail + ocol + 32 * bj) = v[bj][0]; *(f32x4*)(ftail + ocol + 32 * bj + 4) = v[bj][1]; } }
                }
                asm volatile("" ::: "memory");
            }
    }
};
}

namespace sk {
struct Gemm { const bf16_t* A; int lda; int a_grp; const bf16_t* Bt; int K; int headperm; };
struct Res { const float* xin_s; float* Xf; _Float16* XH; const float* gate; const float* g1; const float* g2; bf16_t* A1; bf16_t* A2; float* SS; };
struct Head { const float* SS; const float* bias; const float* gvec; float oscale; bf16_t* O; };

template <int KIND> __device__ __forceinline__ void run(LAS unsigned char* lds, int tid, int tile, const Gemm g, const Res R, const Head H) {
    const int lane = tid & 63, wid = __builtin_amdgcn_readfirstlane(tid >> 6), fr = lane & 15, fq = lane >> 4;
    const int rt = tile & 3, ct = tile >> 2, K = g.K, kw = K >> 3, nst = kw >> 5;
    const bf16_t* ap = g.A + (size_t)(MP + 32 * rt + fr) * g.lda + (g.a_grp ? 256 * (ct >> 2) : 0) + wid * kw + 8 * fq;
    const int brow0 = g.headperm ? 256 * (ct >> 2) + 32 * (ct & 3) : 64 * ct;
    const bf16_t* bp = g.Bt + (size_t)(brow0 + fr) * K + wid * kw + 8 * fq;
    const size_t bst1 = (size_t)16 * K, bst2 = g.headperm ? (size_t)128 * K : (size_t)32 * K;
    f32x4 acc[2][4];
#pragma unroll
    for (int mi = 0; mi < 2; ++mi)
#pragma unroll
        for (int ni = 0; ni < 4; ++ni) acc[mi][ni] = (f32x4){0.f, 0.f, 0.f, 0.f};
    for (int s0 = 0; s0 < nst; s0 += 4) {
        bf16x8 af[4][2], bf[4][4];
#pragma unroll
        for (int q = 0; q < 4; ++q) { const int s_ = (s0 + q < nst) ? s0 + q : s0;
#pragma unroll
            for (int mi = 0; mi < 2; ++mi) af[q][mi] = *(const bf16x8*)(ap + (size_t)(16 * mi) * g.lda + 32 * s_);
#pragma unroll
            for (int ni = 0; ni < 4; ++ni) bf[q][ni] = *(const bf16x8*)(bp + (ni & 1) * bst1 + (ni >> 1) * bst2 + 32 * s_); }
#pragma unroll
        for (int q = 0; q < 4; ++q) if (s0 + q < nst) {
#pragma unroll
            for (int mi = 0; mi < 2; ++mi)
#pragma unroll
                for (int ni = 0; ni < 4; ++ni) acc[mi][ni] = __builtin_amdgcn_mfma_f32_16x16x32_bf16(bf[q][ni], af[q][mi], acc[mi][ni], 0, 0, 0); }
    }
    LAS f32x4* red = (LAS f32x4*)lds;
#pragma unroll
    for (int mi = 0; mi < 2; ++mi)
#pragma unroll
        for (int ni = 0; ni < 4; ++ni) red[(wid * 8 + mi * 4 + ni) * 64 + lane] = acc[mi][ni];
    LDS_WAIT(); __syncthreads();
    const int rl = 4 * wid + (lane >> 4), c4 = lane & 15;
    f32x4 v = {0.f, 0.f, 0.f, 0.f};
    { const int idx = ((rl >> 4) * 4 + (c4 >> 2)) * 64 + (c4 & 3) * 16 + (rl & 15);
#pragma unroll
      for (int w = 0; w < 8; ++w) v += red[w * 512 + idx]; }
    const int srow = 32 * rt + rl, row = MP + srow, b = NBP + (srow >> 4), col = 64 * ct + 4 * c4;
    if (KIND == 0) {
        f32x4 x4;
        if (R.xin_s) x4 = *(const f32x4*)(R.xin_s + (size_t)srow * D + col);
        else x4 = __builtin_convertvector(*(const h16x4*)(R.XH + (size_t)row * D + col), f32x4);
        const f32x4 xn = x4 + *(const f32x4*)(R.gate + b * D + col) * v;
        if (R.Xf) *(f32x4*)(R.Xf + (size_t)row * D + col) = xn; else *(h16x4*)(R.XH + (size_t)row * D + col) = __builtin_convertvector(xn, h16x4);
        if (R.SS) { float ss = (xn[0] * xn[0] + xn[1] * xn[1]) + (xn[2] * xn[2] + xn[3] * xn[3]);
            ss += shx(ss, 1, lane); ss += shx(ss, 2, lane); ss += shx(ss, 4, lane); ss += shx(ss, 8, lane);
            if (c4 == 0) unsafeAtomicAdd(R.SS + row, ss); }
        if (R.A1) { const f32x4 a = xn * *(const f32x4*)(R.g1 + b * D + col); u32x2 w; w.x = pk_bf16(a[0], a[1]); w.y = pk_bf16(a[2], a[3]); *(u32x2*)(R.A1 + (size_t)row * D + col) = w; }
        if (R.A2) { const f32x4 a = xn * *(const f32x4*)(R.g2 + b * D + col); u32x2 w; w.x = pk_bf16(a[0], a[1]); w.y = pk_bf16(a[2], a[3]); *(u32x2*)(R.A2 + (size_t)row * D + col) = w; }
    } else {
        const int d = 4 * c4, phys = 256 * (ct >> 2) + 32 * (ct & 3) + 128 * (d >> 5) + (d & 31);
        const float rs = pg8::rstd_of(H.SS[row]);
        f32x4 q = v * rs + *(const f32x4*)(H.bias + (size_t)b * D + phys);
        float ss = (q[0] * q[0] + q[1] * q[1]) + (q[2] * q[2] + q[3] * q[3]);
        ss += shx(ss, 1, lane); ss += shx(ss, 2, lane); ss += shx(ss, 4, lane); ss += shx(ss, 8, lane);
        const float hr = 1.0f / sqrtf(ss * (1.0f / HD) + EPS);
        q = q * (hr * H.oscale) * *(const f32x4*)(H.gvec + d);
        u32x2 w; w.x = pk_bf16(q[0], q[1]); w.y = pk_bf16(q[2], q[3]); *(u32x2*)(H.O + (size_t)row * D + 64 * ct + d) = w;
    }
    LDS_WAIT(); __syncthreads();
}
}

namespace att {
constexpr int SLOTB = 8192;
constexpr int L_K = 0, L_V = 3 * SLOTB, L_WS = 6 * SLOTB, L_OST = L_WS + 8 * 256, L_BYTES = L_OST + 8 * 4096;
constexpr float LOG2E = 1.4426950408889634f, C2 = 0.125f * LOG2E, NEG = -1e30f;
__device__ __forceinline__ int crow(int r, int hi) { return (r & 3) + 8 * (r >> 2) + 4 * hi; }
typedef short v4i16_t __attribute__((ext_vector_type(4)));
__device__ __forceinline__ s16x4 vtr(const LAS unsigned char* p) { return __builtin_bit_cast(s16x4, __builtin_amdgcn_ds_read_tr16_b64_v4i16((LAS v4i16_t*)p)); }

__device__ __forceinline__ void attn_unit(LAS unsigned char* lds, const int tid, int bidx, int c, int g, const bf16_t* Q, bf16_t* O, const bf16_t* Kb, const bf16_t* Vb, const bf16_t* KC, const bf16_t* VC, const float* sinks, unsigned* cnt, int wseam, int pseam) {
    const int lane = tid & 63, r32 = lane & 31, hi = lane >> 5; const int wid = __builtin_amdgcn_readfirstlane(tid >> 6);
    int row0, nq; const bf16_t* kp[3]; const bf16_t* vp[3]; int nv[3];
    if (bidx < NBP) {
        row0 = bidx * SEQ + 64 * c; nq = 64;
#pragma unroll
        for (int s = 0; s < 3; ++s) { const int tc = c - 2 + s; nv[s] = tc >= 0 ? 64 : 0; const int tcc = tc >= 0 ? tc : 0; kp[s] = Kb + (size_t)(bidx * SEQ + 64 * tcc) * KVD; vp[s] = Vb + (size_t)(bidx * SEQ + 64 * tcc) * KVD; }
    } else {
        const int bs = bidx - NBP; row0 = MP + bs * LS; nq = LS;
        kp[0] = KC + (size_t)(bs * WIN) * KVD; kp[1] = kp[0] + 64 * KVD; kp[2] = Kb + (size_t)row0 * KVD;
        vp[0] = VC + (size_t)(bs * WIN) * KVD; vp[1] = vp[0] + 64 * KVD; vp[2] = Vb + (size_t)row0 * KVD;
        nv[0] = 64; nv[1] = 64; nv[2] = LS;
    }
    const int panel = row0 >> 8;
    if (wseam >= 0) {
        if (wid == 0) { pg8::dep_poll(cnt, wseam, panel, 32u); __builtin_amdgcn_fence(__ATOMIC_ACQUIRE, "agent"); asm volatile("s_waitcnt vmcnt(0)" ::: "memory"); }
        asm volatile("" ::: "memory"); __builtin_amdgcn_s_barrier(); asm volatile("" ::: "memory");
    }
#pragma unroll
    for (int s = 0; s < 3; ++s) if (nv[s] > 0) {
        const bf16_t* ks = kp[s] + (size_t)lane * KVD + g * HD + wid * 8;
        const bf16_t* vs = vp[s] + (size_t)(16 * (wid & 3) + (lane >> 2)) * KVD + g * HD + (wid >> 2) * 32 + (lane & 3) * 8;
        __builtin_amdgcn_global_load_lds((const unsigned*)ks, (LAS unsigned*)(lds + L_K + s * SLOTB + wid * 1024), 16, 0, 0);
        __builtin_amdgcn_global_load_lds((const unsigned*)vs, (LAS unsigned*)(lds + L_V + s * SLOTB + wid * 1024), 16, 0, 0);
    }
    const int head = 4 * g + (wid >> 1), qoff = 32 * (wid & 1);
    const bf16_t* Qw = Q + (size_t)(row0 + qoff + r32) * D + head * HD + hi * 8;
    bf16x8 qr[4];
#pragma unroll
    for (int d0 = 0; d0 < 4; ++d0) qr[d0] = *(const bf16x8*)(Qw + d0 * 16);
    const float sink2 = sinks[head] * LOG2E;
    asm volatile("s_waitcnt vmcnt(0)" ::: "memory"); __builtin_amdgcn_s_barrier(); asm volatile("" ::: "memory");
    f32x16 p[3][2];
    float mx = sink2;
#pragma unroll
    for (int s = 0; s < 3; ++s) if (nv[s] > 0) {
        const LAS unsigned char* kb = lds + L_K + s * SLOTB + hi * 1024 + r32 * 16;
        f32x16 p0 = {}, p1 = {};
#pragma unroll
        for (int d0 = 0; d0 < 4; ++d0) {
            const bf16x8 b0 = *(const LAS bf16x8*)(kb + d0 * 2048), b1 = *(const LAS bf16x8*)(kb + d0 * 2048 + 512);
            p0 = __builtin_amdgcn_mfma_f32_32x32x16_bf16(b0, qr[d0], p0, 0, 0, 0); p1 = __builtin_amdgcn_mfma_f32_32x32x16_bf16(b1, qr[d0], p1, 0, 0, 0);
        }
        if (nv[s] < 64) {
#pragma unroll
            for (int r = 0; r < 16; ++r) { const int kv = crow(r, hi); if (kv >= nv[s]) p0[r] = NEG; if (kv + 32 >= nv[s]) p1[r] = NEG; }
        }
#pragma unroll
        for (int r = 0; r < 16; ++r) mx = fmaxf(mx, fmaxf(p0[r], p1[r]));
        p[s][0] = p0; p[s][1] = p1;
    }
    mx = fmaxf(mx, shx(mx, 32, lane));
    float l = 0.f;
    u32x4 pw[3][4];
#pragma unroll
    for (int s = 0; s < 3; ++s) if (nv[s] > 0) {
#pragma unroll
        for (int h2 = 0; h2 < 2; ++h2) {
            f32x16 e;
#pragma unroll
            for (int r = 0; r < 16; ++r) { e[r] = __builtin_amdgcn_exp2f(p[s][h2][r] - mx); l += e[r]; }
#pragma unroll
            for (int q = 0; q < 2; ++q) { u32x4 w; w.x = pk_bf16(e[8 * q], e[8 * q + 1]); w.y = pk_bf16(e[8 * q + 2], e[8 * q + 3]); w.z = pk_bf16(e[8 * q + 4], e[8 * q + 5]); w.w = pk_bf16(e[8 * q + 6], e[8 * q + 7]); pw[s][2 * h2 + q] = w; }
        }
    }
    l += shx(l, 32, lane);
    l += __builtin_amdgcn_exp2f(sink2 - mx);
    f32x16 o[2]; o[0] = f32x16{}; o[1] = f32x16{};
    const LAS unsigned char* vb0 = lds + L_V + ((lane >> 4) & 1) * 32 + (lane & 3) * 8 + (4 * hi + ((lane & 15) >> 2)) * 64;
#pragma unroll
    for (int s = 0; s < 3; ++s) if (nv[s] > 0) {
#pragma unroll
        for (int ks = 0; ks < 4; ++ks) {
            const bf16x8 pa = __builtin_bit_cast(bf16x8, pw[s][ks]);
#pragma unroll
            for (int d0 = 0; d0 < 2; ++d0) {
                const s16x4 lo = vtr(vb0 + s * SLOTB + d0 * 4096 + ks * 1024), hh = vtr(vb0 + s * SLOTB + d0 * 4096 + ks * 1024 + 512);
                const bf16x8 vf = (bf16x8){lo[0], lo[1], lo[2], lo[3], hh[0], hh[1], hh[2], hh[3]};
                o[d0] = __builtin_amdgcn_mfma_f32_32x32x16_bf16(pa, vf, o[d0], 0, 0, 0);
            }
        }
        __builtin_amdgcn_sched_barrier(0);
    }
    LAS float* wsf = (LAS float*)(lds + L_WS) + wid * 64;
    if (hi == 0) wsf[r32] = l;
    LDS_WAIT();
    float rli[16];
#pragma unroll
    for (int r = 0; r < 16; ++r) rli[r] = __builtin_amdgcn_rcpf(wsf[crow(r, hi)]);
    LAS bf16_t* stg = (LAS bf16_t*)(lds + L_OST) + wid * 2048;
#pragma unroll
    for (int r = 0; r < 16; ++r) { const int orow = crow(r, hi);
#pragma unroll
        for (int d0 = 0; d0 < 2; ++d0) stg[orow * 64 + d0 * 32 + r32] = (bf16_t)(pk_bf16(o[d0][r] * rli[r], 0.f) & 0xffffu); }
    LDS_WAIT();
    const rsrc_t rw = mk_rsrc((const unsigned char*)O - WS_AB, (unsigned)WS_END);
#pragma unroll
    for (int i = 0; i < 4; ++i) { const int row = i * 8 + (lane >> 3), ch = lane & 7; const u32x4 v = *(const LAS u32x4*)(stg + row * 64 + ch * 8);
        if (qoff + row < nq) st16_wt(rw, (unsigned)WS_AB + ((unsigned)(row0 + qoff + row) * D + head * HD + ch * 8) * 2, v); }
    if (pseam >= 0) pg8::dep_publish(cnt, pseam, panel, lane);
    asm volatile("s_waitcnt lgkmcnt(0)" ::: "memory"); __builtin_amdgcn_s_barrier(); asm volatile("" ::: "memory");
}
}

constexpr int NWAVES = 8;
constexpr int RING_BYTES = 131072, LDSCTL_OFF = RING_BYTES, MISC_OFF = LDSCTL_OFF + 320, XIN_OFF = LDSCTL_OFF + 512, LDS_BYTES = 147456;

#define XB_TMO      128
#define XB_XCNT(j)  (256  + 64 * (j))
#define XB_XSUB(j)  (1280 + 64 * (j))
#define XB_XGEN(j)  (2304 + 64 * (j))
#define XB_TOP      3328
#define XB_TOPGEN   3392
#define XCD_BAR_WORDS 3456
#define XB_SPIN_CAP (1u << 18)
__device__ __forceinline__ unsigned xb_ld(unsigned* p)              { return __hip_atomic_load(p, __ATOMIC_RELAXED, __HIP_MEMORY_SCOPE_AGENT); }
__device__ __forceinline__ unsigned xb_add(unsigned* p, unsigned v) { return __hip_atomic_fetch_add(p, v, __ATOMIC_RELAXED, __HIP_MEMORY_SCOPE_AGENT); }
__device__ __forceinline__ unsigned xb_xcc_id() { return (unsigned)__builtin_amdgcn_s_getreg((3 << 11) | 20) & 0xFu; }
#define XB_SPIN(cond, bar) do { unsigned _sp = 0; while (cond) { __builtin_amdgcn_s_sleep(1); \
    if ((++_sp & 255u) == 0u) { if (xb_ld(&(bar)[XB_TMO])) break; if (_sp > XB_SPIN_CAP) { atomicAdd(&(bar)[XB_TMO], 1u); break; } } } } while (0)
struct XcdBarrier { unsigned* bar; unsigned x; volatile LAS unsigned* st; };
__device__ __forceinline__ XcdBarrier xcd_barrier_post(unsigned* bar, volatile LAS unsigned* st) {
    XcdBarrier b; b.bar = bar; b.x = xb_xcc_id(); b.st = st;
    if (threadIdx.x == 0) (void)xb_add(&bar[XB_XCNT(b.x)], 1u);
    return b;
}
__device__ __forceinline__ void xcd_barrier_complete(unsigned* bar, unsigned x, unsigned& nloc, unsigned& nx) {
    const unsigned G = gridDim.x * gridDim.y * gridDim.z;
    unsigned sum, cnt, mine, sp = 0u;
    for (;;) {
        sum = 0u; cnt = 0u; mine = 0u;
#pragma unroll
        for (unsigned j = 0; j < 16; ++j) { const unsigned c = xb_ld(&bar[XB_XCNT(j)]); sum += c; cnt += (c > 0u) ? 1u : 0u; mine = (j == x) ? c : mine; }
        if (sum == G) break;
        __builtin_amdgcn_s_sleep(1);
        if ((++sp & 255u) == 0u) { if (xb_ld(&bar[XB_TMO])) break; if (sp > XB_SPIN_CAP) { atomicAdd(&bar[XB_TMO], 1u); break; } }
    }
    nloc = mine > 0u ? mine : 1u; nx = cnt > 0u ? cnt : 1u;
}
__device__ __forceinline__ void xcd_barrier(const XcdBarrier& b, const int tid) {
    asm volatile("s_waitcnt vmcnt(0)" ::: "memory");
    __syncthreads();
    if (tid == 0) {
        unsigned* bar = b.bar;
        __builtin_amdgcn_s_waitcnt(0);
        unsigned nloc = b.st[0], nx = b.st[1];
        if (nloc == 0u) { xcd_barrier_complete(bar, b.x, nloc, nx); b.st[0] = nloc; b.st[1] = nx; }
        const unsigned old = xb_add(&bar[XB_XSUB(b.x)], 1u);
        const unsigned gen = old / nloc;
        if (old + 1u == (gen + 1u) * nloc) {
            __builtin_amdgcn_fence(__ATOMIC_RELEASE, "agent");
            asm volatile("s_waitcnt vmcnt(0)" ::: "memory");
            const unsigned og = xb_add(&bar[XB_TOP], 1u);
            const unsigned tg = og / nx;
            if (og + 1u == (tg + 1u) * nx) xb_add(&bar[XB_TOPGEN], 1u);
            else XB_SPIN(xb_ld(&bar[XB_TOPGEN]) == tg, bar);
            __builtin_amdgcn_fence(__ATOMIC_ACQUIRE, "agent");
            xb_add(&bar[XB_XGEN(b.x)], 1u);
            asm volatile("s_waitcnt vmcnt(0)" ::: "memory");
        } else {
            XB_SPIN(xb_ld(&bar[XB_XGEN(b.x)]) == gen, bar);
            __builtin_amdgcn_fence(__ATOMIC_ACQUIRE, "agent");
            asm volatile("s_waitcnt vmcnt(0)" ::: "memory");
        }
    }
    __syncthreads();
}

struct Args { const float* in[24]; float* out; unsigned char* ws; int ph_lo, ph_hi; };

struct Frame {
    LAS unsigned char* lds; int tid, lane, wave, vcu, G;
    float* out; unsigned char* ws;
};
#define FIN(i) (args.in[i])

__device__ __forceinline__ void transpose_item(const float* W, int ldn, int K, int k0, int s0, bf16_t* WT, int p0, LAS float* scr, int lane) {
    float wv[32];
    const float* wp = W + (size_t)(k0 + (lane >> 5)) * ldn + s0 + (lane & 31);
#pragma unroll
    for (int i = 0; i < 32; ++i) wv[i] = wp[(size_t)(2 * i) * ldn];
#pragma unroll
    for (int i = 0; i < 32; ++i) scr[(2 * i + (lane >> 5)) * 33 + (lane & 31)] = wv[i];
    LDS_WAIT(); asm volatile("" ::: "memory");
    const int c = lane & 7;
#pragma unroll
    for (int j = 0; j < 4; ++j) { const int n = (lane >> 3) + 8 * j; const LAS float* s = scr + (8 * c) * 33 + n;
        u32x4 o; o.x = pk_bf16(s[0 * 33], s[1 * 33]); o.y = pk_bf16(s[2 * 33], s[3 * 33]); o.z = pk_bf16(s[4 * 33], s[5 * 33]); o.w = pk_bf16(s[6 * 33], s[7 * 33]);
        *(u32x4*)(WT + (size_t)(p0 + n) * K + k0 + 8 * c) = o; }
    LDS_WAIT(); asm volatile("" ::: "memory");
}
__device__ __forceinline__ int headperm_src(int p0) { const int pn = p0 >> 8, bj = (p0 >> 7) & 1, wc = (p0 >> 5) & 3; return (4 * pn + wc) * HD + 32 * bj; }
__device__ __forceinline__ int swiglu_src(int p0) { const int pn = p0 >> 8, bj = (p0 >> 7) & 1, r = p0 & 127; return bj * DFF + 128 * pn + r; }

constexpr int CV_POOL = 2 * 4 * 4 * 8, CV_WQ = 2 * 16 * 32, CV_WO = 2 * 16 * 32, CV_WKV = 16 * 16, CV_WIN = 4 * 16 * 176, CV_WOUT = 4 * 44 * 32;
constexpr int CV_TOTAL = CV_POOL + CV_WQ + CV_WO + CV_WKV + CV_WIN + CV_WOUT;

__device__ __forceinline__ void convert_item(Frame& F, const Args& args, int it, LAS float* scr) {
    unsigned char* ws = F.ws;
    if (it < CV_POOL) {
        const int lg = it >> 5, r = it & 31, kb = r >> 3, nb = r & 7;
        transpose_item(FIN(11) + (size_t)lg * 65536, 256, 256, 64 * kb, 32 * nb, (bf16_t*)(ws + WS_WPOOL) + (size_t)lg * 65536, 32 * nb, scr, F.lane); return; }
    it -= CV_POOL;
    if (it < CV_WQ) { const int j = it >> 9, r = it & 511, kb = r >> 5, nb = r & 31;
        transpose_item(FIN(13) + (size_t)j * D * D, D, D, 64 * kb, headperm_src(32 * nb), (bf16_t*)(ws + WS_WQ) + (size_t)j * D * D, 32 * nb, scr, F.lane); return; }
    it -= CV_WQ;
    if (it < CV_WO) { const int j = it >> 9, r = it & 511, kb = r >> 5, nb = r & 31;
        transpose_item(FIN(16) + (size_t)j * D * D, D, D, 64 * kb, 32 * nb, (bf16_t*)(ws + WS_WO) + (size_t)j * D * D, 32 * nb, scr, F.lane); return; }
    it -= CV_WO;
    if (it < CV_WKV) { const int kb = it >> 4, nb = it & 15;
        transpose_item(FIN(20), 2 * KVD, D, 64 * kb, headperm_src(32 * nb), (bf16_t*)(ws + WS_WKV), 32 * nb, scr, F.lane); return; }
    it -= CV_WKV;
    if (it < CV_WIN) { const int l = it / (16 * 176), r = it % (16 * 176), kb = r / 176, nb = r % 176;
        transpose_item(FIN(22) + (size_t)l * D * NIN, NIN, D, 64 * kb, swiglu_src(32 * nb), (bf16_t*)(ws + WS_WIN) + (size_t)l * NIN * D, 32 * nb, scr, F.lane); return; }
    it -= CV_WIN;
    { const int l = it / (44 * 32), r = it % (44 * 32), kb = r >> 5, nb = r & 31;
        transpose_item(FIN(23) + (size_t)l * DFF * D, D, DFF, 64 * kb, 32 * nb, (bf16_t*)(ws + WS_WOUT) + (size_t)l * D * DFF, 32 * nb, scr, F.lane); }
}

constexpr int ADA_ITEMS = 4 * 48 + 16;
__device__ __forceinline__ void ada_item(Frame& F, const Args& args, int it) {
    LAS float* CA = (LAS float*)F.lds;
    LAS float* RED = (LAS float*)(F.lds + 49152);
    const float* W; const float* bias; float* out; int ldn, n0, ostride;
    if (it < 192) { const int l = it / 48; n0 = (it % 48) * 128; W = FIN(7) + (size_t)l * D * ADAW; ldn = ADAW; bias = FIN(8) + l * ADAW; out = (float*)(F.ws + WS_ADA) + (size_t)l * NBATCH * ADAW; ostride = ADAW; }
    else { n0 = (it - 192) * 128; W = FIN(18); ldn = 2 * D; bias = FIN(19); out = (float*)(F.ws + WS_ADAKV); ostride = 2 * D; }
    for (int idx = F.tid; idx < NBATCH * D; idx += NWAVES * 64) { const int b = idx >> 10, k = idx & 1023;
        const float c = b < NBP ? FIN(2)[b * D + k] : FIN(3)[(b - NBP) * D + k]; CA[k * 12 + b] = c / (1.0f + __expf(-c)); }
    LDS_WAIT(); __syncthreads();
    f32x2 acc[NBATCH];
#pragma unroll
    for (int b = 0; b < NBATCH; ++b) acc[b] = (f32x2){0.f, 0.f};
    const float* wp = W + (size_t)(F.wave * 128) * ldn + n0 + 2 * F.lane;
#pragma unroll 32
    for (int k = 0; k < 128; ++k) {
        const f32x2 wv = *(const f32x2*)(wp + (size_t)k * ldn);
        const LAS f32x4* cp = (const LAS f32x4*)(CA + (F.wave * 128 + k) * 12);
        const f32x4 c0 = cp[0], c1 = cp[1], c2 = cp[2];
        acc[0] += wv * c0[0]; acc[1] += wv * c0[1]; acc[2] += wv * c0[2]; acc[3] += wv * c0[3]; acc[4] += wv * c1[0];
        acc[5] += wv * c1[1]; acc[6] += wv * c1[2]; acc[7] += wv * c1[3]; acc[8] += wv * c2[0]; acc[9] += wv * c2[1];
    }
#pragma unroll
    for (int b = 0; b < NBATCH; ++b) *(LAS f32x2*)(RED + (F.wave * NBATCH + b) * 128 + 2 * F.lane) = acc[b];
    LDS_WAIT(); __syncthreads();
    for (int idx = F.tid; idx < NBATCH * 128; idx += NWAVES * 64) { const int b = idx >> 7, c = idx & 127; float s = bias[n0 + c];
#pragma unroll
        for (int w = 0; w < NWAVES; ++w) s += RED[(w * NBATCH + b) * 128 + c];
        out[(size_t)b * ostride + n0 + c] = s; }
    LDS_WAIT(); __syncthreads();
}

constexpr int BI_WIN = 4 * 44, BI_WQ = 2 * 8, BI_WKV = 4, BI_TOTAL = BI_WIN + BI_WQ + BI_WKV, SHP = D + 8;
__device__ __forceinline__ void bias_item(Frame& F, int it) {
    LAS bf16_t* SH = (LAS bf16_t*)F.lds;
    const bf16_t* W; const float* sh; int shs; float* out; int os, r0;
    if (it < BI_WIN) { const int l = it / 44; r0 = (it % 44) * 128; W = (const bf16_t*)(F.ws + WS_WIN) + (size_t)l * NIN * D; sh = (const float*)(F.ws + WS_ADA) + (size_t)l * NBATCH * ADAW + 3 * D; shs = ADAW;
        out = (float*)(F.ws + WS_BIN) + (size_t)l * NBATCH * NIN; os = NIN; }
    else if (it < BI_WIN + BI_WQ) { const int j = (it - BI_WIN) >> 3; r0 = ((it - BI_WIN) & 7) * 128; W = (const bf16_t*)(F.ws + WS_WQ) + (size_t)j * D * D; sh = (const float*)(F.ws + WS_ADA) + (size_t)(2 + j) * NBATCH * ADAW; shs = ADAW;
        out = (float*)(F.ws + WS_BQ) + (size_t)j * NBATCH * D; os = D; }
    else { r0 = (it - BI_WIN - BI_WQ) * 128; W = (const bf16_t*)(F.ws + WS_WKV); sh = (const float*)(F.ws + WS_ADAKV); shs = 2 * D; out = (float*)(F.ws + WS_BKV); os = 2 * KVD; }
    const bf16_t* wp = W + (size_t)(r0 + F.wave * 16 + (F.lane & 15)) * D + 8 * (F.lane >> 4);
    bf16x8 wf[32];
#pragma unroll
    for (int s_ = 0; s_ < 32; ++s_) wf[s_] = *(const bf16x8*)(wp + 32 * s_);
    for (int idx = F.tid; idx < 16 * D; idx += NWAVES * 64) { const int b = idx >> 10, k = idx & 1023; SH[b * SHP + k] = b < NBATCH ? (bf16_t)(pk_bf16(sh[(size_t)b * shs + k], 0.f) & 0xffffu) : (bf16_t)0; }
    LDS_WAIT(); __syncthreads();
    f32x4 acc = {0.f, 0.f, 0.f, 0.f};
    const LAS bf16_t* sp = SH + (F.lane & 15) * SHP + 8 * (F.lane >> 4);
#pragma unroll
    for (int s_ = 0; s_ < 32; ++s_) acc = __builtin_amdgcn_mfma_f32_16x16x32_bf16(*(const LAS bf16x8*)(sp + 32 * s_), wf[s_], acc, 0, 0, 0);
#pragma unroll
    for (int j = 0; j < 4; ++j) { const int b = 4 * (F.lane >> 4) + j; if (b < NBATCH) out[(size_t)b * os + r0 + F.wave * 16 + (F.lane & 15)] = acc[j]; }
    LDS_WAIT(); __syncthreads();
}

constexpr int PP_ITEMS = 2 * 128 + NBS;
__device__ __forceinline__ void pool_prep_item(Frame& F, const Args& args, int layer, int item, const float* xsrc_p, const float* xsrc_s, int pub_seam) {
    LAS float* RS = (LAS float*)F.lds;
    int bidx, t0, nrows, L, pos0, grow0; const float* xb; const float* hist; float* pout;
    if (item < 256) { bidx = item >> 7; t0 = (item & 127) * 64; nrows = 64; L = SEQ; pos0 = 0; grow0 = bidx * SEQ; xb = xsrc_p + (size_t)grow0 * D; hist = nullptr;
        pout = F.out + O_POOLP + (size_t)(layer * NBP + bidx) * PH * D; }
    else { const int bs = item - 256; bidx = NBP + bs; t0 = 0; nrows = LS; L = LS; pos0 = 4096; grow0 = MP + bs * LS; xb = xsrc_s + (size_t)(bs * LS) * D; hist = FIN(4) + (size_t)(layer * NBS + bs) * PH * D;
        pout = F.out + O_POOLS + (size_t)(layer * NBS + bs) * PH * D; }
    if (layer == 1) {
        const float* rss = (const float*)(F.ws + WS_SS) + (size_t)1 * MPAD + grow0;
        for (int e = F.tid; e < 15 + nrows; e += NWAVES * 64) { const int t = t0 - 15 + e; if (t >= 0) RS[e] = 1.0f / sqrtf(rss[t] * (1.0f / D) + EPS); }
    } else
    for (int e0 = F.wave; e0 < 15 + nrows; e0 += 5 * NWAVES) {
        f32x4 v[5][4];
#pragma unroll
        for (int q = 0; q < 5; ++q) { const int e = e0 + q * NWAVES, t = t0 - 15 + e; const bool ok = (e < 15 + nrows) && t >= 0; const f32x4* xr = (const f32x4*)(xb + (size_t)(ok ? t : t0) * D) + F.lane;
#pragma unroll
            for (int j = 0; j < 4; ++j) v[q][j] = xr[64 * j]; }
#pragma unroll
        for (int q = 0; q < 5; ++q) { const int e = e0 + q * NWAVES, t = t0 - 15 + e; float s_ = 0.f;
#pragma unroll
            for (int j = 0; j < 4; ++j) s_ += (v[q][j][0] * v[q][j][0] + v[q][j][1] * v[q][j][1]) + (v[q][j][2] * v[q][j][2] + v[q][j][3] * v[q][j][3]);
            s_ = wave_sum(s_, F.lane); if (F.lane == 0 && e < 15 + nrows && t >= 0) RS[e] = 1.0f / sqrtf(s_ * (1.0f / D) + EPS); }
    }
    LDS_WAIT(); __syncthreads();
    const int g = F.wave & 3, rh = F.wave >> 2, w = 2 << g, col = 256 * g + 4 * F.lane;
    const _Float16* xh = (const _Float16*)(F.ws + WS_XH) + (size_t)grow0 * D;
#define PP_LDX(t_) (layer == 1 ? __builtin_convertvector(*(const h16x4*)(xh + (size_t)(t_) * D + col), f32x4) : *(const f32x4*)(xb + (size_t)(t_) * D + col))
    if (32 * rh < nrows) {
        const float* ada = (const float*)(F.ws + WS_ADA) + ((size_t)layer * NBATCH + bidx) * ADAW;
        const f32x4 gm = *(const f32x4*)(FIN(9) + layer * D + col) * (*(const f32x4*)(ada + D + col) + 1.0f);
        const f32x4 sh = *(const f32x4*)(ada + col);
        const int tb = t0 + 32 * rh;
        const rsrc_t rw = mk_rsrc(F.ws, (unsigned)WS_END);
        const unsigned dout = (unsigned)WS_AB + ((unsigned)grow0 * D + col) * 2;
        f32x4 ring[16];
        ring[0] = (f32x4){0.f, 0.f, 0.f, 0.f};
#pragma unroll
        for (int j = 1; j < 16; ++j) { const int t = tb - 16 + j;
            if (t >= 0) ring[j] = PP_LDX(t) * RS[t - (t0 - 15)] * gm + sh;
            else if (hist) ring[j] = *(const f32x4*)(hist + (size_t)(15 + t) * D + col);
            else ring[j] = (f32x4){0.f, 0.f, 0.f, 0.f}; }
#pragma unroll
        for (int blk = 0; blk < 2; ++blk) if (32 * rh + 16 * blk < nrows) {
#pragma unroll
            for (int jj = 0; jj < 16; ++jj) { const int t = tb + 16 * blk + jj;
                const f32x4 h = PP_LDX(t) * RS[t - (t0 - 15)] * gm + sh;
                ring[jj] = h;
                f32x4 s = ring[jj] + ring[(jj + 15) & 15];
                if (w > 2) { s += ring[(jj + 14) & 15] + ring[(jj + 13) & 15];
                    if (w > 4) { s += (ring[(jj + 12) & 15] + ring[(jj + 11) & 15]) + (ring[(jj + 10) & 15] + ring[(jj + 9) & 15]);
                        if (w > 8) s += ((ring[(jj + 8) & 15] + ring[(jj + 7) & 15]) + (ring[(jj + 6) & 15] + ring[(jj + 5) & 15])) + ((ring[(jj + 4) & 15] + ring[(jj + 3) & 15]) + (ring[(jj + 2) & 15] + ring[(jj + 1) & 15])); } }
                const int cnt = min(w, pos0 + t + 1);
                const f32x4 d = s * (1.0f / (float)cnt) - h;
                u32x2 o; o.x = pk_bf16(d[0], d[1]); o.y = pk_bf16(d[2], d[3]);
                st8_wt(rw, dout + (unsigned)t * D * 2, o);
                if (t >= L - PH) *(f32x4*)(pout + (size_t)(t - (L - PH)) * D + col) = h; }
        }
    }
#undef PP_LDX
    if (pub_seam >= 0) pg8::dep_publish((unsigned*)(F.ws + WS_CTL) + CW_CNT, pub_seam, (grow0 + t0) >> 8, F.lane);
    LDS_WAIT(); __syncthreads();
}

__device__ __forceinline__ void ttable_item(Frame& F, const Args& args, int id) {
    const float* ADA = (const float*)(F.ws + WS_ADA); const float* ADAKV = (const float*)(F.ws + WS_ADAKV);
    float* T = (float*)(F.ws + WS_T) + (size_t)id * TV;
    for (int idx = F.tid; idx < TV; idx += NWAVES * 64) { const int b = idx >> 10, c = idx & 1023; float v;
        if (id < T_GAINF) { const int l = id - T_GATE1; v = ADA[((size_t)l * NBATCH + b) * ADAW + 2 * D + c]; if (l < 2) v *= FIN(12)[l * D + c]; }
        else if (id < T_GATE2) { const int l = id - T_GAINF; v = FIN(10)[l * D + c] * (1.0f + ADA[((size_t)l * NBATCH + b) * ADAW + 4 * D + c]); }
        else if (id < T_GAINQ) { const int l = id - T_GATE2; v = ADA[((size_t)l * NBATCH + b) * ADAW + 5 * D + c]; }
        else if (id < T_GAINKV) { const int l = 2 + id - T_GAINQ; v = FIN(9)[l * D + c] * (1.0f + ADA[((size_t)l * NBATCH + b) * ADAW + D + c]); }
        else v = FIN(17)[c] * (1.0f + ADAKV[(size_t)b * 2 * D + D + c]);
        T[idx] = v; }
}

#ifndef PH_MASK
#define PH_MASK 0x7ffff
#endif
__global__ void __launch_bounds__(NWAVES * 64, 2) yoco_fwd(Args args) {
    extern __shared__ __attribute__((aligned(16))) unsigned char lds_raw[];
    Frame F;
    F.lds = (LAS unsigned char*)lds_raw;
    F.tid = 0; F.lane = 0; F.wave = __builtin_amdgcn_readfirstlane((int)threadIdx.x >> 6);
    F.G = gridDim.x; { const int bx = blockIdx.x; int v_ = ((F.G & 7) == 0) ? (bx & 7) * (F.G >> 3) + (bx >> 3) : bx; asm volatile("" : "+s"(v_)); F.vcu = v_; }
    F.out = args.out; F.ws = args.ws;
    for (int u = threadIdx.x; u < (LDS_BYTES - LDSCTL_OFF) / 4; u += NWAVES * 64) ((LAS unsigned*)(F.lds + LDSCTL_OFF))[u] = 0u;
    __syncthreads();
    if (threadIdx.x == 0) { ((LAS unsigned long long*)(F.lds + XIN_OFF))[0] = (unsigned long long)FIN(0); ((LAS unsigned long long*)(F.lds + XIN_OFF))[1] = (unsigned long long)(FIN(1) - (size_t)MP * D); }
    __syncthreads();
    const int lo = args.ph_lo, hi = args.ph_hi;
    XcdBarrier bar; bar.bar = (unsigned*)(args.ws + WS_CTL) + CW_BAR; bar.x = 0; bar.st = nullptr;
    if (hi - lo > 1) bar = xcd_barrier_post((unsigned*)(args.ws + WS_CTL) + CW_BAR, (volatile LAS unsigned*)(F.lds + MISC_OFF) + 8);
#define WSP(T_, off) ((T_*)(wsl + (off)))
#pragma unroll 1
    for (int ph = lo; ph < hi; ++ph) {
        unsigned char* wsl = F.ws; asm volatile("" : "+s"(wsl));
        int lanel; asm volatile("v_mbcnt_lo_u32_b32 %0, -1, 0\n\tv_mbcnt_hi_u32_b32 %0, -1, %0" : "=v"(lanel));
        const int tidl = F.wave * 64 + lanel;
        Frame Fp = F; Fp.tid = tidl; Fp.lane = lanel; Fp.ws = wsl;
        const int layer = ph < 6 ? 0 : ph < 10 ? 1 : ph < 15 ? 2 : 3;
        int Gp = F.G; asm volatile("" : "+s"(Gp));
        unsigned* cnt = WSP(unsigned, WS_CTL) + CW_CNT;
        const bool solo = true;
        const int krot = ph == 7 ? 19 : ph == 12 ? 6 : ph == 17 ? 25 : ph == 2 ? 1 : ph == 4 ? 2 : ph == 6 ? 3 : ph == 8 ? 4 : ph == 9 ? 5 : ph == 11 ? 6 : ph == 13 ? 7 : ph == 14 ? 8 : ph == 16 ? 9 : ph == 18 ? 10 : 0;
        int crot = (int)blockIdx.x; asm volatile("" : "+s"(crot)); (void)krot;
        pg8::DepOrder S; S.cnt = cnt; S.wseam = -1; S.pseam = -1; S.need_p = 0; S.need_s = 0; S.wait_next = 0; S.last_pm = -1;
#define PHQ(k) (ph == (k) && ((PH_MASK >> (k)) & 1))
        if (PHQ(0)) {
            for (int it = F.vcu; it < ADA_ITEMS; it += F.G) ada_item(Fp, args, it);
            LAS float* scr = (LAS float*)(Fp.lds + Fp.wave * 16384);
            const int gw = F.vcu * NWAVES + Fp.wave, NGW = F.G * NWAVES;
            for (int it = gw; it < CV_TOTAL; it += NGW) convert_item(Fp, args, it, scr);
            const int gt = F.vcu * NWAVES * 64 + Fp.tid, NGT = F.G * NWAVES * 64;
            for (int i = gt; i < (RSS_N + 1) * MPAD / 4; i += NGT) WSP(f32x4, WS_SS)[i] = (f32x4){0.f, 0.f, 0.f, 0.f};
            for (int i = gt; i < 2 * NBS * WIN * KVD / 4; i += NGT) {
                const int which = i >= NBS * WIN * KVD / 4, j = which ? i - NBS * WIN * KVD / 4 : i;
                const f32x4 v = ((const f32x4*)(which ? FIN(6) : FIN(5)))[j];
                u32x2 o; o.x = pk_bf16(v[0], v[1]); o.y = pk_bf16(v[2], v[3]);
                (which ? WSP(u32x2, WS_VC) : WSP(u32x2, WS_KC))[j] = o;
                const int e = j * 4, bs = e / (WIN * KVD), r = (e / KVD) % WIN, cidx = e % KVD;
                if (r >= LS) *(f32x4*)(F.out + (which ? O_VS : O_KS) + ((size_t)bs * WIN + (r - LS)) * KVD + cidx) = v;
            }
        } else if (PHQ(1)) {
            for (int it = F.vcu; it < PP_ITEMS; it += F.G) pool_prep_item(Fp, args, 0, it, FIN(0), FIN(1), -1);
            for (int it = F.G - 1 - F.vcu; it < BI_TOTAL + T_NVEC; it += F.G) { if (it < BI_TOTAL) bias_item(Fp, it); else ttable_item(Fp, args, it - BI_TOTAL); }
        } else if (PHQ(5)) {
            for (int it = F.vcu; it < PP_ITEMS; it += F.G) pool_prep_item(Fp, args, 1, it, nullptr, nullptr, solo ? -1 : 5);
        } else if (PHQ(2)) {
            int kp = 256; asm volatile("" : "+s"(kp));
            const float* Tt = WSP(const float, WS_T);
            if (F.vcu < 64) { sk::Gemm sg{WSP(const bf16_t, WS_AB), D, 1, WSP(const bf16_t, WS_WPOOL), 256, 0};
                sk::Res sr{FIN(1), nullptr, WSP(_Float16, WS_XH), Tt + (T_GATE1 + 0) * TV, Tt + (T_GAINF + 0) * TV, nullptr, WSP(bf16_t, WS_AQ), nullptr, WSP(float, WS_SS) + (size_t)(0) * MPAD}; sk::Head sh{};
                sk::run<0>(Fp.lds, tidl, F.vcu, sg, sr, sh); }
            pg8::Gemm g{WSP(const bf16_t, WS_AB), WSP(const bf16_t, WS_WPOOL), D, 256, kp}; S.init(NTM - 1, 4, Gp, crot);
            if (!solo) S.pseam = 2;
            typedef pg8::EpiRes<true, 1, true> EP; EP E{Fp.lds + XIN_OFF, mk_rsrc(F.out, (unsigned)(O_END * 4)), mk_rsrc(wsl, (unsigned)WS_END), T_GATE1 + 0, T_GAINF + 0, 0, WSP(float, WS_SS) + (size_t)(0) * MPAD};
            pg8::gemm_phase<EP, pg8::DepOrder, true>(Fp.lds, tidl, g, S, E);
        } else if (PHQ(6)) {
            int kp = 256; asm volatile("" : "+s"(kp));
            if (F.vcu < 64) { const float* Tt = WSP(const float, WS_T); sk::Gemm sg{WSP(const bf16_t, WS_AB), D, 1, WSP(const bf16_t, WS_WPOOL) + (size_t)D * 256, 256, 0};
                sk::Res sr{nullptr, nullptr, WSP(_Float16, WS_XH), Tt + (T_GATE1 + 1) * TV, Tt + (T_GAINF + 1) * TV, nullptr, WSP(bf16_t, WS_AQ), nullptr, WSP(float, WS_SS) + (size_t)2 * MPAD}; sk::Head sh{};
                sk::run<0>(Fp.lds, tidl, F.vcu, sg, sr, sh); }
            pg8::Gemm g{WSP(const bf16_t, WS_AB), WSP(const bf16_t, WS_WPOOL) + (size_t)D * 256, D, 256, kp}; S.init(NTM - 1, 4, Gp, crot);
            typedef pg8::EpiRes<false, 1, true> EP; EP E{nullptr, mk_rsrc(F.out, (unsigned)(O_END * 4)), mk_rsrc(wsl, (unsigned)WS_END), T_GATE1 + 1, T_GAINF + 1, 0, WSP(float, WS_SS) + (size_t)2 * MPAD};
            pg8::gemm_phase<EP, pg8::DepOrder, true>(Fp.lds, tidl, g, S, E);
        } else if (PHQ(11) || PHQ(16)) {
            const bf16_t* Bw = WSP(const bf16_t, WS_WO) + (size_t)(layer - 2) * D * D; float* rssp = WSP(float, WS_SS) + (size_t)(2 * layer) * MPAD;
            if (F.vcu < 64) { const float* Tt = WSP(const float, WS_T); sk::Gemm sg{WSP(const bf16_t, WS_AB), D, 0, Bw, D, 0};
                sk::Res sr{nullptr, nullptr, WSP(_Float16, WS_XH), Tt + (T_GATE1 + layer) * TV, Tt + (T_GAINF + layer) * TV, nullptr, WSP(bf16_t, WS_AQ), nullptr, rssp}; sk::Head sh{};
                sk::run<0>(Fp.lds, tidl, F.vcu, sg, sr, sh); }
            pg8::Gemm g{WSP(const bf16_t, WS_AB), Bw, D, 0, D}; S.init(NTM - 1, 4, Gp, crot);
            typedef pg8::EpiRes<false, 1, true> EP; EP E{nullptr, mk_rsrc(F.out, (unsigned)(O_END * 4)), mk_rsrc(wsl, (unsigned)WS_END), T_GATE1 + layer, T_GAINF + layer, 0, rssp};
            pg8::gemm_phase<EP, pg8::DepOrder, true>(Fp.lds, tidl, g, S, E);
        } else if (PHQ(13)) {
            const bf16_t* Bw = WSP(const bf16_t, WS_WOUT) + (size_t)2 * D * DFF;
            if (F.vcu < 64) { const float* Tt = WSP(const float, WS_T); sk::Gemm sg{WSP(const bf16_t, WS_H), DFF, 0, Bw, DFF, 0};
                sk::Res sr{nullptr, nullptr, WSP(_Float16, WS_XH), Tt + (T_GATE2 + 2) * TV, Tt + (T_GAINQ + 1) * TV, nullptr, WSP(bf16_t, WS_AQ), nullptr, WSP(float, WS_SS) + (size_t)5 * MPAD}; sk::Head sh{};
                sk::run<0>(Fp.lds, tidl, F.vcu, sg, sr, sh); }
            pg8::Gemm g{WSP(const bf16_t, WS_H), Bw, DFF, 0, DFF}; S.init(NTM - 1, 4, Gp, crot);
            typedef pg8::EpiRes<false, 1, true> EP; EP E{nullptr, mk_rsrc(F.out, (unsigned)(O_END * 4)), mk_rsrc(wsl, (unsigned)WS_END), T_GATE2 + 2, T_GAINQ + 1, 0, WSP(float, WS_SS) + (size_t)5 * MPAD};
            pg8::gemm_phase<EP, pg8::DepOrder, true>(Fp.lds, tidl, g, S, E);
        } else if (PHQ(8)) {
            pg8::Gemm g{WSP(const bf16_t, WS_H), WSP(const bf16_t, WS_WOUT) + (size_t)1 * D * DFF, DFF, 0, DFF}; S.init(NTM - 1, 4, Gp, crot);
            if (F.vcu < 64) { const float* Tt = WSP(const float, WS_T); sk::Gemm sg{g.A, g.lda, 0, g.Bt, g.K, 0};
                sk::Res sr{nullptr, nullptr, WSP(_Float16, WS_XH), Tt + (T_GATE2 + 1) * TV, Tt + (T_GAINQ + 0) * TV, Tt + T_GAINKV * TV, WSP(bf16_t, WS_AQ), WSP(bf16_t, WS_AB), WSP(float, WS_SS) + (size_t)(3) * MPAD}; sk::Head sh{};
                sk::run<0>(Fp.lds, tidl, F.vcu, sg, sr, sh); }
            if (!solo) { S.wseam = 7; S.need_p = S.need_s = 22 * 8; S.pseam = 8; }
            typedef pg8::EpiRes<false, 2, true> EP; EP E{nullptr, mk_rsrc(F.out, (unsigned)(O_END * 4)), mk_rsrc(wsl, (unsigned)WS_END), T_GATE2 + 1, T_GAINQ + 0, T_GAINKV, WSP(float, WS_SS) + (size_t)(3) * MPAD};
            pg8::gemm_phase<EP, pg8::DepOrder, true>(Fp.lds, tidl, g, S, E);
        } else if (PHQ(4) || PHQ(18)) {
            pg8::Gemm g{WSP(const bf16_t, WS_H), WSP(const bf16_t, WS_WOUT) + (size_t)layer * D * DFF, DFF, 0, DFF}; S.init(NTM - 1, 4, Gp, crot);
            if (F.vcu < 64) { const float* Tt = WSP(const float, WS_T); sk::Gemm sg{g.A, g.lda, 0, g.Bt, g.K, 0};
                sk::Res sr{nullptr, ph == 18 ? F.out : nullptr, WSP(_Float16, WS_XH), Tt + (T_GATE2 + layer) * TV, nullptr, nullptr, nullptr, nullptr, ph == 4 ? WSP(float, WS_SS) + (size_t)1 * MPAD : nullptr}; sk::Head sh{};
                sk::run<0>(Fp.lds, tidl, F.vcu, sg, sr, sh); }
            if (!solo) { S.wseam = ph - 1; S.need_p = S.need_s = 22 * 8; }
            if (ph == 4) { typedef pg8::EpiRes<false, 0, true, false> EP; EP E{nullptr, mk_rsrc(F.out, (unsigned)(O_END * 4)), mk_rsrc(wsl, (unsigned)WS_END), T_GATE2 + layer, 0, 0, WSP(float, WS_SS) + (size_t)1 * MPAD};
                pg8::gemm_phase<EP, pg8::DepOrder, true>(Fp.lds, tidl, g, S, E); }
            else { typedef pg8::EpiRes<false, 0, false, true> EP; EP E{nullptr, mk_rsrc(F.out, (unsigned)(O_END * 4)), mk_rsrc(wsl, (unsigned)WS_END), T_GATE2 + layer, 0, 0, nullptr};
                pg8::gemm_phase<EP, pg8::DepOrder, true>(Fp.lds, tidl, g, S, E); }
        } else if (PHQ(3) || PHQ(7) || PHQ(12) || PHQ(17)) {
            pg8::Gemm g{WSP(const bf16_t, WS_AQ), WSP(const bf16_t, WS_WIN) + (size_t)layer * NIN * D, D, 0, D}; S.init(NTM, NIN / 256, Gp, crot);
            if (!solo) { S.wseam = ph - 1; S.need_p = S.need_s = 4 * 8; S.pseam = ph; }
            pg8::EpiSwiglu E{WSP(const float, WS_SS) + (size_t)(2 * layer) * MPAD, WSP(const float, WS_BIN) + (size_t)layer * NBATCH * NIN, mk_rsrc(wsl, (unsigned)WS_END)};
            pg8::gemm_phase<pg8::EpiSwiglu, pg8::DepOrder, true>(Fp.lds, tidl, g, S, E);
        } else if (PHQ(9) || PHQ(14)) {
            const int j = layer - 1;
            if (!solo) { S.wseam = ph - 1; S.need_p = S.need_s = 4 * 8; if (ph == 14) S.pseam = 14; }
            if (ph == 14 && F.vcu < 64) { sk::Gemm sg{WSP(const bf16_t, WS_AQ), D, 0, WSP(const bf16_t, WS_WQ) + (size_t)j * D * D, D, 1}; sk::Res sr{};
                sk::Head sh{WSP(const float, WS_SS) + (size_t)5 * MPAD, WSP(const float, WS_BQ) + (size_t)j * NBATCH * D, FIN(14) + j * HD, att::C2, WSP(bf16_t, WS_QO)};
                sk::run<1>(Fp.lds, tidl, F.vcu, sg, sr, sh); }
            { pg8::Gemm g{WSP(const bf16_t, WS_AQ), WSP(const bf16_t, WS_WQ) + (size_t)j * D * D, D, 0, D}; S.init(ph == 14 ? NTM - 1 : NTM, 4, Gp, crot);
              pg8::EpiHead<0> E{WSP(const float, WS_SS) + (size_t)(ph == 9 ? 3 : 5) * MPAD, WSP(const float, WS_BQ) + (size_t)j * NBATCH * D, D, FIN(14) + j * HD, att::C2, mk_rsrc(wsl, (unsigned)WS_END), nullptr, nullptr, nullptr, nullptr};
              pg8::gemm_phase<pg8::EpiHead<0>, pg8::DepOrder, true>(Fp.lds, tidl, g, S, E); }
            if (ph == 9) {
              pg8::Gemm g{WSP(const bf16_t, WS_AB), WSP(const bf16_t, WS_WKV), D, 0, D}; S.init(NTM, 2, Gp, Gp - 1 - crot); S.last_pm = -1;
              pg8::EpiHead<1> E{WSP(const float, WS_SS) + (size_t)3 * MPAD, WSP(const float, WS_BKV), 2 * KVD, FIN(21), 1.0f, mk_rsrc(wsl, (unsigned)WS_END), F.out + O_KP, F.out + O_VP, F.out + O_KS, F.out + O_VS};
              pg8::gemm_phase<pg8::EpiHead<1>, pg8::DepOrder, true>(Fp.lds, tidl, g, S, E); }
        } else if (PHQ(10) || PHQ(15)) {
            const int NU = NBP * 128 * NKV + NBS * NKV;
            const float* sk = FIN(15) + (layer - 2) * NH;
            const int ws_ = (!solo && ph == 15) ? 14 : -1, ps_ = solo ? -1 : ph;
            for (int u = F.vcu; u < NU; u += F.G) {
                int bidx, c, g;
                if (u < NBP * 128 * NKV) { g = u & 3; c = (u >> 2) & 127; bidx = u >> 9; } else { const int v = u - NBP * 128 * NKV; g = v & 3; c = 0; bidx = NBP + (v >> 2); }
                att::attn_unit(Fp.lds, tidl, bidx, c, g, WSP(const bf16_t, WS_QO), WSP(bf16_t, WS_AB), WSP(const bf16_t, WS_KB), WSP(const bf16_t, WS_VB), WSP(const bf16_t, WS_KC), WSP(const bf16_t, WS_VC), sk, cnt, ws_, ps_);
            }
        }
        if (ph + 1 < hi) xcd_barrier(bar, tidl);
    }
}

extern "C" void kernel_launch(void* const* d_in, const int* in_sizes, int n_in, void* d_out, int out_size, void* d_ws, size_t ws_size, hipStream_t stream) {
    static int grid = 0;
    if (grid == 0) {
        if (n_in != 24 || (size_t)out_size != O_END || ws_size < WS_END) { fprintf(stderr, "kernel_launch: unexpected sizes n_in %d out %d ws %zu\n", n_in, out_size, ws_size); grid = -1; return; }
        int dev = 0, cus = 0, per_cu = 0;
        if (hipGetDevice(&dev) != hipSuccess || hipDeviceGetAttribute(&cus, hipDeviceAttributeMultiprocessorCount, dev) != hipSuccess) { grid = -1; return; }
        if (hipFuncSetAttribute((const void*)yoco_fwd, hipFuncAttributeMaxDynamicSharedMemorySize, LDS_BYTES) != hipSuccess) { fprintf(stderr, "kernel_launch: hipFuncSetAttribute failed\n"); grid = -1; return; }
        if (hipOccupancyMaxActiveBlocksPerMultiprocessor(&per_cu, (const void*)yoco_fwd, NWAVES * 64, LDS_BYTES) != hipSuccess || per_cu < 1) { fprintf(stderr, "kernel_launch: occupancy query reports %d blocks per CU\n", per_cu); grid = -1; (void)hipGetLastError(); return; }
        grid = cus;
    }
    if (grid < 0) return;
    (void)hipMemsetAsync((char*)d_ws + WS_CTL, 0, CTL_ZERO_BYTES, stream);
    Args a{};
    for (int i = 0; i < 24; ++i) a.in[i] = (const float*)d_in[i];
    a.out = (float*)d_out; a.ws = (unsigned char*)d_ws;
#if MK_ONE_LAUNCH
    a.ph_lo = 0; a.ph_hi = NPHASE;
    hipLaunchKernelGGL(yoco_fwd, dim3(grid), dim3(NWAVES * 64), LDS_BYTES, stream, a);
#else
#ifndef DUP_MASK
#define DUP_MASK 0
#endif
#ifdef PRE_PHASE
    { a.ph_lo = PRE_PHASE; a.ph_hi = PRE_PHASE + 1; hipLaunchKernelGGL(yoco_fwd, dim3(grid), dim3(NWAVES * 64), LDS_BYTES, stream, a); }
#endif
    for (int p = 0; p < NPHASE; ++p) { a.ph_lo = p; a.ph_hi = p + 1; hipLaunchKernelGGL(yoco_fwd, dim3(grid), dim3(NWAVES * 64), LDS_BYTES, stream, a);
        if ((DUP_MASK >> p) & 1) hipLaunchKernelGGL(yoco_fwd, dim3(grid), dim3(NWAVES * 64), LDS_BYTES, stream, a); }
#endif
}
```

```cpp
#include <hip/hip_runtime.h>
#include <cstdio>
#include <cstdint>

#define LAS __attribute__((address_space(3)))
typedef unsigned short bf16_t;
typedef short bf16x8 __attribute__((ext_vector_type(8)));
typedef short s16x4 __attribute__((ext_vector_type(4)));
typedef float f32x2 __attribute__((ext_vector_type(2)));
typedef float f32x4 __attribute__((ext_vector_type(4)));
typedef float f32x16 __attribute__((ext_vector_type(16)));
typedef unsigned u32x2 __attribute__((ext_vector_type(2)));
typedef unsigned u32x4 __attribute__((ext_vector_type(4)));
typedef __bf16 bf16x2_t __attribute__((ext_vector_type(2)));
typedef _Float16 h16x4 __attribute__((ext_vector_type(4)));
typedef _Float16 h16x8 __attribute__((ext_vector_type(8)));
typedef float f32x8 __attribute__((ext_vector_type(8)));

#ifndef MK_ONE_LAUNCH
#define MK_ONE_LAUNCH 1
#define WT_AUX 0
#endif

constexpr int D = 1024, SEQ = 8192, NBP = 2, NBS = 8, LS = 16, NBATCH = 10;
constexpr int MP = NBP * SEQ, MS = NBS * LS, MREAL = MP + MS, NTM = 65, MPAD = NTM * 256;
constexpr int DFF = 2816, NIN = 2 * DFF, HD = 64, NH = 16, NKV = 4, KVD = NKV * HD, WIN = 128, PH = 15;
constexpr int ADAW = 6 * D;
constexpr float EPS = 1e-6f;
constexpr int NPHASE = 19;

constexpr size_t O_Y = 0, O_POOLP = (size_t)MREAL * D, O_KP = O_POOLP + 2 * NBP * PH * D, O_VP = O_KP + (size_t)NBP * WIN * KVD,
                 O_POOLS = O_VP + (size_t)NBP * WIN * KVD, O_KS = O_POOLS + 2 * NBS * PH * D, O_VS = O_KS + (size_t)NBS * WIN * KVD, O_END = O_VS + (size_t)NBS * WIN * KVD;

constexpr size_t MiB = 1u << 20;
constexpr size_t WS_CTL = 0, CTL_ZERO_BYTES = 1 * MiB;
constexpr size_t WS_ADA = 1 * MiB, WS_ADAKV = 2 * MiB, WS_BIN = 3 * MiB, WS_BQ = 4 * MiB, WS_BKV = 4 * MiB + 128 * 1024, WS_SS = 5 * MiB, WS_T = 7 * MiB;
constexpr int T_GATE1 = 0, T_GAINF = 4, T_GATE2 = 8, T_GAINQ = 12, T_GAINKV = 14, T_NVEC = 15, TV = NBATCH * D;
constexpr size_t WS_WPOOL = 8 * MiB, WS_WQ = 9 * MiB, WS_WO = 13 * MiB, WS_WKV = 17 * MiB, WS_WIN = 18 * MiB, WS_WOUT = 62 * MiB;
constexpr size_t WS_KC = 84 * MiB, WS_VC = 84 * MiB + 512 * 1024, WS_KB = 85 * MiB, WS_VB = 94 * MiB;
constexpr size_t WS_AQ = 104 * MiB, WS_AB = 137 * MiB, WS_QO = 170 * MiB, WS_H = 203 * MiB, WS_XH = 293 * MiB, WS_END = 326 * MiB;
constexpr int RSS_N = 7;
static_assert((size_t)(RSS_N + 1) * MPAD * 4 <= 2 * MiB, "rss"); static_assert((size_t)MPAD * D * 2 <= 33 * MiB && (size_t)MPAD * DFF * 2 <= 90 * MiB && (size_t)MPAD * KVD * 2 <= 9 * MiB && (size_t)MPAD * 16 * 4 <= 3 * MiB, "ws map");
constexpr int CW_BAR = 4096, CW_CNT = 8192;

__device__ __forceinline__ unsigned pk_bf16(float lo, float hi) { f32x2 v = {lo, hi}; bf16x2_t b = __builtin_convertvector(v, bf16x2_t); return __builtin_bit_cast(unsigned, b); }
__device__ __forceinline__ float bf_lo(unsigned u) { return __uint_as_float(u << 16); }
__device__ __forceinline__ float bf_hi(unsigned u) { return __uint_as_float(u & 0xffff0000u); }
__device__ __forceinline__ float shx(float v, int mask, int lane) { return __int_as_float(__builtin_amdgcn_ds_bpermute((lane ^ mask) << 2, __float_as_int(v))); }
__device__ __forceinline__ float wave_sum(float v, int lane) {
#pragma unroll
    for (int o = 1; o < 64; o <<= 1) v += shx(v, o, lane);
    return v;
}
__device__ __forceinline__ int batch_of(int row16) { return row16 < MP ? (row16 >> 13) : min(2 + ((row16 - MP) >> 4), NBATCH - 1); }
#ifndef WT_AUX
#define WT_AUX 16
#endif
typedef __amdgpu_buffer_rsrc_t rsrc_t;
__device__ __forceinline__ rsrc_t mk_rsrc(const void* p, unsigned bytes) { return __builtin_amdgcn_make_buffer_rsrc((void*)p, 0, (int)bytes, 0x00020000); }
__device__ __forceinline__ void st16_wt(rsrc_t r, unsigned off, u32x4 v) { __builtin_amdgcn_raw_buffer_store_b128(v, r, (int)off, 0, WT_AUX); }
__device__ __forceinline__ void st16f_wt(rsrc_t r, unsigned off, f32x4 v) { __builtin_amdgcn_raw_buffer_store_b128(__builtin_bit_cast(u32x4, v), r, (int)off, 0, WT_AUX); }
__device__ __forceinline__ void st8_wt(rsrc_t r, unsigned off, u32x2 v) { __builtin_amdgcn_raw_buffer_store_b64(v, r, (int)off, 0, WT_AUX); }
__device__ __forceinline__ void st4_wt(rsrc_t r, unsigned off, float v) { __builtin_amdgcn_raw_buffer_store_b32(__float_as_uint(v), r, (int)off, 0, WT_AUX); }
__device__ __forceinline__ u32x4 ld16u(rsrc_t r, unsigned off) { return __builtin_amdgcn_raw_buffer_load_b128(r, (int)off, 0, 0); }
__device__ __forceinline__ f32x4 ld16f(rsrc_t r, unsigned off) { return __builtin_bit_cast(f32x4, __builtin_amdgcn_raw_buffer_load_b128(r, (int)off, 0, 0)); }
#define LDS_WAIT() asm volatile("s_waitcnt lgkmcnt(0)" ::: "memory")
#define VM_WAIT() asm volatile("s_waitcnt vmcnt(0)" ::: "memory")

namespace pg8 {
constexpr int BM = 256, BK = 64, HALF = 128, HTB = HALF * BK * 2, STAGE_BYTES = 8 * HTB, NXCD = 8, WGM = 8;
__host__ __device__ __forceinline__ int lds_byte(int r, int c) { const int st = (r >> 4) * 2 + (c >> 5), rr = r & 15, cc = c & 31, ob = rr * 64 + cc * 2; return st * 1024 + (ob ^ (((ob >> 9) & 1) << 5)); }
__host__ __device__ __forceinline__ void stage_rc(int b, int& R, int& C) { const int st = b / 1024, sb = b % 1024, swz = sb ^ (((sb >> 9) & 1) << 5); R = (st >> 1) * 16 + swz / 64; C = (st & 1) * 32 + (swz % 64) / 2; }
__host__ __device__ __forceinline__ int perm32(int rho) { const int n = rho >> 4, i = rho & 15; return 8 * (i >> 2) + 4 * n + (i & 3); }

struct Unit { int pm, pn; };
struct Gemm { const bf16_t* A; const bf16_t* Bt; int lda; int a_pn_off; int K; };

struct StaticOrder {
    int nM, nN, nwg, G, c;
    __host__ __device__ void init(int nM_, int nN_, int G_, int c_) { nM = nM_; nN = nN_; nwg = nM * nN; G = G_; c = c_; }
    __host__ __device__ bool next(int i, Unit& u) const {
        const long L = (long)i * G + c; if (L >= nwg) return false;
        int wgid = (int)L; { const int q = nwg / NXCD, r = nwg % NXCD, xcd = wgid % NXCD, off = wgid / NXCD; wgid = (xcd < r ? xcd * (q + 1) : r * (q + 1) + (xcd - r) * q) + off; }
        const int nig = WGM * nN, gid = wgid / nig, fm = gid * WGM, gsz = (nM - fm) < WGM ? (nM - fm) : WGM;
        u.pm = fm + ((wgid % nig) % gsz); u.pn = (wgid % nig) / gsz; return true;
    }
};
constexpr int NPAN = 65;
__device__ __forceinline__ void dep_publish(unsigned* cnt, int seam, int pm, int lane) {
    asm volatile("s_waitcnt vmcnt(0)" ::: "memory");
    if (lane == 0) __hip_atomic_fetch_add(cnt + (size_t)(seam * NPAN + pm) * 64, 1u, __ATOMIC_RELAXED, __HIP_MEMORY_SCOPE_AGENT);
}
__device__ __forceinline__ void dep_poll(unsigned* cnt, int seam, int pm, unsigned need) {
    unsigned* p = cnt + (size_t)(seam * NPAN + pm) * 64;
    const unsigned long long t0 = __builtin_amdgcn_s_memrealtime();
    while ((unsigned)__builtin_amdgcn_readfirstlane(__hip_atomic_load(p, __ATOMIC_RELAXED, __HIP_MEMORY_SCOPE_AGENT)) < need) {
        if (__builtin_amdgcn_s_memrealtime() - t0 > 2000000ull) break;
        __builtin_amdgcn_s_sleep(2); }
}
struct DepOrder : StaticOrder {
    unsigned* cnt; int wseam, pseam; unsigned need_p, need_s; int wait_next; int last_pm;
    __device__ __forceinline__ void a_ready(const Unit& u, int wid) {
        if (wseam < 0 || u.pm == last_pm) return;
        if (wid == 0) {
            dep_poll(cnt, wseam, u.pm, u.pm == NPAN - 1 ? need_s : need_p);
            if (wait_next && u.pm + 1 < NPAN) dep_poll(cnt, wseam, u.pm + 1, u.pm + 1 == NPAN - 1 ? need_s : need_p);
            __builtin_amdgcn_fence(__ATOMIC_ACQUIRE, "agent");
            asm volatile("s_waitcnt vmcnt(0)" ::: "memory");
        }
        asm volatile("" ::: "memory"); __builtin_amdgcn_s_barrier(); asm volatile("" ::: "memory");
        last_pm = u.pm;
    }
    __device__ __forceinline__ void done(const Unit& u, int lane) const { if (pseam >= 0) dep_publish(cnt, pseam, u.pm, lane); }
};

template <class Epi, class Sched, bool ALIGN_EPI = false>
__device__ __forceinline__ void gemm_phase(LAS unsigned char* lds, const int tid, const Gemm g, Sched& S, const Epi& E) {
    const int wid = __builtin_amdgcn_readfirstlane(tid >> 6), lane = tid & 63, wr = wid >> 2, wc = wid & 3, fr = lane & 15, fq = lane >> 4;
    const int K = g.K, nt = K / BK, lda = g.lda;
    unsigned voffA[2], voffB[2];
#pragma unroll
    for (int i = 0; i < 2; ++i) { int R, C; stage_rc(tid * 16 + i * 8192, R, C); const int Rb = Epi::PERM ? ((R & ~31) + perm32(R & 31)) : R;
        voffA[i] = (unsigned)(R * lda + C) * 2u; voffB[i] = (unsigned)(Rb * K + C) * 2u; }
    const size_t kstep = (size_t)(BK * 2);
    const size_t hstepA = (size_t)HALF * lda * 2, hstepB = (size_t)HALF * K * 2;
    const size_t tstepA = 2 * hstepA, tstepB = 2 * hstepB;
    const unsigned ldsw = (unsigned)wid * 1024u;
    const int aoff = lds_byte(wr * 64 + fr, fq * 8), boff = lds_byte(wc * 32 + fr, fq * 8);
#define PG8_SA(b, h) (((b) * 2 + (h)) * HTB)
#define PG8_SB(b, h) ((4 + (b) * 2 + (h)) * HTB)
#define PG8_STAGE(bufoff, gbase, voff) do { _Pragma("unroll") for (int _i = 0; _i < 2; ++_i) \
        __builtin_amdgcn_global_load_lds((const unsigned*)((const char*)(gbase) + (voff)[_i]), (LAS unsigned*)(lds + (bufoff) + ldsw + _i * 8192), 16, 0, 0); } while (0)
#define PG8_LDA(dst, b, h) do { _Pragma("unroll") for (int m = 0; m < 4; ++m) _Pragma("unroll") for (int k = 0; k < 2; ++k) dst[m][k] = *(const LAS bf16x8*)(lds + PG8_SA(b, h) + aoff + m * 2048 + k * 1024); } while (0)
#define PG8_LDB(dst, b, h) do { _Pragma("unroll") for (int n = 0; n < 2; ++n) _Pragma("unroll") for (int k = 0; k < 2; ++k) dst[n][k] = *(const LAS bf16x8*)(lds + PG8_SB(b, h) + boff + n * 2048 + k * 1024); } while (0)
#define PG8_MMA(ai, bj, At, Bt) do { __builtin_amdgcn_s_setprio(1); _Pragma("unroll") for (int m = 0; m < 4; ++m) _Pragma("unroll") for (int n = 0; n < 2; ++n) _Pragma("unroll") for (int k = 0; k < 2; ++k) \
        acc[ai][bj][m][n] = __builtin_amdgcn_mfma_f32_16x16x32_bf16(Bt[n][k], At[m][k], acc[ai][bj][m][n], 0, 0, 0); __builtin_amdgcn_s_setprio(0); } while (0)
#define PG8_WAIT_V(n) asm volatile("s_waitcnt vmcnt(" #n ")" ::: "memory")
#define PG8_WAIT_L(n) asm volatile("s_waitcnt lgkmcnt(" #n ")" ::: "memory")
#define PG8_BAR __builtin_amdgcn_s_barrier()
#define PG8_SCHED __builtin_amdgcn_sched_barrier(0)
    Unit cur, nxt; int ui = 0;
    if (!S.next(0, cur)) return;
    f32x4 acc[2][2][4][2];
    const float zf = __int_as_float(tid >> 12);
#pragma unroll
    for (int a = 0; a < 2; ++a)
#pragma unroll
        for (int b = 0; b < 2; ++b)
#pragma unroll
            for (int m = 0; m < 4; ++m)
#pragma unroll
                for (int n = 0; n < 2; ++n) acc[a][b][m][n] = (f32x4){zf, zf, zf, zf};
    bf16x8 At[4][2], B0[2][2], B1[2][2];
    const char* cA = (const char*)g.A + (size_t)cur.pm * tstepA + (size_t)cur.pn * g.a_pn_off * 2; const char* cB = (const char*)g.Bt + (size_t)cur.pn * tstepB;
    S.a_ready(cur, wid);
    PG8_STAGE(PG8_SB(0, 0), cB, voffB); PG8_STAGE(PG8_SB(0, 1), cB + hstepB, voffB); PG8_STAGE(PG8_SA(0, 0), cA, voffA); PG8_STAGE(PG8_SA(0, 1), cA + hstepA, voffA);
    if (wr == 1) PG8_BAR;
    PG8_WAIT_V(2); PG8_BAR;
    PG8_STAGE(PG8_SB(1, 0), cB + kstep, voffB); PG8_STAGE(PG8_SA(1, 0), cA + kstep, voffA); PG8_STAGE(PG8_SB(1, 1), cB + hstepB + kstep, voffB);
    PG8_WAIT_V(6); PG8_BAR;
    for (;;) {
        const bool has_next = S.next(ui + 1, nxt);
        const char* nA = has_next ? (const char*)g.A + (size_t)nxt.pm * tstepA + (size_t)nxt.pn * g.a_pn_off * 2 : cA; const char* nB = has_next ? (const char*)g.Bt + (size_t)nxt.pn * tstepB : cB;
        for (int t = 0; t < nt; t += 2) {
            const bool last = (t == nt - 2);
            const char* a1 = cA + (size_t)(t + 1) * kstep;
            const char* a2 = last ? nA : cA + (size_t)(t + 2) * kstep; const char* b2 = last ? nB : cB + (size_t)(t + 2) * kstep;
            const char* a3 = a2 + kstep; const char* b3 = b2 + kstep;
            if (last && has_next) S.a_ready(nxt, wid);
            PG8_LDB(B0, 0, 0); PG8_LDB(B1, 0, 1); PG8_SCHED; PG8_LDA(At, 0, 0); PG8_STAGE(PG8_SA(1, 1), a1 + hstepA, voffA);
            PG8_WAIT_V(8); PG8_WAIT_L(0); PG8_BAR; PG8_MMA(0, 0, At, B0); PG8_MMA(0, 1, At, B1); PG8_BAR; PG8_SCHED;
            PG8_LDA(At, 0, 1); PG8_STAGE(PG8_SB(0, 0), b2, voffB); PG8_STAGE(PG8_SB(0, 1), b2 + hstepB, voffB); PG8_STAGE(PG8_SA(0, 0), a2, voffA);
            PG8_WAIT_V(8); PG8_WAIT_L(0); PG8_BAR; PG8_MMA(1, 0, At, B0); PG8_MMA(1, 1, At, B1); PG8_BAR; PG8_SCHED;
            PG8_LDB(B0, 1, 0); PG8_LDB(B1, 1, 1); PG8_SCHED; PG8_LDA(At, 1, 0); PG8_STAGE(PG8_SA(0, 1), a2 + hstepA, voffA);
            PG8_WAIT_V(8); PG8_WAIT_L(0); PG8_BAR; PG8_MMA(0, 0, At, B0); PG8_MMA(0, 1, At, B1); PG8_BAR; PG8_SCHED;
            PG8_LDA(At, 1, 1); PG8_STAGE(PG8_SB(1, 0), b3, voffB); PG8_STAGE(PG8_SB(1, 1), b3 + hstepB, voffB); PG8_STAGE(PG8_SA(1, 0), a3, voffA);
            PG8_WAIT_V(8); PG8_WAIT_L(0); PG8_BAR; PG8_MMA(1, 0, At, B0); PG8_MMA(1, 1, At, B1); PG8_BAR; PG8_SCHED;
        }
        if constexpr (ALIGN_EPI) { if (wr == 0) PG8_BAR; }
        E(acc, cur, wr, wc, fr, fq); S.done(cur, lane);
        if (!has_next) break;
#pragma unroll
        for (int a = 0; a < 2; ++a)
#pragma unroll
            for (int b = 0; b < 2; ++b)
#pragma unroll
                for (int m = 0; m < 4; ++m)
#pragma unroll
                    for (int n = 0; n < 2; ++n) acc[a][b][m][n] = (f32x4){zf, zf, zf, zf};
        cur = nxt; cA = nA; cB = nB; ++ui;
        if constexpr (ALIGN_EPI) { if (wr == 1) PG8_BAR; }
    }
    PG8_WAIT_V(0);
    if constexpr (!ALIGN_EPI) { if (wr == 0) PG8_BAR; }
    PG8_BAR;
#undef PG8_SA
#undef PG8_SB
#undef PG8_STAGE
#undef PG8_LDA
#undef PG8_LDB
#undef PG8_MMA
#undef PG8_WAIT_V
#undef PG8_WAIT_L
#undef PG8_BAR
#undef PG8_SCHED
}


template <bool XIN, int NA, bool HAS_SS, bool FINAL = false> struct EpiRes {
    static constexpr bool PERM = true;
    LAS const unsigned char* xin_lds;
    rsrc_t rx, rw;
    int gate_id, g1_id, g2_id; float* rss;
    __device__ __forceinline__ void operator()(const f32x4 (&acc)[2][2][4][2], const Unit& u, int wr, int wc, int fr, int fq) const {
        const unsigned colb = (unsigned)(u.pn * BM + wc * 32 + 8 * fq), toff = (unsigned)(u.pm >> 5) * D + colb;
        const unsigned gate = (unsigned)WS_T + ((unsigned)gate_id * TV + toff) * 4, g1 = (unsigned)WS_T + ((unsigned)g1_id * TV + toff) * 4, g2 = (unsigned)WS_T + ((unsigned)g2_id * TV + toff) * 4;
        const float* xo = nullptr;
        if (XIN) { const unsigned long long pv = ((const LAS unsigned long long*)xin_lds)[0];
            xo = (const float*)(((unsigned long long)(unsigned)__builtin_amdgcn_readfirstlane((int)(pv >> 32)) << 32) | (unsigned)__builtin_amdgcn_readfirstlane((int)pv)); }
        const unsigned row0 = (unsigned)(u.pm * BM + wr * 64 + fr);
        float ssq[8];
#pragma unroll
        for (int g_ = 0; g_ < 8; ++g_) ssq[g_] = 0.f;
#define E1_LOADX(dst, g_, bj_) do { const unsigned xoff_ = (row0 + ((g_) >> 2) * HALF + ((g_) & 3) * 16) * D + colb + (bj_) * HALF; \
            if (XIN) { const f32x4 t0_ = *(const f32x4*)(xo + xoff_), t1_ = *(const f32x4*)(xo + xoff_ + 4); dst = (f32x8){t0_[0], t0_[1], t0_[2], t0_[3], t1_[0], t1_[1], t1_[2], t1_[3]}; } \
            else dst = __builtin_convertvector(__builtin_bit_cast(h16x8, ld16u(rw, (unsigned)WS_XH + xoff_ * 2)), f32x8); } while (0)
#pragma unroll
        for (int bj = 0; bj < 2; ++bj) {
            f32x4 gt[2], ga[2], gb[2]; f32x8 xc, xn_;
#pragma unroll
            for (int n = 0; n < 2; ++n) { gt[n] = ld16f(rw, gate + (bj * HALF + 4 * n) * 4);
                if (NA >= 1) ga[n] = ld16f(rw, g1 + (bj * HALF + 4 * n) * 4);
                if (NA >= 2) gb[n] = ld16f(rw, g2 + (bj * HALF + 4 * n) * 4); }
            E1_LOADX(xc, 0, bj);
#pragma unroll
            for (int g_ = 0; g_ < 8; ++g_) {
                const int ai = g_ >> 2, m = g_ & 3;
                if (g_ < 7) E1_LOADX(xn_, g_ + 1, bj);
                const unsigned ooff = (row0 + ai * HALF + m * 16) * D + colb + bj * HALF;
                const f32x4 na = (f32x4){xc[0], xc[1], xc[2], xc[3]} + gt[0] * acc[ai][bj][m][0], nb = (f32x4){xc[4], xc[5], xc[6], xc[7]} + gt[1] * acc[ai][bj][m][1];
                if (FINAL) { st16f_wt(rx, ooff * 4, na); st16f_wt(rx, (ooff + 4) * 4, nb); }
                else { const h16x8 hv = __builtin_convertvector((f32x8){na[0], na[1], na[2], na[3], nb[0], nb[1], nb[2], nb[3]}, h16x8); st16_wt(rw, (unsigned)WS_XH + ooff * 2, __builtin_bit_cast(u32x4, hv)); }
                if (HAS_SS) ssq[g_] += ((na[0] * na[0] + na[1] * na[1]) + (na[2] * na[2] + na[3] * na[3])) + ((nb[0] * nb[0] + nb[1] * nb[1]) + (nb[2] * nb[2] + nb[3] * nb[3]));
                if (NA >= 1) { const f32x4 pa = na * ga[0], pb = nb * ga[1];
                    u32x4 w; w.x = pk_bf16(pa[0], pa[1]); w.y = pk_bf16(pa[2], pa[3]); w.z = pk_bf16(pb[0], pb[1]); w.w = pk_bf16(pb[2], pb[3]); st16_wt(rw, (unsigned)WS_AQ + ooff * 2, w); }
                if (NA >= 2) { const f32x4 pa = na * gb[0], pb = nb * gb[1];
                    u32x4 w; w.x = pk_bf16(pa[0], pa[1]); w.y = pk_bf16(pa[2], pa[3]); w.z = pk_bf16(pb[0], pb[1]); w.w = pk_bf16(pb[2], pb[3]); st16_wt(rw, (unsigned)WS_AB + ooff * 2, w); }
                asm volatile("" ::: "memory");
                xc = xn_;
            }
        }
        if (HAS_SS) {
#pragma unroll
            for (int g_ = 0; g_ < 8; ++g_) { float ss = ssq[g_]; ss += shx(ss, 16, fq * 16 + fr); ss += shx(ss, 32, fq * 16 + fr); if (fq == 0) unsafeAtomicAdd(rss + row0 + (g_ >> 2) * HALF + (g_ & 3) * 16, ss); }
        }
#undef E1_LOADX
    }
};

__device__ __forceinline__ float rstd_of(float sumsq) { return 1.0f / sqrtf(sumsq * (1.0f / D) + EPS); }
__device__ __forceinline__ float silu_f(float g) { return g * __builtin_amdgcn_rcpf(1.0f + __builtin_amdgcn_exp2f(-1.4426950408889634f * g)); }

struct EpiSwiglu {
    static constexpr bool PERM = true;
    const float* rss; const float* bias;
    rsrc_t rw;
    __device__ __forceinline__ void operator()(const f32x4 (&acc)[2][2][4][2], const Unit& u, int wr, int wc, int fr, int fq) const {
        const int pc = u.pn * BM + wc * 32 + 8 * fq;
        const bool prompt = u.pm < MP / BM;
        const unsigned row0 = (unsigned)(u.pm * BM + wr * 64 + fr);
        float rs[8];
#pragma unroll
        for (int g_ = 0; g_ < 8; ++g_) rs[g_] = rss[row0 + (g_ >> 2) * HALF + (g_ & 3) * 16];
        f32x4 bg[2], bu[2];
        { const float* bp = bias + (size_t)(prompt ? (u.pm >> 5) : NBP) * NIN + pc;
#pragma unroll
          for (int n = 0; n < 2; ++n) { bg[n] = *(const f32x4*)(bp + 4 * n); bu[n] = *(const f32x4*)(bp + HALF + 4 * n); } }
#pragma unroll
        for (int g_ = 0; g_ < 8; ++g_) {
            const int ai = g_ >> 2, m = g_ & 3;
            const unsigned row = row0 + ai * HALF + m * 16;
            if (!prompt) { const float* bp = bias + (size_t)batch_of((int)(row - fr)) * NIN + pc;
#pragma unroll
                for (int n = 0; n < 2; ++n) { bg[n] = *(const f32x4*)(bp + 4 * n); bu[n] = *(const f32x4*)(bp + HALF + 4 * n); } }
            const float r = rstd_of(rs[g_]);
            u32x4 w;
#pragma unroll
            for (int n = 0; n < 2; ++n) {
                const f32x4 gv = acc[ai][0][m][n] * r + bg[n], uv = acc[ai][1][m][n] * r + bu[n];
                const float h0 = silu_f(gv[0]) * uv[0], h1 = silu_f(gv[1]) * uv[1], h2 = silu_f(gv[2]) * uv[2], h3 = silu_f(gv[3]) * uv[3];
                if (n == 0) { w.x = pk_bf16(h0, h1); w.y = pk_bf16(h2, h3); } else { w.z = pk_bf16(h0, h1); w.w = pk_bf16(h2, h3); }
            }
            st16_wt(rw, (unsigned)WS_H + (row * DFF + u.pn * HALF + wc * 32 + 8 * fq) * 2, w);
        }
    }
};

template <int MODE> struct EpiHead {
    static constexpr bool PERM = true;
    const float* rss; const float* bias; int bias_stride; const float* gvec; float oscale;
    rsrc_t rw; float* fk_p; float* fv_p; float* fk_s; float* fv_s;
    __device__ __forceinline__ void operator()(const f32x4 (&acc)[2][2][4][2], const Unit& u, int wr, int wc, int fr, int fq) const {
        const bool isv = (MODE == 1) && (u.pn == 1);
        const int ldo = (MODE == 0) ? D : KVD;
        const int ocol = (MODE == 0 ? (4 * u.pn + wc) * HD : wc * HD) + 8 * fq;
        const unsigned Ob = (MODE == 0) ? (unsigned)WS_QO : (isv ? (unsigned)WS_VB : (unsigned)WS_KB);
        const bool prompt = u.pm < MP / BM;
        float rsv[8];
#pragma unroll
        for (int g_ = 0; g_ < 8; ++g_) rsv[g_] = rss[u.pm * BM + wr * 64 + fr + (g_ >> 2) * HALF + (g_ & 3) * 16];
        f32x4 bv[2][2];
        { const float* bp = bias + (size_t)(prompt ? (u.pm >> 5) : NBP) * bias_stride + u.pn * BM + wc * 32 + 8 * fq;
#pragma unroll
          for (int bj = 0; bj < 2; ++bj)
#pragma unroll
              for (int n = 0; n < 2; ++n) bv[bj][n] = *(const f32x4*)(bp + bj * HALF + 4 * n); }
#pragma unroll
        for (int ai = 0; ai < 2; ++ai)
#pragma unroll
            for (int m = 0; m < 4; ++m) {
                const int row16 = u.pm * BM + ai * HALF + wr * 64 + m * 16, row = row16 + fr;
                const float rs = rstd_of(rsv[ai * 4 + m]);
                if (!prompt) { const float* bp = bias + (size_t)batch_of(row16) * bias_stride + u.pn * BM + wc * 32 + 8 * fq;
#pragma unroll
                    for (int bj = 0; bj < 2; ++bj)
#pragma unroll
                        for (int n = 0; n < 2; ++n) bv[bj][n] = *(const f32x4*)(bp + bj * HALF + 4 * n); }
                f32x4 v[2][2]; float ss = 0.f;
#pragma unroll
                for (int bj = 0; bj < 2; ++bj)
#pragma unroll
                    for (int n = 0; n < 2; ++n) { v[bj][n] = acc[ai][bj][m][n] * rs + bv[bj][n];
                        ss += (v[bj][n][0] * v[bj][n][0] + v[bj][n][1] * v[bj][n][1]) + (v[bj][n][2] * v[bj][n][2] + v[bj][n][3] * v[bj][n][3]); }
                ss += shx(ss, 16, fq * 16 + fr); ss += shx(ss, 32, fq * 16 + fr);
                const float hr = 1.0f / sqrtf(ss * (1.0f / HD) + EPS);
                if (!isv) {
#pragma unroll
                    for (int bj = 0; bj < 2; ++bj)
#pragma unroll
                        for (int n = 0; n < 2; ++n) v[bj][n] = v[bj][n] * (hr * oscale) * *(const f32x4*)(gvec + 32 * bj + 8 * fq + 4 * n);
                }
                float* ftail = nullptr;
                if (MODE == 1) {
                    if (row < MP) { const int t = row & (SEQ - 1); if (t >= SEQ - WIN) ftail = (isv ? fv_p : fk_p) + ((size_t)(row >> 13) * WIN + (t - (SEQ - WIN))) * KVD; }
                    else if (row < MREAL) { const int bs = (row - MP) >> 4, t = (row - MP) & 15; ftail = (isv ? fv_s : fk_s) + ((size_t)bs * WIN + (WIN - LS) + t) * KVD; }
                }
#pragma unroll
                for (int bj = 0; bj < 2; ++bj) {
                    u32x4 w; w.x = pk_bf16(v[bj][0][0], v[bj][0][1]); w.y = pk_bf16(v[bj][0][2], v[bj][0][3]); w.z = pk_bf16(v[bj][1][0], v[bj][1][1]); w.w = pk_bf16(v[bj][1][2], v[bj][1][3]);
                    st16_wt(rw, Ob + ((unsigned)row * ldo + ocol + 32 * bj) * 2, w);
                    if (MODE == 1) { if (ftail) { *(f32x4*)(ftail + ocol + 32 * bj) = v[bj][0]; *(f32x4*)(ftail + ocol + 32 * bj + 4) = v[bj][1]; } }
                }
                asm volatile("" ::: "memory");
            }
    }
};
}

namespace sk {
struct Gemm { const bf16_t* A; int lda; int a_grp; const bf16_t* Bt; int K; int headperm; };
struct Res { const float* xin_s; float* Xf; _Float16* XH; const float* gate; const float* g1; const float* g2; bf16_t* A1; bf16_t* A2; float* SS; };
struct Head { const float* SS; const float* bias; const float* gvec; float oscale; bf16_t* O; };

template <int KIND> __device__ __forceinline__ void run(LAS unsigned char* lds, int tid, int tile, const Gemm g, const Res R, const Head H) {
    const int lane = tid & 63, wid = __builtin_amdgcn_readfirstlane(tid >> 6), fr = lane & 15, fq = lane >> 4;
    const int rt = tile & 3, ct = tile >> 2, K = g.K, kw = K >> 3, nst = kw >> 5;
    const bf16_t* ap = g.A + (size_t)(MP + 32 * rt + fr) * g.lda + (g.a_grp ? 256 * (ct >> 2) : 0) + wid * kw + 8 * fq;
    const int brow0 = g.headperm ? 256 * (ct >> 2) + 32 * (ct & 3) : 64 * ct;
    const bf16_t* bp = g.Bt + (size_t)(brow0 + fr) * K + wid * kw + 8 * fq;
    const size_t bst1 = (size_t)16 * K, bst2 = g.headperm ? (size_t)128 * K : (size_t)32 * K;
    f32x4 acc[2][4];
#pragma unroll
    for (int mi = 0; mi < 2; ++mi)
#pragma unroll
        for (int ni = 0; ni < 4; ++ni) acc[mi][ni] = (f32x4){0.f, 0.f, 0.f, 0.f};
    for (int s0 = 0; s0 < nst; s0 += 4) {
        bf16x8 af[4][2], bf[4][4];
#pragma unroll
        for (int q = 0; q < 4; ++q) { const int s_ = (s0 + q < nst) ? s0 + q : s0;
#pragma unroll
            for (int mi = 0; mi < 2; ++mi) af[q][mi] = *(const bf16x8*)(ap + (size_t)(16 * mi) * g.lda + 32 * s_);
#pragma unroll
            for (int ni = 0; ni < 4; ++ni) bf[q][ni] = *(const bf16x8*)(bp + (ni & 1) * bst1 + (ni >> 1) * bst2 + 32 * s_); }
#pragma unroll
        for (int q = 0; q < 4; ++q) if (s0 + q < nst) {
#pragma unroll
            for (int mi = 0; mi < 2; ++mi)
#pragma unroll
                for (int ni = 0; ni < 4; ++ni) acc[mi][ni] = __builtin_amdgcn_mfma_f32_16x16x32_bf16(bf[q][ni], af[q][mi], acc[mi][ni], 0, 0, 0); }
    }
    LAS f32x4* red = (LAS f32x4*)lds;
#pragma unroll
    for (int mi = 0; mi < 2; ++mi)
#pragma unroll
        for (int ni = 0; ni < 4; ++ni) red[(wid * 8 + mi * 4 + ni) * 64 + lane] = acc[mi][ni];
    LDS_WAIT(); __syncthreads();
    const int rl = 4 * wid + (lane >> 4), c4 = lane & 15;
    f32x4 v = {0.f, 0.f, 0.f, 0.f};
    { const int idx = ((rl >> 4) * 4 + (c4 >> 2)) * 64 + (c4 & 3) * 16 + (rl & 15);
#pragma unroll
      for (int w = 0; w < 8; ++w) v += red[w * 512 + idx]; }
    const int srow = 32 * rt + rl, row = MP + srow, b = NBP + (srow >> 4), col = 64 * ct + 4 * c4;
    if (KIND == 0) {
        f32x4 x4;
        if (R.xin_s) x4 = *(const f32x4*)(R.xin_s + (size_t)srow * D + col);
        else x4 = __builtin_convertvector(*(const h16x4*)(R.XH + (size_t)row * D + col), f32x4);
        const f32x4 xn = x4 + *(const f32x4*)(R.gate + b * D + col) * v;
        if (R.Xf) *(f32x4*)(R.Xf + (size_t)row * D + col) = xn; else *(h16x4*)(R.XH + (size_t)row * D + col) = __builtin_convertvector(xn, h16x4);
        if (R.SS) { float ss = (xn[0] * xn[0] + xn[1] * xn[1]) + (xn[2] * xn[2] + xn[3] * xn[3]);
            ss += shx(ss, 1, lane); ss += shx(ss, 2, lane); ss += shx(ss, 4, lane); ss += shx(ss, 8, lane);
            if (c4 == 0) unsafeAtomicAdd(R.SS + row, ss); }
        if (R.A1) { const f32x4 a = xn * *(const f32x4*)(R.g1 + b * D + col); u32x2 w; w.x = pk_bf16(a[0], a[1]); w.y = pk_bf16(a[2], a[3]); *(u32x2*)(R.A1 + (size_t)row * D + col) = w; }
        if (R.A2) { const f32x4 a = xn * *(const f32x4*)(R.g2 + b * D + col); u32x2 w; w.x = pk_bf16(a[0], a[1]); w.y = pk_bf16(a[2], a[3]); *(u32x2*)(R.A2 + (size_t)row * D + col) = w; }
    } else {
        const int d = 4 * c4, phys = 256 * (ct >> 2) + 32 * (ct & 3) + 128 * (d >> 5) + (d & 31);
        const float rs = pg8::rstd_of(H.SS[row]);
        f32x4 q = v * rs + *(const f32x4*)(H.bias + (size_t)b * D + phys);
        float ss = (q[0] * q[0] + q[1] * q[1]) + (q[2] * q[2] + q[3] * q[3]);
        ss += shx(ss, 1, lane); ss += shx(ss, 2, lane); ss += shx(ss, 4, lane); ss += shx(ss, 8, lane);
        const float hr = 1.0f / sqrtf(ss * (1.0f / HD) + EPS);
        q = q * (hr * H.oscale) * *(const f32x4*)(H.gvec + d);
        u32x2 w; w.x = pk_bf16(q[0], q[1]); w.y = pk_bf16(q[2], q[3]); *(u32x2*)(H.O + (size_t)row * D + 64 * ct + d) = w;
    }
    LDS_WAIT(); __syncthreads();
}
}

namespace att {
constexpr int SLOTB = 8192;
constexpr int L_K = 0, L_V = 3 * SLOTB, L_WS = 6 * SLOTB, L_OST = L_WS + 8 * 256, L_BYTES = L_OST + 8 * 4096;
constexpr float LOG2E = 1.4426950408889634f, C2 = 0.125f * LOG2E, NEG = -1e30f;
__device__ __forceinline__ int crow(int r, int hi) { return (r & 3) + 8 * (r >> 2) + 4 * hi; }
typedef short v4i16_t __attribute__((ext_vector_type(4)));
__device__ __forceinline__ s16x4 vtr(const LAS unsigned char* p) { return __builtin_bit_cast(s16x4, __builtin_amdgcn_ds_read_tr16_b64_v4i16((LAS v4i16_t*)p)); }

struct UnitDesc { int row0, nq, g; const bf16_t* kp[3]; const bf16_t* vp[3]; int nv[3]; };
__device__ __forceinline__ UnitDesc decode(int u, const bf16_t* Kb, const bf16_t* Vb, const bf16_t* KC, const bf16_t* VC) {
    UnitDesc d; int bidx, c;
    if (u < NBP * 128 * NKV) { d.g = u & 3; c = (u >> 2) & 127; bidx = u >> 9; } else { const int v = u - NBP * 128 * NKV; d.g = v & 3; c = 0; bidx = NBP + (v >> 2); }
    if (bidx < NBP) {
        d.row0 = bidx * SEQ + 64 * c; d.nq = 64;
#pragma unroll
        for (int s = 0; s < 3; ++s) { const int tc = c - 2 + s; d.nv[s] = tc >= 0 ? 64 : 0; const int tcc = tc >= 0 ? tc : 0; d.kp[s] = Kb + (size_t)(bidx * SEQ + 64 * tcc) * KVD; d.vp[s] = Vb + (size_t)(bidx * SEQ + 64 * tcc) * KVD; }
    } else {
        const int bs = bidx - NBP; d.row0 = MP + bs * LS; d.nq = LS;
        d.kp[0] = KC + (size_t)(bs * WIN) * KVD; d.kp[1] = d.kp[0] + 64 * KVD; d.kp[2] = Kb + (size_t)d.row0 * KVD;
        d.vp[0] = VC + (size_t)(bs * WIN) * KVD; d.vp[1] = d.vp[0] + 64 * KVD; d.vp[2] = Vb + (size_t)d.row0 * KVD;
        d.nv[0] = 64; d.nv[1] = 64; d.nv[2] = LS;
    }
    return d;
}
constexpr int BUFB = 6 * SLOTB, L_WS2 = 2 * BUFB;
__device__ __forceinline__ void issue_kv(LAS unsigned char* buf, const UnitDesc& d, int lane, int wid) {
#pragma unroll
    for (int s = 0; s < 3; ++s) if (d.nv[s] > 0) {
        const bf16_t* ks = d.kp[s] + (size_t)lane * KVD + d.g * HD + wid * 8;
        const bf16_t* vs = d.vp[s] + (size_t)(16 * (wid & 3) + (lane >> 2)) * KVD + d.g * HD + (wid >> 2) * 32 + (lane & 3) * 8;
        __builtin_amdgcn_global_load_lds((const unsigned*)ks, (LAS unsigned*)(buf + s * SLOTB + wid * 1024), 16, 0, 0);
        __builtin_amdgcn_global_load_lds((const unsigned*)vs, (LAS unsigned*)(buf + 3 * SLOTB + s * SLOTB + wid * 1024), 16, 0, 0);
    }
}
__device__ __forceinline__ void load_q(const UnitDesc& d, const bf16_t* Q, int lane, int wid, bf16x8 (&qr)[4]) {
    const bf16_t* Qw = Q + (size_t)(d.row0 + 32 * (wid & 1) + (lane & 31)) * D + (4 * d.g + (wid >> 1)) * HD + (lane >> 5) * 8;
#pragma unroll
    for (int d0 = 0; d0 < 4; ++d0) qr[d0] = *(const __attribute__((address_space(1))) bf16x8*)(Qw + d0 * 16);
}
__device__ __forceinline__ void attn_phase(LAS unsigned char* lds, const int tid, int u, const int G, const bf16_t* Q, unsigned char* ws, const bf16_t* Kb, const bf16_t* Vb, const bf16_t* KC, const bf16_t* VC, const float* sinks) {
    const int NU = NBP * 128 * NKV + NBS * NKV;
    if (u >= NU) return;
    const int lane = tid & 63, r32 = lane & 31, hi = lane >> 5; const int wid = __builtin_amdgcn_readfirstlane(tid >> 6);
    const rsrc_t rw = mk_rsrc(ws, (unsigned)WS_END);
    const float zf = __int_as_float(tid >> 12);
    UnitDesc cur = decode(u, Kb, Vb, KC, VC);
    bf16x8 qr[4];
    int bsel = 0;
    issue_kv(lds, cur, lane, wid); load_q(cur, Q, lane, wid, qr);
    for (;;) {
        LAS unsigned char* buf = lds + bsel * BUFB;
        asm volatile("s_waitcnt vmcnt(0)" ::: "memory"); __builtin_amdgcn_s_barrier(); asm volatile("" ::: "memory");
        const int un = u + G; const bool has_next = un < NU;
        if (has_next) { const UnitDesc nxt = decode(un, Kb, Vb, KC, VC); issue_kv(lds + (bsel ^ 1) * BUFB, nxt, lane, wid); }
        const int head = 4 * cur.g + (wid >> 1), qoff = 32 * (wid & 1);
        const float sink2 = sinks[head] * LOG2E;
        f32x16 p[3][2];
        float mx = sink2;
#pragma unroll
        for (int s = 0; s < 3; ++s) if (cur.nv[s] > 0) {
            const LAS unsigned char* kb = buf + s * SLOTB + hi * 1024 + r32 * 16;
            f32x16 p0, p1;
#pragma unroll
            for (int r = 0; r < 16; ++r) { p0[r] = zf; p1[r] = zf; }
#pragma unroll
            for (int d0 = 0; d0 < 4; ++d0) {
                const bf16x8 b0 = *(const LAS bf16x8*)(kb + d0 * 2048), b1 = *(const LAS bf16x8*)(kb + d0 * 2048 + 512);
                p0 = __builtin_amdgcn_mfma_f32_32x32x16_bf16(b0, qr[d0], p0, 0, 0, 0); p1 = __builtin_amdgcn_mfma_f32_32x32x16_bf16(b1, qr[d0], p1, 0, 0, 0);
            }
            if (cur.nv[s] < 64) {
#pragma unroll
                for (int r = 0; r < 16; ++r) { const int kv = crow(r, hi); if (kv >= cur.nv[s]) p0[r] = NEG; if (kv + 32 >= cur.nv[s]) p1[r] = NEG; }
            }
#pragma unroll
            for (int r = 0; r < 16; ++r) mx = fmaxf(mx, fmaxf(p0[r], p1[r]));
            p[s][0] = p0; p[s][1] = p1;
            __builtin_amdgcn_sched_barrier(0);
        }
        asm volatile("" ::: "memory");
        mx = fmaxf(mx, shx(mx, 32, lane));
        const int head_c = 4 * cur.g + (wid >> 1), row0_c = cur.row0, nq_c = cur.nq, nv0 = cur.nv[0], nv1 = cur.nv[1], nv2 = cur.nv[2];
        float l = 0.f;
        u32x4 pw[3][4];
#pragma unroll
        for (int s = 0; s < 3; ++s) if ((s == 0 ? nv0 : s == 1 ? nv1 : nv2) > 0) {
#pragma unroll
            for (int h2 = 0; h2 < 2; ++h2) {
                f32x16 e;
#pragma unroll
                for (int r = 0; r < 16; ++r) { e[r] = __builtin_amdgcn_exp2f(p[s][h2][r] - mx); l += e[r]; }
#pragma unroll
                for (int q = 0; q < 2; ++q) { u32x4 w; w.x = pk_bf16(e[8 * q], e[8 * q + 1]); w.y = pk_bf16(e[8 * q + 2], e[8 * q + 3]); w.z = pk_bf16(e[8 * q + 4], e[8 * q + 5]); w.w = pk_bf16(e[8 * q + 6], e[8 * q + 7]); pw[s][2 * h2 + q] = w; }
            }
            __builtin_amdgcn_sched_barrier(0);
        }
        l += shx(l, 32, lane);
        l += __builtin_amdgcn_exp2f(sink2 - mx);
        asm volatile("" ::: "memory"); __builtin_amdgcn_sched_barrier(0);
        f32x16 o[2];
#pragma unroll
        for (int r = 0; r < 16; ++r) { o[0][r] = zf; o[1][r] = zf; }
        const LAS unsigned char* vb0 = buf + 3 * SLOTB + ((lane >> 4) & 1) * 32 + (lane & 3) * 8 + (4 * hi + ((lane & 15) >> 2)) * 64;
#pragma unroll
        for (int s = 0; s < 3; ++s) if ((s == 0 ? nv0 : s == 1 ? nv1 : nv2) > 0) {
#pragma unroll
            for (int ks = 0; ks < 4; ++ks) {
                const bf16x8 pa = __builtin_bit_cast(bf16x8, pw[s][ks]);
#pragma unroll
                for (int d0 = 0; d0 < 2; ++d0) {
                    const s16x4 lo = vtr(vb0 + s * SLOTB + d0 * 4096 + ks * 1024), hh = vtr(vb0 + s * SLOTB + d0 * 4096 + ks * 1024 + 512);
                    const bf16x8 vf = (bf16x8){lo[0], lo[1], lo[2], lo[3], hh[0], hh[1], hh[2], hh[3]};
                    o[d0] = __builtin_amdgcn_mfma_f32_32x32x16_bf16(pa, vf, o[d0], 0, 0, 0);
                }
            }
            __builtin_amdgcn_sched_barrier(0);
        }
        LAS float* wsf = (LAS float*)(lds + L_WS2) + wid * 64;
        if (hi == 0) wsf[r32] = l;
        LDS_WAIT();
        float rli[16];
#pragma unroll
        for (int r = 0; r < 16; ++r) rli[r] = __builtin_amdgcn_rcpf(wsf[crow(r, hi)]);
        asm volatile("s_waitcnt lgkmcnt(0)" ::: "memory"); __builtin_amdgcn_s_barrier(); asm volatile("" ::: "memory");
        LAS bf16_t* stg = (LAS bf16_t*)buf + wid * 2048;
#pragma unroll
        for (int r = 0; r < 16; ++r) { const int orow = crow(r, hi);
#pragma unroll
            for (int d0 = 0; d0 < 2; ++d0) stg[orow * 64 + d0 * 32 + r32] = (bf16_t)(pk_bf16(o[d0][r] * rli[r], 0.f) & 0xffffu); }
        LDS_WAIT();
#pragma unroll
        for (int i = 0; i < 4; ++i) { const int row = i * 8 + (lane >> 3), ch = lane & 7; const u32x4 v = *(const LAS u32x4*)(stg + row * 64 + ch * 8);
            if (qoff + row < nq_c) st16_wt(rw, (unsigned)WS_AB + ((unsigned)(row0_c + qoff + row) * D + head_c * HD + ch * 8) * 2, v); }
        if (!has_next) break;
        cur = decode(un, Kb, Vb, KC, VC); load_q(cur, Q, lane, wid, qr);
        u = un; bsel ^= 1;
    }
    asm volatile("s_waitcnt vmcnt(0) lgkmcnt(0)" ::: "memory"); __builtin_amdgcn_s_barrier(); asm volatile("" ::: "memory");
}
}

constexpr int NWAVES = 8;
constexpr int RING_BYTES = 131072, LDSCTL_OFF = RING_BYTES, MISC_OFF = LDSCTL_OFF + 320, XIN_OFF = LDSCTL_OFF + 512, LDS_BYTES = 147456;

#define XB_TMO      128
#define XB_XCNT(j)  (256  + 64 * (j))
#define XB_XSUB(j)  (1280 + 64 * (j))
#define XB_XGEN(j)  (2304 + 64 * (j))
#define XB_TOP      3328
#define XB_TOPGEN   3392
#define XCD_BAR_WORDS 3456
#define XB_SPIN_CAP (1u << 18)
__device__ __forceinline__ unsigned xb_ld(unsigned* p)              { return __hip_atomic_load(p, __ATOMIC_RELAXED, __HIP_MEMORY_SCOPE_AGENT); }
__device__ __forceinline__ unsigned xb_add(unsigned* p, unsigned v) { return __hip_atomic_fetch_add(p, v, __ATOMIC_RELAXED, __HIP_MEMORY_SCOPE_AGENT); }
__device__ __forceinline__ unsigned xb_xcc_id() { return (unsigned)__builtin_amdgcn_s_getreg((3 << 11) | 20) & 0xFu; }
#define XB_SPIN(cond, bar) do { unsigned _sp = 0; while (cond) { __builtin_amdgcn_s_sleep(1); \
    if ((++_sp & 255u) == 0u) { if (xb_ld(&(bar)[XB_TMO])) break; if (_sp > XB_SPIN_CAP) { atomicAdd(&(bar)[XB_TMO], 1u); break; } } } } while (0)
struct XcdBarrier { unsigned* bar; unsigned x; volatile LAS unsigned* st; };
__device__ __forceinline__ XcdBarrier xcd_barrier_post(unsigned* bar, volatile LAS unsigned* st) {
    XcdBarrier b; b.bar = bar; b.x = xb_xcc_id(); b.st = st;
    if (threadIdx.x == 0) (void)xb_add(&bar[XB_XCNT(b.x)], 1u);
    return b;
}
__device__ __forceinline__ void xcd_barrier_complete(unsigned* bar, unsigned x, unsigned& nloc, unsigned& nx) {
    const unsigned G = gridDim.x * gridDim.y * gridDim.z;
    unsigned sum, cnt, mine, sp = 0u;
    for (;;) {
        sum = 0u; cnt = 0u; mine = 0u;
#pragma unroll
        for (unsigned j = 0; j < 16; ++j) { const unsigned c = xb_ld(&bar[XB_XCNT(j)]); sum += c; cnt += (c > 0u) ? 1u : 0u; mine = (j == x) ? c : mine; }
        if (sum == G) break;
        __builtin_amdgcn_s_sleep(1);
        if ((++sp & 255u) == 0u) { if (xb_ld(&bar[XB_TMO])) break; if (sp > XB_SPIN_CAP) { atomicAdd(&bar[XB_TMO], 1u); break; } }
    }
    nloc = mine > 0u ? mine : 1u; nx = cnt > 0u ? cnt : 1u;
}
__device__ __forceinline__ void xcd_barrier(const XcdBarrier& b, const int tid) {
    asm volatile("s_waitcnt vmcnt(0)" ::: "memory");
    __syncthreads();
    if (tid == 0) {
        unsigned* bar = b.bar;
        __builtin_amdgcn_s_waitcnt(0);
        unsigned nloc = b.st[0], nx = b.st[1];
        if (nloc == 0u) { xcd_barrier_complete(bar, b.x, nloc, nx); b.st[0] = nloc; b.st[1] = nx; }
        const unsigned old = xb_add(&bar[XB_XSUB(b.x)], 1u);
        const unsigned gen = old / nloc;
        if (old + 1u == (gen + 1u) * nloc) {
            __builtin_amdgcn_fence(__ATOMIC_RELEASE, "agent");
            asm volatile("s_waitcnt vmcnt(0)" ::: "memory");
            const unsigned og = xb_add(&bar[XB_TOP], 1u);
            const unsigned tg = og / nx;
            if (og + 1u == (tg + 1u) * nx) xb_add(&bar[XB_TOPGEN], 1u);
            else XB_SPIN(xb_ld(&bar[XB_TOPGEN]) == tg, bar);
            __builtin_amdgcn_fence(__ATOMIC_ACQUIRE, "agent");
            xb_add(&bar[XB_XGEN(b.x)], 1u);
            asm volatile("s_waitcnt vmcnt(0)" ::: "memory");
        } else {
            XB_SPIN(xb_ld(&bar[XB_XGEN(b.x)]) == gen, bar);
            __builtin_amdgcn_fence(__ATOMIC_ACQUIRE, "agent");
            asm volatile("s_waitcnt vmcnt(0)" ::: "memory");
        }
    }
    __syncthreads();
}

struct Args { const float* in[24]; float* out; unsigned char* ws; int ph_lo, ph_hi; };

struct Frame {
    LAS unsigned char* lds; int tid, lane, wave, vcu, G;
    float* out; unsigned char* ws;
};
#define FIN(i) (args.in[i])

__device__ __forceinline__ void transpose_item(const float* W, int ldn, int K, int k0, int s0, bf16_t* WT, int p0, LAS float* scr, int lane) {
    float wv[32];
    const float* wp = W + (size_t)(k0 + (lane >> 5)) * ldn + s0 + (lane & 31);
#pragma unroll
    for (int i = 0; i < 32; ++i) wv[i] = wp[(size_t)(2 * i) * ldn];
#pragma unroll
    for (int i = 0; i < 32; ++i) scr[(2 * i + (lane >> 5)) * 33 + (lane & 31)] = wv[i];
    LDS_WAIT(); asm volatile("" ::: "memory");
    const int c = lane & 7;
#pragma unroll
    for (int j = 0; j < 4; ++j) { const int n = (lane >> 3) + 8 * j; const LAS float* s = scr + (8 * c) * 33 + n;
        u32x4 o; o.x = pk_bf16(s[0 * 33], s[1 * 33]); o.y = pk_bf16(s[2 * 33], s[3 * 33]); o.z = pk_bf16(s[4 * 33], s[5 * 33]); o.w = pk_bf16(s[6 * 33], s[7 * 33]);
        *(u32x4*)(WT + (size_t)(p0 + n) * K + k0 + 8 * c) = o; }
    LDS_WAIT(); asm volatile("" ::: "memory");
}
__device__ __forceinline__ int headperm_src(int p0) { const int pn = p0 >> 8, bj = (p0 >> 7) & 1, wc = (p0 >> 5) & 3; return (4 * pn + wc) * HD + 32 * bj; }
__device__ __forceinline__ int swiglu_src(int p0) { const int pn = p0 >> 8, bj = (p0 >> 7) & 1, r = p0 & 127; return bj * DFF + 128 * pn + r; }

constexpr int CV_POOL = 2 * 4 * 4 * 8, CV_WQ = 2 * 16 * 32, CV_WO = 2 * 16 * 32, CV_WKV = 16 * 16, CV_WIN = 4 * 16 * 176, CV_WOUT = 4 * 44 * 32;
constexpr int CV_TOTAL = CV_POOL + CV_WQ + CV_WO + CV_WKV + CV_WIN + CV_WOUT;

__device__ __forceinline__ void convert_item(Frame& F, const Args& args, int it, LAS float* scr) {
    unsigned char* ws = F.ws;
    if (it < CV_POOL) {
        const int lg = it >> 5, r = it & 31, kb = r >> 3, nb = r & 7;
        transpose_item(FIN(11) + (size_t)lg * 65536, 256, 256, 64 * kb, 32 * nb, (bf16_t*)(ws + WS_WPOOL) + (size_t)lg * 65536, 32 * nb, scr, F.lane); return; }
    it -= CV_POOL;
    if (it < CV_WQ) { const int j = it >> 9, r = it & 511, kb = r >> 5, nb = r & 31;
        transpose_item(FIN(13) + (size_t)j * D * D, D, D, 64 * kb, headperm_src(32 * nb), (bf16_t*)(ws + WS_WQ) + (size_t)j * D * D, 32 * nb, scr, F.lane); return; }
    it -= CV_WQ;
    if (it < CV_WO) { const int j = it >> 9, r = it & 511, kb = r >> 5, nb = r & 31;
        transpose_item(FIN(16) + (size_t)j * D * D, D, D, 64 * kb, 32 * nb, (bf16_t*)(ws + WS_WO) + (size_t)j * D * D, 32 * nb, scr, F.lane); return; }
    it -= CV_WO;
    if (it < CV_WKV) { const int kb = it >> 4, nb = it & 15;
        transpose_item(FIN(20), 2 * KVD, D, 64 * kb, headperm_src(32 * nb), (bf16_t*)(ws + WS_WKV), 32 * nb, scr, F.lane); return; }
    it -= CV_WKV;
    if (it < CV_WIN) { const int l = it / (16 * 176), r = it % (16 * 176), kb = r / 176, nb = r % 176;
        transpose_item(FIN(22) + (size_t)l * D * NIN, NIN, D, 64 * kb, swiglu_src(32 * nb), (bf16_t*)(ws + WS_WIN) + (size_t)l * NIN * D, 32 * nb, scr, F.lane); return; }
    it -= CV_WIN;
    { const int l = it / (44 * 32), r = it % (44 * 32), kb = r >> 5, nb = r & 31;
        transpose_item(FIN(23) + (size_t)l * DFF * D, D, DFF, 64 * kb, 32 * nb, (bf16_t*)(ws + WS_WOUT) + (size_t)l * D * DFF, 32 * nb, scr, F.lane); }
}

constexpr int ADA_ITEMS = 4 * 48 + 16;
__device__ __forceinline__ void ada_item(Frame& F, const Args& args, int it) {
    LAS float* CA = (LAS float*)F.lds;
    LAS float* RED = (LAS float*)(F.lds + 49152);
    const float* W; const float* bias; float* out; int ldn, n0, ostride;
    if (it < 192) { const int l = it / 48; n0 = (it % 48) * 128; W = FIN(7) + (size_t)l * D * ADAW; ldn = ADAW; bias = FIN(8) + l * ADAW; out = (float*)(F.ws + WS_ADA) + (size_t)l * NBATCH * ADAW; ostride = ADAW; }
    else { n0 = (it - 192) * 128; W = FIN(18); ldn = 2 * D; bias = FIN(19); out = (float*)(F.ws + WS_ADAKV); ostride = 2 * D; }
    for (int idx = F.tid; idx < NBATCH * D; idx += NWAVES * 64) { const int b = idx >> 10, k = idx & 1023;
        const float c = b < NBP ? FIN(2)[b * D + k] : FIN(3)[(b - NBP) * D + k]; CA[k * 12 + b] = c / (1.0f + __expf(-c)); }
    LDS_WAIT(); __syncthreads();
    f32x2 acc[NBATCH];
#pragma unroll
    for (int b = 0; b < NBATCH; ++b) acc[b] = (f32x2){0.f, 0.f};
    const float* wp = W + (size_t)(F.wave * 128) * ldn + n0 + 2 * F.lane;
#pragma unroll 32
    for (int k = 0; k < 128; ++k) {
        const f32x2 wv = *(const f32x2*)(wp + (size_t)k * ldn);
        const LAS f32x4* cp = (const LAS f32x4*)(CA + (F.wave * 128 + k) * 12);
        const f32x4 c0 = cp[0], c1 = cp[1], c2 = cp[2];
        acc[0] += wv * c0[0]; acc[1] += wv * c0[1]; acc[2] += wv * c0[2]; acc[3] += wv * c0[3]; acc[4] += wv * c1[0];
        acc[5] += wv * c1[1]; acc[6] += wv * c1[2]; acc[7] += wv * c1[3]; acc[8] += wv * c2[0]; acc[9] += wv * c2[1];
    }
#pragma unroll
    for (int b = 0; b < NBATCH; ++b) *(LAS f32x2*)(RED + (F.wave * NBATCH + b) * 128 + 2 * F.lane) = acc[b];
    LDS_WAIT(); __syncthreads();
    for (int idx = F.tid; idx < NBATCH * 128; idx += NWAVES * 64) { const int b = idx >> 7, c = idx & 127; float s = bias[n0 + c];
#pragma unroll
        for (int w = 0; w < NWAVES; ++w) s += RED[(w * NBATCH + b) * 128 + c];
        out[(size_t)b * ostride + n0 + c] = s; }
    LDS_WAIT(); __syncthreads();
}

constexpr int BI_WIN = 4 * 44, BI_WQ = 2 * 8, BI_WKV = 4, BI_TOTAL = BI_WIN + BI_WQ + BI_WKV, SHP = D + 8;
__device__ __forceinline__ void bias_item(Frame& F, int it) {
    LAS bf16_t* SH = (LAS bf16_t*)F.lds;
    const bf16_t* W; const float* sh; int shs; float* out; int os, r0;
    if (it < BI_WIN) { const int l = it / 44; r0 = (it % 44) * 128; W = (const bf16_t*)(F.ws + WS_WIN) + (size_t)l * NIN * D; sh = (const float*)(F.ws + WS_ADA) + (size_t)l * NBATCH * ADAW + 3 * D; shs = ADAW;
        out = (float*)(F.ws + WS_BIN) + (size_t)l * NBATCH * NIN; os = NIN; }
    else if (it < BI_WIN + BI_WQ) { const int j = (it - BI_WIN) >> 3; r0 = ((it - BI_WIN) & 7) * 128; W = (const bf16_t*)(F.ws + WS_WQ) + (size_t)j * D * D; sh = (const float*)(F.ws + WS_ADA) + (size_t)(2 + j) * NBATCH * ADAW; shs = ADAW;
        out = (float*)(F.ws + WS_BQ) + (size_t)j * NBATCH * D; os = D; }
    else { r0 = (it - BI_WIN - BI_WQ) * 128; W = (const bf16_t*)(F.ws + WS_WKV); sh = (const float*)(F.ws + WS_ADAKV); shs = 2 * D; out = (float*)(F.ws + WS_BKV); os = 2 * KVD; }
    const bf16_t* wp = W + (size_t)(r0 + F.wave * 16 + (F.lane & 15)) * D + 8 * (F.lane >> 4);
    bf16x8 wf[32];
#pragma unroll
    for (int s_ = 0; s_ < 32; ++s_) wf[s_] = *(const bf16x8*)(wp + 32 * s_);
    for (int idx = F.tid; idx < 16 * D; idx += NWAVES * 64) { const int b = idx >> 10, k = idx & 1023; SH[b * SHP + k] = b < NBATCH ? (bf16_t)(pk_bf16(sh[(size_t)b * shs + k], 0.f) & 0xffffu) : (bf16_t)0; }
    LDS_WAIT(); __syncthreads();
    f32x4 acc = {0.f, 0.f, 0.f, 0.f};
    const LAS bf16_t* sp = SH + (F.lane & 15) * SHP + 8 * (F.lane >> 4);
#pragma unroll
    for (int s_ = 0; s_ < 32; ++s_) acc = __builtin_amdgcn_mfma_f32_16x16x32_bf16(*(const LAS bf16x8*)(sp + 32 * s_), wf[s_], acc, 0, 0, 0);
#pragma unroll
    for (int j = 0; j < 4; ++j) { const int b = 4 * (F.lane >> 4) + j; if (b < NBATCH) out[(size_t)b * os + r0 + F.wave * 16 + (F.lane & 15)] = acc[j]; }
    LDS_WAIT(); __syncthreads();
}

constexpr int PP_ITEMS = 2 * 128 + NBS;
__device__ __forceinline__ void pool_prep_item(Frame& F, const Args& args, int layer, int item, const float* xsrc_p, const float* xsrc_s, int pub_seam) {
    LAS float* RS = (LAS float*)F.lds;
    int bidx, t0, nrows, L, pos0, grow0; const float* xb; const float* hist; float* pout;
    if (item < 256) { bidx = item >> 7; t0 = (item & 127) * 64; nrows = 64; L = SEQ; pos0 = 0; grow0 = bidx * SEQ; xb = xsrc_p + (size_t)grow0 * D; hist = nullptr;
        pout = F.out + O_POOLP + (size_t)(layer * NBP + bidx) * PH * D; }
    else { const int bs = item - 256; bidx = NBP + bs; t0 = 0; nrows = LS; L = LS; pos0 = 4096; grow0 = MP + bs * LS; xb = xsrc_s + (size_t)(bs * LS) * D; hist = FIN(4) + (size_t)(layer * NBS + bs) * PH * D;
        pout = F.out + O_POOLS + (size_t)(layer * NBS + bs) * PH * D; }
    if (layer == 1) {
        const float* rss = (const float*)(F.ws + WS_SS) + (size_t)1 * MPAD + grow0;
        for (int e = F.tid; e < 15 + nrows; e += NWAVES * 64) { const int t = t0 - 15 + e; if (t >= 0) RS[e] = 1.0f / sqrtf(rss[t] * (1.0f / D) + EPS); }
    } else
    for (int e0 = F.wave; e0 < 15 + nrows; e0 += 5 * NWAVES) {
        f32x4 v[5][4];
#pragma unroll
        for (int q = 0; q < 5; ++q) { const int e = e0 + q * NWAVES, t = t0 - 15 + e; const bool ok = (e < 15 + nrows) && t >= 0; const f32x4* xr = (const f32x4*)(xb + (size_t)(ok ? t : t0) * D) + F.lane;
#pragma unroll
            for (int j = 0; j < 4; ++j) v[q][j] = xr[64 * j]; }
#pragma unroll
        for (int q = 0; q < 5; ++q) { const int e = e0 + q * NWAVES, t = t0 - 15 + e; float s_ = 0.f;
#pragma unroll
            for (int j = 0; j < 4; ++j) s_ += (v[q][j][0] * v[q][j][0] + v[q][j][1] * v[q][j][1]) + (v[q][j][2] * v[q][j][2] + v[q][j][3] * v[q][j][3]);
            s_ = wave_sum(s_, F.lane); if (F.lane == 0 && e < 15 + nrows && t >= 0) RS[e] = 1.0f / sqrtf(s_ * (1.0f / D) + EPS); }
    }
    LDS_WAIT(); __syncthreads();
    const int g = F.wave & 3, rh = F.wave >> 2, w = 2 << g, col = 256 * g + 4 * F.lane;
    const _Float16* xh = (const _Float16*)(F.ws + WS_XH) + (size_t)grow0 * D;
#define PP_LDX(t_) (layer == 1 ? __builtin_convertvector(*(const h16x4*)(xh + (size_t)(t_) * D + col), f32x4) : *(const f32x4*)(xb + (size_t)(t_) * D + col))
    if (32 * rh < nrows) {
        const float* ada = (const float*)(F.ws + WS_ADA) + ((size_t)layer * NBATCH + bidx) * ADAW;
        const f32x4 gm = *(const f32x4*)(FIN(9) + layer * D + col) * (*(const f32x4*)(ada + D + col) + 1.0f);
        const f32x4 sh = *(const f32x4*)(ada + col);
        const int tb = t0 + 32 * rh;
        const rsrc_t rw = mk_rsrc(F.ws, (unsigned)WS_END);
        const unsigned dout = (unsigned)WS_AB + ((unsigned)grow0 * D + col) * 2;
        f32x4 ring[16];
        ring[0] = (f32x4){0.f, 0.f, 0.f, 0.f};
#pragma unroll
        for (int j = 1; j < 16; ++j) { const int t = tb - 16 + j;
            if (t >= 0) ring[j] = PP_LDX(t) * RS[t - (t0 - 15)] * gm + sh;
            else if (hist) ring[j] = *(const f32x4*)(hist + (size_t)(15 + t) * D + col);
            else ring[j] = (f32x4){0.f, 0.f, 0.f, 0.f}; }
#pragma unroll
        for (int blk = 0; blk < 2; ++blk) if (32 * rh + 16 * blk < nrows) {
#pragma unroll
            for (int jj = 0; jj < 16; ++jj) { const int t = tb + 16 * blk + jj;
                const f32x4 h = PP_LDX(t) * RS[t - (t0 - 15)] * gm + sh;
                ring[jj] = h;
                f32x4 s = ring[jj] + ring[(jj + 15) & 15];
                if (w > 2) { s += ring[(jj + 14) & 15] + ring[(jj + 13) & 15];
                    if (w > 4) { s += (ring[(jj + 12) & 15] + ring[(jj + 11) & 15]) + (ring[(jj + 10) & 15] + ring[(jj + 9) & 15]);
                        if (w > 8) s += ((ring[(jj + 8) & 15] + ring[(jj + 7) & 15]) + (ring[(jj + 6) & 15] + ring[(jj + 5) & 15])) + ((ring[(jj + 4) & 15] + ring[(jj + 3) & 15]) + (ring[(jj + 2) & 15] + ring[(jj + 1) & 15])); } }
                const int cnt = min(w, pos0 + t + 1);
                const f32x4 d = s * (1.0f / (float)cnt) - h;
                u32x2 o; o.x = pk_bf16(d[0], d[1]); o.y = pk_bf16(d[2], d[3]);
                st8_wt(rw, dout + (unsigned)t * D * 2, o);
                if (t >= L - PH) *(f32x4*)(pout + (size_t)(t - (L - PH)) * D + col) = h; }
        }
    }
#undef PP_LDX
    if (pub_seam >= 0) pg8::dep_publish((unsigned*)(F.ws + WS_CTL) + CW_CNT, pub_seam, (grow0 + t0) >> 8, F.lane);
    LDS_WAIT(); __syncthreads();
}

__device__ __forceinline__ void ttable_all(Frame& F, const Args& args, int gt, int NGT) {
    const float* ADA = (const float*)(F.ws + WS_ADA); const float* ADAKV = (const float*)(F.ws + WS_ADAKV);
    float* T = (float*)(F.ws + WS_T);
    for (int e = gt; e < T_NVEC * TV; e += NGT) { const int id = e / TV, idx = e - id * TV, b = idx >> 10, c = idx & 1023; float v;
        if (id < T_GAINF) { const int l = id - T_GATE1; v = ADA[((size_t)l * NBATCH + b) * ADAW + 2 * D + c]; if (l < 2) v *= FIN(12)[l * D + c]; }
        else if (id < T_GATE2) { const int l = id - T_GAINF; v = FIN(10)[l * D + c] * (1.0f + ADA[((size_t)l * NBATCH + b) * ADAW + 4 * D + c]); }
        else if (id < T_GAINQ) { const int l = id - T_GATE2; v = ADA[((size_t)l * NBATCH + b) * ADAW + 5 * D + c]; }
        else if (id < T_GAINKV) { const int l = 2 + id - T_GAINQ; v = FIN(9)[l * D + c] * (1.0f + ADA[((size_t)l * NBATCH + b) * ADAW + D + c]); }
        else v = FIN(17)[c] * (1.0f + ADAKV[(size_t)b * 2 * D + D + c]);
        T[e] = v; }
}

#ifndef PH_MASK
#define PH_MASK 0x7ffff
#endif
__global__ void __launch_bounds__(NWAVES * 64, 2) yoco_fwd(Args args) {
    extern __shared__ __attribute__((aligned(16))) unsigned char lds_raw[];
    Frame F;
    F.lds = (LAS unsigned char*)lds_raw;
    F.tid = 0; F.lane = 0; F.wave = __builtin_amdgcn_readfirstlane((int)threadIdx.x >> 6);
    F.G = gridDim.x; { const int bx = blockIdx.x; int v_ = ((F.G & 7) == 0) ? (bx & 7) * (F.G >> 3) + (bx >> 3) : bx; asm volatile("" : "+s"(v_)); F.vcu = v_; }
    F.out = args.out; F.ws = args.ws;
    for (int u = threadIdx.x; u < (LDS_BYTES - LDSCTL_OFF) / 4; u += NWAVES * 64) ((LAS unsigned*)(F.lds + LDSCTL_OFF))[u] = 0u;
    __syncthreads();
    if (threadIdx.x == 0) { ((LAS unsigned long long*)(F.lds + XIN_OFF))[0] = (unsigned long long)FIN(0); ((LAS unsigned long long*)(F.lds + XIN_OFF))[1] = (unsigned long long)(FIN(1) - (size_t)MP * D); }
    __syncthreads();
    const int lo = args.ph_lo, hi = args.ph_hi;
    XcdBarrier bar; bar.bar = (unsigned*)(args.ws + WS_CTL) + CW_BAR; bar.x = 0; bar.st = nullptr;
    if (hi - lo > 1) bar = xcd_barrier_post((unsigned*)(args.ws + WS_CTL) + CW_BAR, (volatile LAS unsigned*)(F.lds + MISC_OFF) + 8);
#define WSP(T_, off) ((T_*)(wsl + (off)))
#pragma unroll 1
    for (int ph = lo; ph < hi; ++ph) {
        unsigned char* wsl = F.ws; asm volatile("" : "+s"(wsl));
        int lanel; asm volatile("v_mbcnt_lo_u32_b32 %0, -1, 0\n\tv_mbcnt_hi_u32_b32 %0, -1, %0" : "=v"(lanel));
        const int tidl = F.wave * 64 + lanel;
        Frame Fp = F; Fp.tid = tidl; Fp.lane = lanel; Fp.ws = wsl;
        const int layer = ph < 6 ? 0 : ph < 10 ? 1 : ph < 15 ? 2 : 3;
        int Gp = F.G; asm volatile("" : "+s"(Gp));
        unsigned* cnt = WSP(unsigned, WS_CTL) + CW_CNT;
        const bool solo = true;
        const int krot = ph == 7 ? 19 : ph == 12 ? 6 : ph == 17 ? 25 : ph == 2 ? 1 : ph == 4 ? 2 : ph == 6 ? 3 : ph == 8 ? 4 : ph == 9 ? 5 : ph == 11 ? 6 : ph == 13 ? 7 : ph == 14 ? 8 : ph == 16 ? 9 : ph == 18 ? 10 : 0;
        int crot = (int)blockIdx.x; asm volatile("" : "+s"(crot)); (void)krot;
        pg8::DepOrder S; S.cnt = cnt; S.wseam = -1; S.pseam = -1; S.need_p = 0; S.need_s = 0; S.wait_next = 0; S.last_pm = -1;
#define PHQ(k) (ph == (k) && ((PH_MASK >> (k)) & 1))
        if (PHQ(0)) {
            for (int it = F.vcu; it < ADA_ITEMS; it += F.G) ada_item(Fp, args, it);
            LAS float* scr = (LAS float*)(Fp.lds + Fp.wave * 16384);
            const int gw = F.vcu * NWAVES + Fp.wave, NGW = F.G * NWAVES;
            for (int it = gw; it < CV_TOTAL; it += NGW) convert_item(Fp, args, it, scr);
            const int gt = F.vcu * NWAVES * 64 + Fp.tid, NGT = F.G * NWAVES * 64;
            for (int i = gt; i < (RSS_N + 1) * MPAD / 4; i += NGT) WSP(f32x4, WS_SS)[i] = (f32x4){0.f, 0.f, 0.f, 0.f};
            for (int i = gt; i < 2 * NBS * WIN * KVD / 4; i += NGT) {
                const int which = i >= NBS * WIN * KVD / 4, j = which ? i - NBS * WIN * KVD / 4 : i;
                const f32x4 v = ((const f32x4*)(which ? FIN(6) : FIN(5)))[j];
                u32x2 o; o.x = pk_bf16(v[0], v[1]); o.y = pk_bf16(v[2], v[3]);
                (which ? WSP(u32x2, WS_VC) : WSP(u32x2, WS_KC))[j] = o;
                const int e = j * 4, bs = e / (WIN * KVD), r = (e / KVD) % WIN, cidx = e % KVD;
                if (r >= LS) *(f32x4*)(F.out + (which ? O_VS : O_KS) + ((size_t)bs * WIN + (r - LS)) * KVD + cidx) = v;
            }
        } else if (PHQ(1)) {
            for (int it = F.vcu; it < PP_ITEMS; it += F.G) pool_prep_item(Fp, args, 0, it, FIN(0), FIN(1), -1);
            ttable_all(Fp, args, F.vcu * NWAVES * 64 + Fp.tid, F.G * NWAVES * 64);
            for (int it = F.G - 1 - F.vcu; it < BI_TOTAL; it += F.G) bias_item(Fp, it);
        } else if (PHQ(5)) {
            for (int it = F.vcu; it < PP_ITEMS; it += F.G) pool_prep_item(Fp, args, 1, it, nullptr, nullptr, solo ? -1 : 5);
        } else if (PHQ(2)) {
            int kp = 256; asm volatile("" : "+s"(kp));
            const float* Tt = WSP(const float, WS_T);
            if (F.vcu < 64) { sk::Gemm sg{WSP(const bf16_t, WS_AB), D, 1, WSP(const bf16_t, WS_WPOOL), 256, 0};
                sk::Res sr{FIN(1), nullptr, WSP(_Float16, WS_XH), Tt + (T_GATE1 + 0) * TV, Tt + (T_GAINF + 0) * TV, nullptr, WSP(bf16_t, WS_AQ), nullptr, WSP(float, WS_SS) + (size_t)(0) * MPAD}; sk::Head sh{};
                sk::run<0>(Fp.lds, tidl, F.vcu, sg, sr, sh); }
            pg8::Gemm g{WSP(const bf16_t, WS_AB), WSP(const bf16_t, WS_WPOOL), D, 256, kp}; S.init(NTM - 1, 4, Gp, crot);
            if (!solo) S.pseam = 2;
            typedef pg8::EpiRes<true, 1, true> EP; EP E{Fp.lds + XIN_OFF, mk_rsrc(F.out, (unsigned)(O_END * 4)), mk_rsrc(wsl, (unsigned)WS_END), T_GATE1 + 0, T_GAINF + 0, 0, WSP(float, WS_SS) + (size_t)(0) * MPAD};
            pg8::gemm_phase<EP, pg8::DepOrder, true>(Fp.lds, tidl, g, S, E);
        } else if (PHQ(6)) {
            int kp = 256; asm volatile("" : "+s"(kp));
            if (F.vcu < 64) { const float* Tt = WSP(const float, WS_T); sk::Gemm sg{WSP(const bf16_t, WS_AB), D, 1, WSP(const bf16_t, WS_WPOOL) + (size_t)D * 256, 256, 0};
                sk::Res sr{nullptr, nullptr, WSP(_Float16, WS_XH), Tt + (T_GATE1 + 1) * TV, Tt + (T_GAINF + 1) * TV, nullptr, WSP(bf16_t, WS_AQ), nullptr, WSP(float, WS_SS) + (size_t)2 * MPAD}; sk::Head sh{};
                sk::run<0>(Fp.lds, tidl, F.vcu, sg, sr, sh); }
            pg8::Gemm g{WSP(const bf16_t, WS_AB), WSP(const bf16_t, WS_WPOOL) + (size_t)D * 256, D, 256, kp}; S.init(NTM - 1, 4, Gp, crot);
            typedef pg8::EpiRes<false, 1, true> EP; EP E{nullptr, mk_rsrc(F.out, (unsigned)(O_END * 4)), mk_rsrc(wsl, (unsigned)WS_END), T_GATE1 + 1, T_GAINF + 1, 0, WSP(float, WS_SS) + (size_t)2 * MPAD};
            pg8::gemm_phase<EP, pg8::DepOrder, true>(Fp.lds, tidl, g, S, E);
        } else if (PHQ(11) || PHQ(16)) {
            const bf16_t* Bw = WSP(const bf16_t, WS_WO) + (size_t)(layer - 2) * D * D; float* rssp = WSP(float, WS_SS) + (size_t)(2 * layer) * MPAD;
            if (F.vcu < 64) { const float* Tt = WSP(const float, WS_T); sk::Gemm sg{WSP(const bf16_t, WS_AB), D, 0, Bw, D, 0};
                sk::Res sr{nullptr, nullptr, WSP(_Float16, WS_XH), Tt + (T_GATE1 + layer) * TV, Tt + (T_GAINF + layer) * TV, nullptr, WSP(bf16_t, WS_AQ), nullptr, rssp}; sk::Head sh{};
                sk::run<0>(Fp.lds, tidl, F.vcu, sg, sr, sh); }
            pg8::Gemm g{WSP(const bf16_t, WS_AB), Bw, D, 0, D}; S.init(NTM - 1, 4, Gp, crot);
            typedef pg8::EpiRes<false, 1, true> EP; EP E{nullptr, mk_rsrc(F.out, (unsigned)(O_END * 4)), mk_rsrc(wsl, (unsigned)WS_END), T_GATE1 + layer, T_GAINF + layer, 0, rssp};
            pg8::gemm_phase<EP, pg8::DepOrder, true>(Fp.lds, tidl, g, S, E);
        } else if (PHQ(13)) {
            const bf16_t* Bw = WSP(const bf16_t, WS_WOUT) + (size_t)2 * D * DFF;
            if (F.vcu < 64) { const float* Tt = WSP(const float, WS_T); sk::Gemm sg{WSP(const bf16_t, WS_H), DFF, 0, Bw, DFF, 0};
                sk::Res sr{nullptr, nullptr, WSP(_Float16, WS_XH), Tt + (T_GATE2 + 2) * TV, Tt + (T_GAINQ + 1) * TV, nullptr, WSP(bf16_t, WS_AQ), nullptr, WSP(float, WS_SS) + (size_t)5 * MPAD}; sk::Head sh{};
                sk::run<0>(Fp.lds, tidl, F.vcu, sg, sr, sh); }
            pg8::Gemm g{WSP(const bf16_t, WS_H), Bw, DFF, 0, DFF}; S.init(NTM - 1, 4, Gp, crot);
            typedef pg8::EpiRes<false, 1, true> EP; EP E{nullptr, mk_rsrc(F.out, (unsigned)(O_END * 4)), mk_rsrc(wsl, (unsigned)WS_END), T_GATE2 + 2, T_GAINQ + 1, 0, WSP(float, WS_SS) + (size_t)5 * MPAD};
            pg8::gemm_phase<EP, pg8::DepOrder, true>(Fp.lds, tidl, g, S, E);
        } else if (PHQ(8)) {
            pg8::Gemm g{WSP(const bf16_t, WS_H), WSP(const bf16_t, WS_WOUT) + (size_t)1 * D * DFF, DFF, 0, DFF}; S.init(NTM - 1, 4, Gp, crot);
            if (F.vcu < 64) { const float* Tt = WSP(const float, WS_T); sk::Gemm sg{g.A, g.lda, 0, g.Bt, g.K, 0};
                sk::Res sr{nullptr, nullptr, WSP(_Float16, WS_XH), Tt + (T_GATE2 + 1) * TV, Tt + (T_GAINQ + 0) * TV, Tt + T_GAINKV * TV, WSP(bf16_t, WS_AQ), WSP(bf16_t, WS_AB), WSP(float, WS_SS) + (size_t)(3) * MPAD}; sk::Head sh{};
                sk::run<0>(Fp.lds, tidl, F.vcu, sg, sr, sh); }
            if (!solo) { S.wseam = 7; S.need_p = S.need_s = 22 * 8; S.pseam = 8; }
            typedef pg8::EpiRes<false, 2, true> EP; EP E{nullptr, mk_rsrc(F.out, (unsigned)(O_END * 4)), mk_rsrc(wsl, (unsigned)WS_END), T_GATE2 + 1, T_GAINQ + 0, T_GAINKV, WSP(float, WS_SS) + (size_t)(3) * MPAD};
            pg8::gemm_phase<EP, pg8::DepOrder, true>(Fp.lds, tidl, g, S, E);
        } else if (PHQ(4) || PHQ(18)) {
            pg8::Gemm g{WSP(const bf16_t, WS_H), WSP(const bf16_t, WS_WOUT) + (size_t)layer * D * DFF, DFF, 0, DFF}; S.init(NTM - 1, 4, Gp, crot);
            if (F.vcu < 64) { const float* Tt = WSP(const float, WS_T); sk::Gemm sg{g.A, g.lda, 0, g.Bt, g.K, 0};
                sk::Res sr{nullptr, ph == 18 ? F.out : nullptr, WSP(_Float16, WS_XH), Tt + (T_GATE2 + layer) * TV, nullptr, nullptr, nullptr, nullptr, ph == 4 ? WSP(float, WS_SS) + (size_t)1 * MPAD : nullptr}; sk::Head sh{};
                sk::run<0>(Fp.lds, tidl, F.vcu, sg, sr, sh); }
            if (!solo) { S.wseam = ph - 1; S.need_p = S.need_s = 22 * 8; }
            if (ph == 4) { typedef pg8::EpiRes<false, 0, true, false> EP; EP E{nullptr, mk_rsrc(F.out, (unsigned)(O_END * 4)), mk_rsrc(wsl, (unsigned)WS_END), T_GATE2 + layer, 0, 0, WSP(float, WS_SS) + (size_t)1 * MPAD};
                pg8::gemm_phase<EP, pg8::DepOrder, true>(Fp.lds, tidl, g, S, E); }
            else { typedef pg8::EpiRes<false, 0, false, true> EP; EP E{nullptr, mk_rsrc(F.out, (unsigned)(O_END * 4)), mk_rsrc(wsl, (unsigned)WS_END), T_GATE2 + layer, 0, 0, nullptr};
                pg8::gemm_phase<EP, pg8::DepOrder, true>(Fp.lds, tidl, g, S, E); }
        } else if (PHQ(3) || PHQ(7) || PHQ(12) || PHQ(17)) {
            pg8::Gemm g{WSP(const bf16_t, WS_AQ), WSP(const bf16_t, WS_WIN) + (size_t)layer * NIN * D, D, 0, D}; S.init(NTM, NIN / 256, Gp, crot);
            if (!solo) { S.wseam = ph - 1; S.need_p = S.need_s = 4 * 8; S.pseam = ph; }
            pg8::EpiSwiglu E{WSP(const float, WS_SS) + (size_t)(2 * layer) * MPAD, WSP(const float, WS_BIN) + (size_t)layer * NBATCH * NIN, mk_rsrc(wsl, (unsigned)WS_END)};
            pg8::gemm_phase<pg8::EpiSwiglu, pg8::DepOrder, true>(Fp.lds, tidl, g, S, E);
        } else if (PHQ(9) || PHQ(14)) {
            const int j = layer - 1;
            if (!solo) { S.wseam = ph - 1; S.need_p = S.need_s = 4 * 8; if (ph == 14) S.pseam = 14; }
            if (ph == 14 && F.vcu < 64) { sk::Gemm sg{WSP(const bf16_t, WS_AQ), D, 0, WSP(const bf16_t, WS_WQ) + (size_t)j * D * D, D, 1}; sk::Res sr{};
                sk::Head sh{WSP(const float, WS_SS) + (size_t)5 * MPAD, WSP(const float, WS_BQ) + (size_t)j * NBATCH * D, FIN(14) + j * HD, att::C2, WSP(bf16_t, WS_QO)};
                sk::run<1>(Fp.lds, tidl, F.vcu, sg, sr, sh); }
            { pg8::Gemm g{WSP(const bf16_t, WS_AQ), WSP(const bf16_t, WS_WQ) + (size_t)j * D * D, D, 0, D}; S.init(ph == 14 ? NTM - 1 : NTM, 4, Gp, crot);
              pg8::EpiHead<0> E{WSP(const float, WS_SS) + (size_t)(ph == 9 ? 3 : 5) * MPAD, WSP(const float, WS_BQ) + (size_t)j * NBATCH * D, D, FIN(14) + j * HD, att::C2, mk_rsrc(wsl, (unsigned)WS_END), nullptr, nullptr, nullptr, nullptr};
              pg8::gemm_phase<pg8::EpiHead<0>, pg8::DepOrder, true>(Fp.lds, tidl, g, S, E); }
            if (ph == 9) {
              pg8::Gemm g{WSP(const bf16_t, WS_AB), WSP(const bf16_t, WS_WKV), D, 0, D}; S.init(NTM, 2, Gp, Gp - 1 - crot); S.last_pm = -1;
              pg8::EpiHead<1> E{WSP(const float, WS_SS) + (size_t)3 * MPAD, WSP(const float, WS_BKV), 2 * KVD, FIN(21), 1.0f, mk_rsrc(wsl, (unsigned)WS_END), F.out + O_KP, F.out + O_VP, F.out + O_KS, F.out + O_VS};
              pg8::gemm_phase<pg8::EpiHead<1>, pg8::DepOrder, true>(Fp.lds, tidl, g, S, E); }
        } else if (PHQ(10) || PHQ(15)) {
            const float* sk = FIN(15) + (layer - 2) * NH;
            att::attn_phase(Fp.lds, tidl, F.vcu, F.G, WSP(const bf16_t, WS_QO), wsl, WSP(const bf16_t, WS_KB), WSP(const bf16_t, WS_VB), WSP(const bf16_t, WS_KC), WSP(const bf16_t, WS_VC), sk);
        }
        if (ph + 1 < hi) xcd_barrier(bar, tidl);
    }
}

extern "C" void kernel_launch(void* const* d_in, const int* in_sizes, int n_in, void* d_out, int out_size, void* d_ws, size_t ws_size, hipStream_t stream) {
    static int grid = 0;
    if (grid == 0) {
        if (n_in != 24 || (size_t)out_size != O_END || ws_size < WS_END) { fprintf(stderr, "kernel_launch: unexpected sizes n_in %d out %d ws %zu\n", n_in, out_size, ws_size); grid = -1; return; }
        int dev = 0, cus = 0, per_cu = 0;
        if (hipGetDevice(&dev) != hipSuccess || hipDeviceGetAttribute(&cus, hipDeviceAttributeMultiprocessorCount, dev) != hipSuccess) { grid = -1; return; }
        if (hipFuncSetAttribute((const void*)yoco_fwd, hipFuncAttributeMaxDynamicSharedMemorySize, LDS_BYTES) != hipSuccess) { fprintf(stderr, "kernel_launch: hipFuncSetAttribute failed\n"); grid = -1; return; }
        if (hipOccupancyMaxActiveBlocksPerMultiprocessor(&per_cu, (const void*)yoco_fwd, NWAVES * 64, LDS_BYTES) != hipSuccess || per_cu < 1) { fprintf(stderr, "kernel_launch: occupancy query reports %d blocks per CU\n", per_cu); grid = -1; (void)hipGetLastError(); return; }
        grid = cus;
    }
    if (grid < 0) return;
    (void)hipMemsetAsync((char*)d_ws + WS_CTL, 0, CTL_ZERO_BYTES, stream);
    Args a{};
    for (int i = 0; i < 24; ++i) a.in[i] = (const float*)d_in[i];
    a.out = (float*)d_out; a.ws = (unsigned char*)d_ws;
#if MK_ONE_LAUNCH
    a.ph_lo = 0; a.ph_hi = NPHASE;
    hipLaunchKernelGGL(yoco_fwd, dim3(grid), dim3(NWAVES * 64), LDS_BYTES, stream, a);
#else
#ifndef DUP_MASK
#define DUP_MASK 0
#endif
#ifdef PRE_PHASE
    { a.ph_lo = PRE_PHASE; a.ph_hi = PRE_PHASE + 1; hipLaunchKernelGGL(yoco_fwd, dim3(grid), dim3(NWAVES * 64), LDS_BYTES, stream, a); }
#endif
    for (int p = 0; p < NPHASE; ++p) { a.ph_lo = p; a.ph_hi = p + 1; hipLaunchKernelGGL(yoco_fwd, dim3(grid), dim3(NWAVES * 64), LDS_BYTES, stream, a);
        if ((DUP_MASK >> p) & 1) hipLaunchKernelGGL(yoco_fwd, dim3(grid), dim3(NWAVES * 64), LDS_BYTES, stream, a); }
#endif
}
```

```cpp
#include <hip/hip_runtime.h>
#include <cstdio>
#include <cstdint>

#define LAS __attribute__((address_space(3)))
typedef unsigned short bf16_t;
typedef short bf16x8 __attribute__((ext_vector_type(8)));
typedef short s16x4 __attribute__((ext_vector_type(4)));
typedef float f32x2 __attribute__((ext_vector_type(2)));
typedef float f32x4 __attribute__((ext_vector_type(4)));
typedef float f32x16 __attribute__((ext_vector_type(16)));
typedef unsigned u32x2 __attribute__((ext_vector_type(2)));
typedef unsigned u32x4 __attribute__((ext_vector_type(4)));
typedef __bf16 bf16x2_t __attribute__((ext_vector_type(2)));
typedef _Float16 h16x4 __attribute__((ext_vector_type(4)));
typedef _Float16 h16x8 __attribute__((ext_vector_type(8)));
typedef float f32x8 __attribute__((ext_vector_type(8)));

#ifndef MK_ONE_LAUNCH
#define MK_ONE_LAUNCH 1
#define WT_AUX 0
#endif

constexpr int D = 1024, SEQ = 8192, NBP = 2, NBS = 8, LS = 16, NBATCH = 10;
constexpr int MP = NBP * SEQ, MS = NBS * LS, MREAL = MP + MS, NTM = 65, MPAD = NTM * 256;
constexpr int DFF = 2816, NIN = 2 * DFF, HD = 64, NH = 16, NKV = 4, KVD = NKV * HD, WIN = 128, PH = 15;
constexpr int ADAW = 6 * D;
constexpr float EPS = 1e-6f;
constexpr int NPHASE = 19;

constexpr size_t O_Y = 0, O_POOLP = (size_t)MREAL * D, O_KP = O_POOLP + 2 * NBP * PH * D, O_VP = O_KP + (size_t)NBP * WIN * KVD,
                 O_POOLS = O_VP + (size_t)NBP * WIN * KVD, O_KS = O_POOLS + 2 * NBS * PH * D, O_VS = O_KS + (size_t)NBS * WIN * KVD, O_END = O_VS + (size_t)NBS * WIN * KVD;

constexpr size_t MiB = 1u << 20;
constexpr size_t WS_CTL = 0, CTL_ZERO_BYTES = 1 * MiB;
constexpr size_t WS_ADA = 1 * MiB, WS_ADAKV = 2 * MiB, WS_BIN = 3 * MiB, WS_BQ = 4 * MiB, WS_BKV = 4 * MiB + 128 * 1024, WS_SS = 5 * MiB, WS_T = 7 * MiB;
constexpr int T_GATE1 = 0, T_GAINF = 4, T_GATE2 = 8, T_GAINQ = 12, T_GAINKV = 14, T_NVEC = 15, TV = NBATCH * D;
constexpr size_t WS_WPOOL = 8 * MiB, WS_WQ = 9 * MiB, WS_WO = 13 * MiB, WS_WKV = 17 * MiB, WS_WIN = 18 * MiB, WS_WOUT = 62 * MiB;
constexpr size_t WS_KC = 84 * MiB, WS_VC = 84 * MiB + 512 * 1024, WS_KB = 85 * MiB, WS_VB = 94 * MiB;
constexpr size_t WS_AQ = 104 * MiB, WS_AB = 137 * MiB, WS_QO = 170 * MiB, WS_H = 203 * MiB, WS_XH = 293 * MiB, WS_END = 326 * MiB;
constexpr int RSS_N = 7;
static_assert((size_t)(RSS_N + 1) * MPAD * 4 <= 2 * MiB, "rss"); static_assert((size_t)MPAD * D * 2 <= 33 * MiB && (size_t)MPAD * DFF * 2 <= 90 * MiB && (size_t)MPAD * KVD * 2 <= 9 * MiB && (size_t)MPAD * 16 * 4 <= 3 * MiB, "ws map");
constexpr int CW_BAR = 4096, CW_CNT = 8192;

__device__ __forceinline__ unsigned pk_bf16(float lo, float hi) { f32x2 v = {lo, hi}; bf16x2_t b = __builtin_convertvector(v, bf16x2_t); return __builtin_bit_cast(unsigned, b); }
__device__ __forceinline__ float bf_lo(unsigned u) { return __uint_as_float(u << 16); }
__device__ __forceinline__ float bf_hi(unsigned u) { return __uint_as_float(u & 0xffff0000u); }
__device__ __forceinline__ float shx(float v, int mask, int lane) { return __int_as_float(__builtin_amdgcn_ds_bpermute((lane ^ mask) << 2, __float_as_int(v))); }
__device__ __forceinline__ float wave_sum(float v, int lane) {
#pragma unroll
    for (int o = 1; o < 64; o <<= 1) v += shx(v, o, lane);
    return v;
}
__device__ __forceinline__ int batch_of(int row16) { return row16 < MP ? (row16 >> 13) : min(2 + ((row16 - MP) >> 4), NBATCH - 1); }
#ifndef WT_AUX
#define WT_AUX 16
#endif
typedef __amdgpu_buffer_rsrc_t rsrc_t;
__device__ __forceinline__ rsrc_t mk_rsrc(const void* p, unsigned bytes) { return __builtin_amdgcn_make_buffer_rsrc((void*)p, 0, (int)bytes, 0x00020000); }
__device__ __forceinline__ void st16_wt(rsrc_t r, unsigned off, u32x4 v) { __builtin_amdgcn_raw_buffer_store_b128(v, r, (int)off, 0, WT_AUX); }
__device__ __forceinline__ void st16f_wt(rsrc_t r, unsigned off, f32x4 v) { __builtin_amdgcn_raw_buffer_store_b128(__builtin_bit_cast(u32x4, v), r, (int)off, 0, WT_AUX); }
__device__ __forceinline__ void st8_wt(rsrc_t r, unsigned off, u32x2 v) { __builtin_amdgcn_raw_buffer_store_b64(v, r, (int)off, 0, WT_AUX); }
__device__ __forceinline__ void st4_wt(rsrc_t r, unsigned off, float v) { __builtin_amdgcn_raw_buffer_store_b32(__float_as_uint(v), r, (int)off, 0, WT_AUX); }
__device__ __forceinline__ u32x4 ld16u(rsrc_t r, unsigned off) { return __builtin_amdgcn_raw_buffer_load_b128(r, (int)off, 0, 0); }
__device__ __forceinline__ f32x4 ld16f(rsrc_t r, unsigned off) { return __builtin_bit_cast(f32x4, __builtin_amdgcn_raw_buffer_load_b128(r, (int)off, 0, 0)); }
#define LDS_WAIT() asm volatile("s_waitcnt lgkmcnt(0)" ::: "memory")
#define VM_WAIT() asm volatile("s_waitcnt vmcnt(0)" ::: "memory")

namespace pg8 {
constexpr int BM = 256, BK = 64, HALF = 128, HTB = HALF * BK * 2, STAGE_BYTES = 8 * HTB, NXCD = 8, WGM = 8;
__host__ __device__ __forceinline__ int lds_byte(int r, int c) { const int st = (r >> 4) * 2 + (c >> 5), rr = r & 15, cc = c & 31, ob = rr * 64 + cc * 2; return st * 1024 + (ob ^ (((ob >> 9) & 1) << 5)); }
__host__ __device__ __forceinline__ void stage_rc(int b, int& R, int& C) { const int st = b / 1024, sb = b % 1024, swz = sb ^ (((sb >> 9) & 1) << 5); R = (st >> 1) * 16 + swz / 64; C = (st & 1) * 32 + (swz % 64) / 2; }
__host__ __device__ __forceinline__ int perm32(int rho) { const int n = rho >> 4, i = rho & 15; return 8 * (i >> 2) + 4 * n + (i & 3); }

struct Unit { int pm, pn; };
struct Gemm { const bf16_t* A; const bf16_t* Bt; int lda; int a_pn_off; int K; };

struct StaticOrder {
    int nM, nN, nwg, G, c;
    __host__ __device__ void init(int nM_, int nN_, int G_, int c_) { nM = nM_; nN = nN_; nwg = nM * nN; G = G_; c = c_; }
    __host__ __device__ bool next(int i, Unit& u) const {
        const long L = (long)i * G + c; if (L >= nwg) return false;
        int wgid = (int)L; { const int q = nwg / NXCD, r = nwg % NXCD, xcd = wgid % NXCD, off = wgid / NXCD; wgid = (xcd < r ? xcd * (q + 1) : r * (q + 1) + (xcd - r) * q) + off; }
        const int nig = WGM * nN, gid = wgid / nig, fm = gid * WGM, gsz = (nM - fm) < WGM ? (nM - fm) : WGM;
        u.pm = fm + ((wgid % nig) % gsz); u.pn = (wgid % nig) / gsz; return true;
    }
};
constexpr int NPAN = 65;
__device__ __forceinline__ void dep_publish(unsigned* cnt, int seam, int pm, int lane) {
    asm volatile("s_waitcnt vmcnt(0)" ::: "memory");
    if (lane == 0) __hip_atomic_fetch_add(cnt + (size_t)(seam * NPAN + pm) * 64, 1u, __ATOMIC_RELAXED, __HIP_MEMORY_SCOPE_AGENT);
}
__device__ __forceinline__ void dep_poll(unsigned* cnt, int seam, int pm, unsigned need) {
    unsigned* p = cnt + (size_t)(seam * NPAN + pm) * 64;
    const unsigned long long t0 = __builtin_amdgcn_s_memrealtime();
    while ((unsigned)__builtin_amdgcn_readfirstlane(__hip_atomic_load(p, __ATOMIC_RELAXED, __HIP_MEMORY_SCOPE_AGENT)) < need) {
        if (__builtin_amdgcn_s_memrealtime() - t0 > 2000000ull) break;
        __builtin_amdgcn_s_sleep(2); }
}
struct DepOrder : StaticOrder {
    unsigned* cnt; int wseam, pseam; unsigned need_p, need_s; int wait_next; int last_pm;
    __device__ __forceinline__ void a_ready(const Unit& u, int wid) {
        if (wseam < 0 || u.pm == last_pm) return;
        if (wid == 0) {
            dep_poll(cnt, wseam, u.pm, u.pm == NPAN - 1 ? need_s : need_p);
            if (wait_next && u.pm + 1 < NPAN) dep_poll(cnt, wseam, u.pm + 1, u.pm + 1 == NPAN - 1 ? need_s : need_p);
            __builtin_amdgcn_fence(__ATOMIC_ACQUIRE, "agent");
            asm volatile("s_waitcnt vmcnt(0)" ::: "memory");
        }
        asm volatile("" ::: "memory"); __builtin_amdgcn_s_barrier(); asm volatile("" ::: "memory");
        last_pm = u.pm;
    }
    __device__ __forceinline__ void done(const Unit& u, int lane) const { if (pseam >= 0) dep_publish(cnt, pseam, u.pm, lane); }
};

template <class Epi, class Sched, bool ALIGN_EPI = false>
__device__ __forceinline__ void gemm_phase(LAS unsigned char* lds, const int tid, const Gemm g, Sched& S, const Epi& E) {
    const int wid = __builtin_amdgcn_readfirstlane(tid >> 6), lane = tid & 63, wr = wid >> 2, wc = wid & 3, fr = lane & 15, fq = lane >> 4;
    int K = g.K, lda = g.lda; asm volatile("" : "+s"(K), "+s"(lda));
    const int nt = K / BK;
    unsigned voffA[2], voffB[2];
#pragma unroll
    for (int i = 0; i < 2; ++i) { int R, C; stage_rc(tid * 16 + i * 8192, R, C); const int Rb = Epi::PERM ? ((R & ~31) + perm32(R & 31)) : R;
        voffA[i] = (unsigned)(R * lda + C) * 2u; voffB[i] = (unsigned)(Rb * K + C) * 2u; }
    const size_t kstep = (size_t)(BK * 2);
    const size_t hstepA = (size_t)HALF * lda * 2, hstepB = (size_t)HALF * K * 2;
    const size_t tstepA = 2 * hstepA, tstepB = 2 * hstepB;
    const unsigned ldsw = (unsigned)wid * 1024u;
    const int aoff = lds_byte(wr * 64 + fr, fq * 8), boff = lds_byte(wc * 32 + fr, fq * 8);
#define PG8_SA(b, h) (((b) * 2 + (h)) * HTB)
#define PG8_SB(b, h) ((4 + (b) * 2 + (h)) * HTB)
#define PG8_STAGE(bufoff, gbase, voff) do { _Pragma("unroll") for (int _i = 0; _i < 2; ++_i) \
        __builtin_amdgcn_global_load_lds((const unsigned*)((const char*)(gbase) + (voff)[_i]), (LAS unsigned*)(lds + (bufoff) + ldsw + _i * 8192), 16, 0, 0); } while (0)
#define PG8_LDA(dst, b, h) do { _Pragma("unroll") for (int m = 0; m < 4; ++m) _Pragma("unroll") for (int k = 0; k < 2; ++k) dst[m][k] = *(const LAS bf16x8*)(lds + PG8_SA(b, h) + aoff + m * 2048 + k * 1024); } while (0)
#define PG8_LDB(dst, b, h) do { _Pragma("unroll") for (int n = 0; n < 2; ++n) _Pragma("unroll") for (int k = 0; k < 2; ++k) dst[n][k] = *(const LAS bf16x8*)(lds + PG8_SB(b, h) + boff + n * 2048 + k * 1024); } while (0)
#define PG8_MMA(ai, bj, At, Bt) do { __builtin_amdgcn_s_setprio(1); _Pragma("unroll") for (int m = 0; m < 4; ++m) _Pragma("unroll") for (int n = 0; n < 2; ++n) _Pragma("unroll") for (int k = 0; k < 2; ++k) \
        acc[ai][bj][m][n] = __builtin_amdgcn_mfma_f32_16x16x32_bf16(Bt[n][k], At[m][k], acc[ai][bj][m][n], 0, 0, 0); __builtin_amdgcn_s_setprio(0); } while (0)
#define PG8_WAIT_V(n) asm volatile("s_waitcnt vmcnt(" #n ")" ::: "memory")
#define PG8_WAIT_L(n) asm volatile("s_waitcnt lgkmcnt(" #n ")" ::: "memory")
#define PG8_BAR __builtin_amdgcn_s_barrier()
#define PG8_SCHED __builtin_amdgcn_sched_barrier(0)
    Unit cur, nxt; int ui = 0;
    if (!S.next(0, cur)) return;
    f32x4 acc[2][2][4][2];
    const float zf = __int_as_float(tid >> 12);
#pragma unroll
    for (int a = 0; a < 2; ++a)
#pragma unroll
        for (int b = 0; b < 2; ++b)
#pragma unroll
            for (int m = 0; m < 4; ++m)
#pragma unroll
                for (int n = 0; n < 2; ++n) acc[a][b][m][n] = (f32x4){zf, zf, zf, zf};
    bf16x8 At[4][2], B0[2][2], B1[2][2];
    const char* cA = (const char*)g.A + (size_t)cur.pm * tstepA + (size_t)cur.pn * g.a_pn_off * 2; const char* cB = (const char*)g.Bt + (size_t)cur.pn * tstepB;
    S.a_ready(cur, wid);
    PG8_STAGE(PG8_SB(0, 0), cB, voffB); PG8_STAGE(PG8_SB(0, 1), cB + hstepB, voffB); PG8_STAGE(PG8_SA(0, 0), cA, voffA); PG8_STAGE(PG8_SA(0, 1), cA + hstepA, voffA);
    if (wr == 1) PG8_BAR;
    PG8_WAIT_V(2); PG8_BAR;
    PG8_STAGE(PG8_SB(1, 0), cB + kstep, voffB); PG8_STAGE(PG8_SA(1, 0), cA + kstep, voffA); PG8_STAGE(PG8_SB(1, 1), cB + hstepB + kstep, voffB);
    PG8_WAIT_V(6); PG8_BAR;
    for (;;) {
        const bool has_next = S.next(ui + 1, nxt);
        const char* nA = has_next ? (const char*)g.A + (size_t)nxt.pm * tstepA + (size_t)nxt.pn * g.a_pn_off * 2 : cA; const char* nB = has_next ? (const char*)g.Bt + (size_t)nxt.pn * tstepB : cB;
        for (int t = 0; t < nt; t += 2) {
            const bool last = (t == nt - 2);
            const char* a1 = cA + (size_t)(t + 1) * kstep;
            const char* a2 = last ? nA : cA + (size_t)(t + 2) * kstep; const char* b2 = last ? nB : cB + (size_t)(t + 2) * kstep;
            const char* a3 = a2 + kstep; const char* b3 = b2 + kstep;
            if (last && has_next) S.a_ready(nxt, wid);
            PG8_LDB(B0, 0, 0); PG8_LDB(B1, 0, 1); PG8_SCHED; PG8_LDA(At, 0, 0); PG8_STAGE(PG8_SA(1, 1), a1 + hstepA, voffA);
            PG8_WAIT_V(8); PG8_WAIT_L(0); PG8_BAR; PG8_MMA(0, 0, At, B0); PG8_MMA(0, 1, At, B1); PG8_BAR; PG8_SCHED;
            PG8_LDA(At, 0, 1); PG8_STAGE(PG8_SB(0, 0), b2, voffB); PG8_STAGE(PG8_SB(0, 1), b2 + hstepB, voffB); PG8_STAGE(PG8_SA(0, 0), a2, voffA);
            PG8_WAIT_V(8); PG8_WAIT_L(0); PG8_BAR; PG8_MMA(1, 0, At, B0); PG8_MMA(1, 1, At, B1); PG8_BAR; PG8_SCHED;
            PG8_LDB(B0, 1, 0); PG8_LDB(B1, 1, 1); PG8_SCHED; PG8_LDA(At, 1, 0); PG8_STAGE(PG8_SA(0, 1), a2 + hstepA, voffA);
            PG8_WAIT_V(8); PG8_WAIT_L(0); PG8_BAR; PG8_MMA(0, 0, At, B0); PG8_MMA(0, 1, At, B1); PG8_BAR; PG8_SCHED;
            PG8_LDA(At, 1, 1); PG8_STAGE(PG8_SB(1, 0), b3, voffB); PG8_STAGE(PG8_SB(1, 1), b3 + hstepB, voffB); PG8_STAGE(PG8_SA(1, 0), a3, voffA);
            PG8_WAIT_V(8); PG8_WAIT_L(0); PG8_BAR; PG8_MMA(1, 0, At, B0); PG8_MMA(1, 1, At, B1); PG8_BAR; PG8_SCHED;
        }
        if constexpr (ALIGN_EPI) { if (wr == 0) PG8_BAR; }
        E(acc, cur, wr, wc, fr, fq); S.done(cur, lane);
        if (!has_next) break;
#pragma unroll
        for (int a = 0; a < 2; ++a)
#pragma unroll
            for (int b = 0; b < 2; ++b)
#pragma unroll
                for (int m = 0; m < 4; ++m)
#pragma unroll
                    for (int n = 0; n < 2; ++n) acc[a][b][m][n] = (f32x4){zf, zf, zf, zf};
        cur = nxt; cA = nA; cB = nB; ++ui;
        if constexpr (ALIGN_EPI) { if (wr == 1) PG8_BAR; }
    }
    PG8_WAIT_V(0);
    if constexpr (!ALIGN_EPI) { if (wr == 0) PG8_BAR; }
    PG8_BAR;
#undef PG8_SA
#undef PG8_SB
#undef PG8_STAGE
#undef PG8_LDA
#undef PG8_LDB
#undef PG8_MMA
#undef PG8_WAIT_V
#undef PG8_WAIT_L
#undef PG8_BAR
#undef PG8_SCHED
}


template <bool XIN, int NA, bool HAS_SS, bool FINAL = false> struct EpiRes {
    static constexpr bool PERM = true;
    LAS const unsigned char* xin_lds;
    rsrc_t rx, rw;
    int gate_id, g1_id, g2_id; float* rss;
    __device__ __forceinline__ void operator()(const f32x4 (&acc)[2][2][4][2], const Unit& u, int wr, int wc, int fr, int fq) const {
        const unsigned colb = (unsigned)(u.pn * BM + wc * 32 + 8 * fq), toff = (unsigned)(u.pm >> 5) * D + colb;
        const unsigned gate = (unsigned)WS_T + ((unsigned)gate_id * TV + toff) * 4, g1 = (unsigned)WS_T + ((unsigned)g1_id * TV + toff) * 4, g2 = (unsigned)WS_T + ((unsigned)g2_id * TV + toff) * 4;
        const float* xo = nullptr;
        if (XIN) { const unsigned long long pv = ((const LAS unsigned long long*)xin_lds)[0];
            xo = (const float*)(((unsigned long long)(unsigned)__builtin_amdgcn_readfirstlane((int)(pv >> 32)) << 32) | (unsigned)__builtin_amdgcn_readfirstlane((int)pv)); }
        const unsigned row0 = (unsigned)(u.pm * BM + wr * 64 + fr);
        float ssq[8];
#pragma unroll
        for (int g_ = 0; g_ < 8; ++g_) ssq[g_] = 0.f;
#define E1_LOADX(dst, g_, bj_) do { const unsigned xoff_ = (row0 + ((g_) >> 2) * HALF + ((g_) & 3) * 16) * D + colb + (bj_) * HALF; \
            if (XIN) { const f32x4 t0_ = *(const f32x4*)(xo + xoff_), t1_ = *(const f32x4*)(xo + xoff_ + 4); dst = (f32x8){t0_[0], t0_[1], t0_[2], t0_[3], t1_[0], t1_[1], t1_[2], t1_[3]}; } \
            else dst = __builtin_convertvector(__builtin_bit_cast(h16x8, ld16u(rw, (unsigned)WS_XH + xoff_ * 2)), f32x8); } while (0)
#pragma unroll
        for (int bj = 0; bj < 2; ++bj) {
            f32x4 gt[2], ga[2], gb[2]; f32x8 xc, xn_;
#pragma unroll
            for (int n = 0; n < 2; ++n) { gt[n] = ld16f(rw, gate + (bj * HALF + 4 * n) * 4);
                if (NA >= 1) ga[n] = ld16f(rw, g1 + (bj * HALF + 4 * n) * 4);
                if (NA >= 2) gb[n] = ld16f(rw, g2 + (bj * HALF + 4 * n) * 4); }
            E1_LOADX(xc, 0, bj);
#pragma unroll
            for (int g_ = 0; g_ < 8; ++g_) {
                const int ai = g_ >> 2, m = g_ & 3;
                if (g_ < 7) E1_LOADX(xn_, g_ + 1, bj);
                const unsigned ooff = (row0 + ai * HALF + m * 16) * D + colb + bj * HALF;
                const f32x4 na = (f32x4){xc[0], xc[1], xc[2], xc[3]} + gt[0] * acc[ai][bj][m][0], nb = (f32x4){xc[4], xc[5], xc[6], xc[7]} + gt[1] * acc[ai][bj][m][1];
                if (FINAL) { st16f_wt(rx, ooff * 4, na); st16f_wt(rx, (ooff + 4) * 4, nb); }
                else { const h16x8 hv = __builtin_convertvector((f32x8){na[0], na[1], na[2], na[3], nb[0], nb[1], nb[2], nb[3]}, h16x8); st16_wt(rw, (unsigned)WS_XH + ooff * 2, __builtin_bit_cast(u32x4, hv)); }
                if (HAS_SS) ssq[g_] += ((na[0] * na[0] + na[1] * na[1]) + (na[2] * na[2] + na[3] * na[3])) + ((nb[0] * nb[0] + nb[1] * nb[1]) + (nb[2] * nb[2] + nb[3] * nb[3]));
                if (NA >= 1) { const f32x4 pa = na * ga[0], pb = nb * ga[1];
                    u32x4 w; w.x = pk_bf16(pa[0], pa[1]); w.y = pk_bf16(pa[2], pa[3]); w.z = pk_bf16(pb[0], pb[1]); w.w = pk_bf16(pb[2], pb[3]); st16_wt(rw, (unsigned)WS_AQ + ooff * 2, w); }
                if (NA >= 2) { const f32x4 pa = na * gb[0], pb = nb * gb[1];
                    u32x4 w; w.x = pk_bf16(pa[0], pa[1]); w.y = pk_bf16(pa[2], pa[3]); w.z = pk_bf16(pb[0], pb[1]); w.w = pk_bf16(pb[2], pb[3]); st16_wt(rw, (unsigned)WS_AB + ooff * 2, w); }
                asm volatile("" ::: "memory");
                xc = xn_;
            }
        }
        if (HAS_SS) {
#pragma unroll
            for (int g_ = 0; g_ < 8; ++g_) { float ss = ssq[g_]; ss += shx(ss, 16, fq * 16 + fr); ss += shx(ss, 32, fq * 16 + fr); if (fq == 0) unsafeAtomicAdd(rss + row0 + (g_ >> 2) * HALF + (g_ & 3) * 16, ss); }
        }
#undef E1_LOADX
    }
};

__device__ __forceinline__ float rstd_of(float sumsq) { return 1.0f / sqrtf(sumsq * (1.0f / D) + EPS); }
__device__ __forceinline__ float silu_f(float g) { return g * __builtin_amdgcn_rcpf(1.0f + __builtin_amdgcn_exp2f(-1.4426950408889634f * g)); }

struct EpiSwiglu {
    static constexpr bool PERM = true;
    const float* rss; const float* bias;
    rsrc_t rw;
    __device__ __forceinline__ void operator()(const f32x4 (&acc)[2][2][4][2], const Unit& u, int wr, int wc, int fr, int fq) const {
        const int pc = u.pn * BM + wc * 32 + 8 * fq;
        const bool prompt = u.pm < MP / BM;
        const unsigned row0 = (unsigned)(u.pm * BM + wr * 64 + fr);
        float rs[8];
#pragma unroll
        for (int g_ = 0; g_ < 8; ++g_) rs[g_] = rss[row0 + (g_ >> 2) * HALF + (g_ & 3) * 16];
        f32x4 bg[2], bu[2];
        { const float* bp = bias + (size_t)(prompt ? (u.pm >> 5) : NBP) * NIN + pc;
#pragma unroll
          for (int n = 0; n < 2; ++n) { bg[n] = *(const f32x4*)(bp + 4 * n); bu[n] = *(const f32x4*)(bp + HALF + 4 * n); } }
#pragma unroll
        for (int g_ = 0; g_ < 8; ++g_) {
            const int ai = g_ >> 2, m = g_ & 3;
            const unsigned row = row0 + ai * HALF + m * 16;
            if (!prompt) { const float* bp = bias + (size_t)batch_of((int)(row - fr)) * NIN + pc;
#pragma unroll
                for (int n = 0; n < 2; ++n) { bg[n] = *(const f32x4*)(bp + 4 * n); bu[n] = *(const f32x4*)(bp + HALF + 4 * n); } }
            const float r = rstd_of(rs[g_]);
            u32x4 w;
#pragma unroll
            for (int n = 0; n < 2; ++n) {
                const f32x4 gv = acc[ai][0][m][n] * r + bg[n], uv = acc[ai][1][m][n] * r + bu[n];
                const float h0 = silu_f(gv[0]) * uv[0], h1 = silu_f(gv[1]) * uv[1], h2 = silu_f(gv[2]) * uv[2], h3 = silu_f(gv[3]) * uv[3];
                if (n == 0) { w.x = pk_bf16(h0, h1); w.y = pk_bf16(h2, h3); } else { w.z = pk_bf16(h0, h1); w.w = pk_bf16(h2, h3); }
            }
            st16_wt(rw, (unsigned)WS_H + (row * DFF + u.pn * HALF + wc * 32 + 8 * fq) * 2, w);
        }
    }
};

template <int MODE> struct EpiHead {
    static constexpr bool PERM = true;
    const float* rss; const float* bias; int bias_stride; const float* gvec; float oscale;
    rsrc_t rw; float* fk_p; float* fv_p; float* fk_s; float* fv_s;
    __device__ __forceinline__ void operator()(const f32x4 (&acc)[2][2][4][2], const Unit& u, int wr, int wc, int fr, int fq) const {
        const bool isv = (MODE == 1) && (u.pn == 1);
        const int ldo = (MODE == 0) ? D : KVD;
        const int ocol = (MODE == 0 ? (4 * u.pn + wc) * HD : wc * HD) + 8 * fq;
        const unsigned Ob = (MODE == 0) ? (unsigned)WS_QO : (isv ? (unsigned)WS_VB : (unsigned)WS_KB);
        const bool prompt = u.pm < MP / BM;
        float rsv[8];
#pragma unroll
        for (int g_ = 0; g_ < 8; ++g_) rsv[g_] = rss[u.pm * BM + wr * 64 + fr + (g_ >> 2) * HALF + (g_ & 3) * 16];
        f32x4 bv[2][2];
        { const float* bp = bias + (size_t)(prompt ? (u.pm >> 5) : NBP) * bias_stride + u.pn * BM + wc * 32 + 8 * fq;
#pragma unroll
          for (int bj = 0; bj < 2; ++bj)
#pragma unroll
              for (int n = 0; n < 2; ++n) bv[bj][n] = *(const f32x4*)(bp + bj * HALF + 4 * n); }
#pragma unroll
        for (int ai = 0; ai < 2; ++ai)
#pragma unroll
            for (int m = 0; m < 4; ++m) {
                const int row16 = u.pm * BM + ai * HALF + wr * 64 + m * 16, row = row16 + fr;
                const float rs = rstd_of(rsv[ai * 4 + m]);
                if (!prompt) { const float* bp = bias + (size_t)batch_of(row16) * bias_stride + u.pn * BM + wc * 32 + 8 * fq;
#pragma unroll
                    for (int bj = 0; bj < 2; ++bj)
#pragma unroll
                        for (int n = 0; n < 2; ++n) bv[bj][n] = *(const f32x4*)(bp + bj * HALF + 4 * n); }
                f32x4 v[2][2]; float ss = 0.f;
#pragma unroll
                for (int bj = 0; bj < 2; ++bj)
#pragma unroll
                    for (int n = 0; n < 2; ++n) { v[bj][n] = acc[ai][bj][m][n] * rs + bv[bj][n];
                        ss += (v[bj][n][0] * v[bj][n][0] + v[bj][n][1] * v[bj][n][1]) + (v[bj][n][2] * v[bj][n][2] + v[bj][n][3] * v[bj][n][3]); }
                ss += shx(ss, 16, fq * 16 + fr); ss += shx(ss, 32, fq * 16 + fr);
                const float hr = 1.0f / sqrtf(ss * (1.0f / HD) + EPS);
                if (!isv) {
#pragma unroll
                    for (int bj = 0; bj < 2; ++bj)
#pragma unroll
                        for (int n = 0; n < 2; ++n) v[bj][n] = v[bj][n] * (hr * oscale) * *(const f32x4*)(gvec + 32 * bj + 8 * fq + 4 * n);
                }
                float* ftail = nullptr;
                if (MODE == 1) {
                    if (row < MP) { const int t = row & (SEQ - 1); if (t >= SEQ - WIN) ftail = (isv ? fv_p : fk_p) + ((size_t)(row >> 13) * WIN + (t - (SEQ - WIN))) * KVD; }
                    else if (row < MREAL) { const int bs = (row - MP) >> 4, t = (row - MP) & 15; ftail = (isv ? fv_s : fk_s) + ((size_t)bs * WIN + (WIN - LS) + t) * KVD; }
                }
#pragma unroll
                for (int bj = 0; bj < 2; ++bj) {
                    u32x4 w; w.x = pk_bf16(v[bj][0][0], v[bj][0][1]); w.y = pk_bf16(v[bj][0][2], v[bj][0][3]); w.z = pk_bf16(v[bj][1][0], v[bj][1][1]); w.w = pk_bf16(v[bj][1][2], v[bj][1][3]);
                    st16_wt(rw, Ob + ((unsigned)row * ldo + ocol + 32 * bj) * 2, w);
                    if (MODE == 1) { if (ftail) { *(f32x4*)(ftail + ocol + 32 * bj) = v[bj][0]; *(f32x4*)(ftail + ocol + 32 * bj + 4) = v[bj][1]; } }
                }
                asm volatile("" ::: "memory");
            }
    }
};
}

namespace sk {
struct Gemm { const bf16_t* A; int lda; int a_grp; const bf16_t* Bt; int K; int headperm; };
struct Res { const float* xin_s; float* Xf; _Float16* XH; const float* gate; const float* g1; const float* g2; bf16_t* A1; bf16_t* A2; float* SS; };
struct Head { const float* SS; const float* bias; const float* gvec; float oscale; bf16_t* O; };

template <int KIND, int NT> __device__ __forceinline__ void run(LAS unsigned char* lds, int tid, int tile, const Gemm g, const Res R, const Head H) {
    typedef const __attribute__((address_space(1))) bf16x8* gfrag_p;
    const int lane = tid & 63, wid = __builtin_amdgcn_readfirstlane(tid >> 6), fr = lane & 15, fq = lane >> 4;
    const int rt = tile & 3, ct = tile >> 2, K = g.K, kw = K >> 3, nst = kw >> 5;
    const int col0 = ct * 16 * NT;
    const bf16_t* ap = g.A + (size_t)(MP + 32 * rt + fr) * g.lda + (g.a_grp ? 256 * (col0 >> 8) : 0) + wid * kw + 8 * fq;
    const int brow0 = g.headperm ? 256 * (ct >> 2) + 32 * (ct & 3) : col0;
    const bf16_t* bp = g.Bt + (size_t)(brow0 + fr) * K + wid * kw + 8 * fq;
    const size_t bst1 = (size_t)16 * K, bst2 = g.headperm ? (size_t)128 * K : (size_t)32 * K;
    const float zf = __int_as_float(tid >> 12);
    f32x4 acc[2][NT];
#pragma unroll
    for (int mi = 0; mi < 2; ++mi)
#pragma unroll
        for (int ni = 0; ni < NT; ++ni) acc[mi][ni] = (f32x4){zf, zf, zf, zf};
    constexpr int NB = NT == 1 ? 11 : 4;
    for (int s0 = 0; s0 < nst; s0 += NB) {
        bf16x8 af[NB][2], bf[NB][NT];
#pragma unroll
        for (int q = 0; q < NB; ++q) { const int s_ = (s0 + q < nst) ? s0 + q : s0;
#pragma unroll
            for (int mi = 0; mi < 2; ++mi) af[q][mi] = *(gfrag_p)(ap + (size_t)(16 * mi) * g.lda + 32 * s_);
#pragma unroll
            for (int ni = 0; ni < NT; ++ni) bf[q][ni] = *(gfrag_p)(bp + (ni & 1) * bst1 + (ni >> 1) * bst2 + 32 * s_); }
#pragma unroll
        for (int q = 0; q < NB; ++q) if (s0 + q < nst) {
#pragma unroll
            for (int mi = 0; mi < 2; ++mi)
#pragma unroll
                for (int ni = 0; ni < NT; ++ni) acc[mi][ni] = __builtin_amdgcn_mfma_f32_16x16x32_bf16(bf[q][ni], af[q][mi], acc[mi][ni], 0, 0, 0); }
    }
    LAS f32x4* red = (LAS f32x4*)lds;
#pragma unroll
    for (int mi = 0; mi < 2; ++mi)
#pragma unroll
        for (int ni = 0; ni < NT; ++ni) red[(wid * 2 * NT + mi * NT + ni) * 64 + lane] = acc[mi][ni];
    LDS_WAIT(); __syncthreads();
    const int rl = NT == 4 ? 4 * wid + (lane >> 4) : (tid >> 2) & 31, c4 = NT == 4 ? (lane & 15) : (tid & 3);
    const bool act = NT == 4 || tid < 128;
    f32x4 v = {0.f, 0.f, 0.f, 0.f};
    if (act) { const int idx = ((rl >> 4) * NT + (c4 >> 2)) * 64 + (c4 & 3) * 16 + (rl & 15);
#pragma unroll
      for (int w = 0; w < 8; ++w) v += red[w * 128 * NT + idx]; }
    const int srow = 32 * rt + rl, row = MP + srow, b = NBP + (srow >> 4), col = col0 + 4 * c4;
    if (KIND == 0) {
        if (act) {
        f32x4 x4;
        if (R.xin_s) x4 = *(const f32x4*)(R.xin_s + (size_t)srow * D + col);
        else x4 = __builtin_convertvector(*(const h16x4*)(R.XH + (size_t)row * D + col), f32x4);
        const f32x4 xn = x4 + *(const f32x4*)(R.gate + b * D + col) * v;
        if (R.Xf) *(f32x4*)(R.Xf + (size_t)row * D + col) = xn; else *(h16x4*)(R.XH + (size_t)row * D + col) = __builtin_convertvector(xn, h16x4);
        if (R.SS) { float ss = (xn[0] * xn[0] + xn[1] * xn[1]) + (xn[2] * xn[2] + xn[3] * xn[3]);
            ss += shx(ss, 1, lane); ss += shx(ss, 2, lane); if (NT == 4) { ss += shx(ss, 4, lane); ss += shx(ss, 8, lane); }
            if (c4 == 0) unsafeAtomicAdd(R.SS + row, ss); }
        if (R.A1) { const f32x4 a = xn * *(const f32x4*)(R.g1 + b * D + col); u32x2 w; w.x = pk_bf16(a[0], a[1]); w.y = pk_bf16(a[2], a[3]); *(u32x2*)(R.A1 + (size_t)row * D + col) = w; }
        if (R.A2) { const f32x4 a = xn * *(const f32x4*)(R.g2 + b * D + col); u32x2 w; w.x = pk_bf16(a[0], a[1]); w.y = pk_bf16(a[2], a[3]); *(u32x2*)(R.A2 + (size_t)row * D + col) = w; }
        }
    } else {
        const int d = 4 * c4, phys = 256 * (ct >> 2) + 32 * (ct & 3) + 128 * (d >> 5) + (d & 31);
        const float rs = pg8::rstd_of(H.SS[row]);
        f32x4 q = v * rs + *(const f32x4*)(H.bias + (size_t)b * D + phys);
        float ss = (q[0] * q[0] + q[1] * q[1]) + (q[2] * q[2] + q[3] * q[3]);
        ss += shx(ss, 1, lane); ss += shx(ss, 2, lane); ss += shx(ss, 4, lane); ss += shx(ss, 8, lane);
        const float hr = 1.0f / sqrtf(ss * (1.0f / HD) + EPS);
        q = q * (hr * H.oscale) * *(const f32x4*)(H.gvec + d);
        u32x2 w; w.x = pk_bf16(q[0], q[1]); w.y = pk_bf16(q[2], q[3]); *(u32x2*)(H.O + (size_t)row * D + 64 * ct + d) = w;
    }
    LDS_WAIT(); __syncthreads();
}
}

namespace att {
constexpr int SLOTB = 8192;
constexpr int L_K = 0, L_V = 3 * SLOTB, L_WS = 6 * SLOTB, L_OST = L_WS + 8 * 256, L_BYTES = L_OST + 8 * 4096;
constexpr float LOG2E = 1.4426950408889634f, C2 = 0.125f * LOG2E, NEG = -1e30f;
__device__ __forceinline__ int crow(int r, int hi) { return (r & 3) + 8 * (r >> 2) + 4 * hi; }
typedef short v4i16_t __attribute__((ext_vector_type(4)));
__device__ __forceinline__ s16x4 vtr(const LAS unsigned char* p) { return __builtin_bit_cast(s16x4, __builtin_amdgcn_ds_read_tr16_b64_v4i16((LAS v4i16_t*)p)); }

struct UnitDesc { int row0, nq, g; const bf16_t* kp[3]; const bf16_t* vp[3]; int nv[3]; };
__device__ __forceinline__ UnitDesc decode(int u, const bf16_t* Kb, const bf16_t* Vb, const bf16_t* KC, const bf16_t* VC) {
    UnitDesc d; int bidx, c;
    if (u < NBP * 128 * NKV) { d.g = u & 3; c = (u >> 2) & 127; bidx = u >> 9; } else { const int v = u - NBP * 128 * NKV; d.g = v & 3; c = 0; bidx = NBP + (v >> 2); }
    if (bidx < NBP) {
        d.row0 = bidx * SEQ + 64 * c; d.nq = 64;
#pragma unroll
        for (int s = 0; s < 3; ++s) { const int tc = c - 2 + s; d.nv[s] = tc >= 0 ? 64 : 0; const int tcc = tc >= 0 ? tc : 0; d.kp[s] = Kb + (size_t)(bidx * SEQ + 64 * tcc) * KVD; d.vp[s] = Vb + (size_t)(bidx * SEQ + 64 * tcc) * KVD; }
    } else {
        const int bs = bidx - NBP; d.row0 = MP + bs * LS; d.nq = LS;
        d.kp[0] = KC + (size_t)(bs * WIN) * KVD; d.kp[1] = d.kp[0] + 64 * KVD; d.kp[2] = Kb + (size_t)d.row0 * KVD;
        d.vp[0] = VC + (size_t)(bs * WIN) * KVD; d.vp[1] = d.vp[0] + 64 * KVD; d.vp[2] = Vb + (size_t)d.row0 * KVD;
        d.nv[0] = 64; d.nv[1] = 64; d.nv[2] = LS;
    }
    return d;
}
constexpr int BUFB = 6 * SLOTB, L_WS2 = 2 * BUFB;
__device__ __forceinline__ void issue_kv(LAS unsigned char* buf, const UnitDesc& d, int lane, int wid) {
#pragma unroll
    for (int s = 0; s < 3; ++s) if (d.nv[s] > 0) {
        const bf16_t* ks = d.kp[s] + (size_t)lane * KVD + d.g * HD + wid * 8;
        const bf16_t* vs = d.vp[s] + (size_t)(16 * (wid & 3) + (lane >> 2)) * KVD + d.g * HD + (wid >> 2) * 32 + (lane & 3) * 8;
        __builtin_amdgcn_global_load_lds((const unsigned*)ks, (LAS unsigned*)(buf + s * SLOTB + wid * 1024), 16, 0, 0);
        __builtin_amdgcn_global_load_lds((const unsigned*)vs, (LAS unsigned*)(buf + 3 * SLOTB + s * SLOTB + wid * 1024), 16, 0, 0);
    }
}
__device__ __forceinline__ void load_q(const UnitDesc& d, const bf16_t* Q, int lane, int wid, bf16x8 (&qr)[4]) {
    const bf16_t* Qw = Q + (size_t)(d.row0 + 32 * (wid & 1) + (lane & 31)) * D + (4 * d.g + (wid >> 1)) * HD + (lane >> 5) * 8;
#pragma unroll
    for (int d0 = 0; d0 < 4; ++d0) qr[d0] = *(const __attribute__((address_space(1))) bf16x8*)(Qw + d0 * 16);
}
__device__ __forceinline__ void attn_phase(LAS unsigned char* lds, const int tid, int u, const int G, int NU, int u2, const int NU2, const bf16_t* Q, unsigned char* ws, const bf16_t* Kb, const bf16_t* Vb, const bf16_t* KC, const bf16_t* VC, const float* sinks) {
    if (u >= NU) { u = u2; NU = NU2; u2 = NU2; if (u >= NU) return; }
    const int lane = tid & 63, r32 = lane & 31, hi = lane >> 5; const int wid = __builtin_amdgcn_readfirstlane(tid >> 6);
    const rsrc_t rw = mk_rsrc(ws, (unsigned)WS_END);
    const float zf = __int_as_float(tid >> 12);
    UnitDesc cur = decode(u, Kb, Vb, KC, VC);
    bf16x8 qr[4];
    int bsel = 0;
    issue_kv(lds, cur, lane, wid); load_q(cur, Q, lane, wid, qr);
    for (;;) {
        LAS unsigned char* buf = lds + bsel * BUFB;
        asm volatile("s_waitcnt vmcnt(0)" ::: "memory"); __builtin_amdgcn_s_barrier(); asm volatile("" ::: "memory");
        int un = u + G; if (un >= NU && u2 < NU2) { un = u2; NU = NU2; u2 = NU2; }
        const bool has_next = un < NU;
        int ln = lane; asm volatile("" : "+v"(ln));
        if (has_next) { const UnitDesc nxt = decode(un, Kb, Vb, KC, VC); issue_kv(lds + (bsel ^ 1) * BUFB, nxt, ln, wid); }
        const int head = 4 * cur.g + (wid >> 1), qoff = 32 * (wid & 1);
        const float sink2 = sinks[head] * LOG2E;
        f32x16 p[3][2];
        float mx = sink2;
#pragma unroll
        for (int s = 0; s < 3; ++s) if (cur.nv[s] > 0) {
            const LAS unsigned char* kb = buf + s * SLOTB + hi * 1024 + r32 * 16;
            f32x16 p0, p1;
#pragma unroll
            for (int r = 0; r < 16; ++r) { p0[r] = zf; p1[r] = zf; }
#pragma unroll
            for (int d0 = 0; d0 < 4; ++d0) {
                const bf16x8 b0 = *(const LAS bf16x8*)(kb + d0 * 2048), b1 = *(const LAS bf16x8*)(kb + d0 * 2048 + 512);
                p0 = __builtin_amdgcn_mfma_f32_32x32x16_bf16(b0, qr[d0], p0, 0, 0, 0); p1 = __builtin_amdgcn_mfma_f32_32x32x16_bf16(b1, qr[d0], p1, 0, 0, 0);
            }
            if (cur.nv[s] < 64) {
#pragma unroll
                for (int r = 0; r < 16; ++r) { const int kv = crow(r, hi); if (kv >= cur.nv[s]) p0[r] = NEG; if (kv + 32 >= cur.nv[s]) p1[r] = NEG; }
            }
#pragma unroll
            for (int r = 0; r < 16; ++r) mx = fmaxf(mx, fmaxf(p0[r], p1[r]));
            p[s][0] = p0; p[s][1] = p1;
            __builtin_amdgcn_sched_barrier(0);
        }
        asm volatile("" ::: "memory");
        mx = fmaxf(mx, shx(mx, 32, lane));
        const int head_c = 4 * cur.g + (wid >> 1), row0_c = cur.row0, nq_c = cur.nq, nv0 = cur.nv[0], nv1 = cur.nv[1], nv2 = cur.nv[2];
        float l = 0.f;
        f32x16 o[2];
#pragma unroll
        for (int r = 0; r < 16; ++r) { o[0][r] = zf; o[1][r] = zf; }
        const LAS unsigned char* vb0 = buf + 3 * SLOTB + ((lane >> 4) & 1) * 32 + (lane & 3) * 8 + (4 * hi + ((lane & 15) >> 2)) * 64;
#pragma unroll
        for (int s = 0; s < 3; ++s) if ((s == 0 ? nv0 : s == 1 ? nv1 : nv2) > 0) {
            u32x4 pw[4];
#pragma unroll
            for (int h2 = 0; h2 < 2; ++h2) {
                f32x16 e;
#pragma unroll
                for (int r = 0; r < 16; ++r) { e[r] = __builtin_amdgcn_exp2f(p[s][h2][r] - mx); l += e[r]; }
#pragma unroll
                for (int q = 0; q < 2; ++q) { u32x4 w; w.x = pk_bf16(e[8 * q], e[8 * q + 1]); w.y = pk_bf16(e[8 * q + 2], e[8 * q + 3]); w.z = pk_bf16(e[8 * q + 4], e[8 * q + 5]); w.w = pk_bf16(e[8 * q + 6], e[8 * q + 7]); pw[2 * h2 + q] = w; }
            }
#pragma unroll
            for (int ks = 0; ks < 4; ++ks) {
                const bf16x8 pa = __builtin_bit_cast(bf16x8, pw[ks]);
#pragma unroll
                for (int d0 = 0; d0 < 2; ++d0) {
                    const s16x4 lo = vtr(vb0 + s * SLOTB + d0 * 4096 + ks * 1024), hh = vtr(vb0 + s * SLOTB + d0 * 4096 + ks * 1024 + 512);
                    const bf16x8 vf = (bf16x8){lo[0], lo[1], lo[2], lo[3], hh[0], hh[1], hh[2], hh[3]};
                    o[d0] = __builtin_amdgcn_mfma_f32_32x32x16_bf16(pa, vf, o[d0], 0, 0, 0);
                }
            }
            __builtin_amdgcn_sched_barrier(0);
        }
        l += shx(l, 32, lane);
        l += __builtin_amdgcn_exp2f(sink2 - mx);
        LAS float* wsf = (LAS float*)(lds + L_WS2) + wid * 64;
        if (hi == 0) wsf[r32] = l;
        LDS_WAIT();
        asm volatile("s_waitcnt lgkmcnt(0)" ::: "memory"); __builtin_amdgcn_s_barrier(); asm volatile("" ::: "memory");
        LAS bf16_t* stg = (LAS bf16_t*)buf + wid * 2048;
#pragma unroll
        for (int r = 0; r < 16; ++r) { const int orow = crow(r, hi); const float rl_ = __builtin_amdgcn_rcpf(wsf[orow]);
#pragma unroll
            for (int d0 = 0; d0 < 2; ++d0) stg[orow * 64 + d0 * 32 + r32] = (bf16_t)(pk_bf16(o[d0][r] * rl_, 0.f) & 0xffffu); }
        LDS_WAIT();
#pragma unroll
        for (int i = 0; i < 4; ++i) { const int row = i * 8 + (lane >> 3), ch = lane & 7; const u32x4 v = *(const LAS u32x4*)(stg + row * 64 + ch * 8);
            if (qoff + row < nq_c) st16_wt(rw, (unsigned)WS_AB + ((unsigned)(row0_c + qoff + row) * D + head_c * HD + ch * 8) * 2, v); }
        if (!has_next) break;
        cur = decode(un, Kb, Vb, KC, VC); load_q(cur, Q, ln, wid, qr);
        u = un; bsel ^= 1;
    }
    asm volatile("s_waitcnt vmcnt(0) lgkmcnt(0)" ::: "memory"); __builtin_amdgcn_s_barrier(); asm volatile("" ::: "memory");
}
}

constexpr int NWAVES = 8;
constexpr int RING_BYTES = 131072, LDSCTL_OFF = RING_BYTES, MISC_OFF = LDSCTL_OFF + 320, XIN_OFF = LDSCTL_OFF + 512, LDS_BYTES = 147456;

#define XB_TMO      128
#define XB_XCNT(j)  (256  + 64 * (j))
#define XB_XSUB(j)  (1280 + 64 * (j))
#define XB_XGEN(j)  (2304 + 64 * (j))
#define XB_TOP      3328
#define XB_TOPGEN   3392
#define XCD_BAR_WORDS 3456
#define XB_SPIN_CAP (1u << 18)
__device__ __forceinline__ unsigned xb_ld(unsigned* p)              { return __hip_atomic_load(p, __ATOMIC_RELAXED, __HIP_MEMORY_SCOPE_AGENT); }
__device__ __forceinline__ unsigned xb_add(unsigned* p, unsigned v) { return __hip_atomic_fetch_add(p, v, __ATOMIC_RELAXED, __HIP_MEMORY_SCOPE_AGENT); }
__device__ __forceinline__ unsigned xb_xcc_id() { return (unsigned)__builtin_amdgcn_s_getreg((3 << 11) | 20) & 0xFu; }
#define XB_SPIN(cond, bar) do { unsigned _sp = 0; while (cond) { __builtin_amdgcn_s_sleep(1); \
    if ((++_sp & 255u) == 0u) { if (xb_ld(&(bar)[XB_TMO])) break; if (_sp > XB_SPIN_CAP) { atomicAdd(&(bar)[XB_TMO], 1u); break; } } } } while (0)
struct XcdBarrier { unsigned* bar; unsigned x; volatile LAS unsigned* st; };
__device__ __forceinline__ XcdBarrier xcd_barrier_post(unsigned* bar, volatile LAS unsigned* st) {
    XcdBarrier b; b.bar = bar; b.x = xb_xcc_id(); b.st = st;
    if (threadIdx.x == 0) (void)xb_add(&bar[XB_XCNT(b.x)], 1u);
    return b;
}
__device__ __forceinline__ void xcd_barrier_complete(unsigned* bar, unsigned x, unsigned& nloc, unsigned& nx) {
    const unsigned G = gridDim.x * gridDim.y * gridDim.z;
    unsigned sum, cnt, mine, sp = 0u;
    for (;;) {
        sum = 0u; cnt = 0u; mine = 0u;
#pragma unroll
        for (unsigned j = 0; j < 16; ++j) { const unsigned c = xb_ld(&bar[XB_XCNT(j)]); sum += c; cnt += (c > 0u) ? 1u : 0u; mine = (j == x) ? c : mine; }
        if (sum == G) break;
        __builtin_amdgcn_s_sleep(1);
        if ((++sp & 255u) == 0u) { if (xb_ld(&bar[XB_TMO])) break; if (sp > XB_SPIN_CAP) { atomicAdd(&bar[XB_TMO], 1u); break; } }
    }
    nloc = mine > 0u ? mine : 1u; nx = cnt > 0u ? cnt : 1u;
}
__device__ __forceinline__ void xcd_barrier(const XcdBarrier& b, const int tid) {
    asm volatile("s_waitcnt vmcnt(0)" ::: "memory");
    __syncthreads();
    if (tid == 0) {
        unsigned* bar = b.bar; asm volatile("" : "+s"(bar));
        __builtin_amdgcn_s_waitcnt(0);
        unsigned nloc = b.st[0], nx = b.st[1];
        if (nloc == 0u) { xcd_barrier_complete(bar, b.x, nloc, nx); b.st[0] = nloc; b.st[1] = nx; }
        const unsigned old = xb_add(&bar[XB_XSUB(b.x)], 1u);
        const unsigned gen = old / nloc;
        if (old + 1u == (gen + 1u) * nloc) {
            __builtin_amdgcn_fence(__ATOMIC_RELEASE, "agent");
            asm volatile("s_waitcnt vmcnt(0)" ::: "memory");
            const unsigned og = xb_add(&bar[XB_TOP], 1u);
            const unsigned tg = og / nx;
            if (og + 1u == (tg + 1u) * nx) xb_add(&bar[XB_TOPGEN], 1u);
            else XB_SPIN(xb_ld(&bar[XB_TOPGEN]) == tg, bar);
            __builtin_amdgcn_fence(__ATOMIC_ACQUIRE, "agent");
            xb_add(&bar[XB_XGEN(b.x)], 1u);
            asm volatile("s_waitcnt vmcnt(0)" ::: "memory");
        } else {
            XB_SPIN(xb_ld(&bar[XB_XGEN(b.x)]) == gen, bar);
            __builtin_amdgcn_fence(__ATOMIC_ACQUIRE, "agent");
            asm volatile("s_waitcnt vmcnt(0)" ::: "memory");
        }
    }
    __syncthreads();
}

struct Args { const float* in[24]; float* out; unsigned char* ws; int ph_lo, ph_hi; };

struct Frame {
    LAS unsigned char* lds; int tid, lane, wave, vcu, G;
    float* out; unsigned char* ws;
};
#define FIN(i) (args.in[i])

__device__ __forceinline__ void transpose_item(const float* W, int ldn, int K, int k0, int s0, bf16_t* WT, int p0, LAS float* scr, int lane) {
    float wv[32];
    const float* wp = W + (size_t)(k0 + (lane >> 5)) * ldn + s0 + (lane & 31);
#pragma unroll
    for (int i = 0; i < 32; ++i) wv[i] = wp[(size_t)(2 * i) * ldn];
#pragma unroll
    for (int i = 0; i < 32; ++i) scr[(2 * i + (lane >> 5)) * 33 + (lane & 31)] = wv[i];
    LDS_WAIT(); asm volatile("" ::: "memory");
    const int c = lane & 7;
#pragma unroll
    for (int j = 0; j < 4; ++j) { const int n = (lane >> 3) + 8 * j; const LAS float* s = scr + (8 * c) * 33 + n;
        u32x4 o; o.x = pk_bf16(s[0 * 33], s[1 * 33]); o.y = pk_bf16(s[2 * 33], s[3 * 33]); o.z = pk_bf16(s[4 * 33], s[5 * 33]); o.w = pk_bf16(s[6 * 33], s[7 * 33]);
        *(u32x4*)(WT + (size_t)(p0 + n) * K + k0 + 8 * c) = o; }
    LDS_WAIT(); asm volatile("" ::: "memory");
}
__device__ __forceinline__ int headperm_src(int p0) { const int pn = p0 >> 8, bj = (p0 >> 7) & 1, wc = (p0 >> 5) & 3; return (4 * pn + wc) * HD + 32 * bj; }
__device__ __forceinline__ int swiglu_src(int p0) { const int pn = p0 >> 8, bj = (p0 >> 7) & 1, r = p0 & 127; return bj * DFF + 128 * pn + r; }

constexpr int CV_POOL = 2 * 4 * 4 * 8, CV_WQ = 2 * 16 * 32, CV_WO = 2 * 16 * 32, CV_WKV = 16 * 16, CV_WIN = 4 * 16 * 176, CV_WOUT = 4 * 44 * 32;
constexpr int CV_TOTAL = CV_POOL + CV_WQ + CV_WO + CV_WKV + CV_WIN + CV_WOUT;

__device__ __forceinline__ void convert_item(Frame& F, const Args& args, int it, LAS float* scr) {
    unsigned char* ws = F.ws;
    if (it < CV_POOL) {
        const int lg = it >> 5, r = it & 31, kb = r >> 3, nb = r & 7;
        transpose_item(FIN(11) + (size_t)lg * 65536, 256, 256, 64 * kb, 32 * nb, (bf16_t*)(ws + WS_WPOOL) + (size_t)lg * 65536, 32 * nb, scr, F.lane); return; }
    it -= CV_POOL;
    if (it < CV_WQ) { const int j = it >> 9, r = it & 511, kb = r >> 5, nb = r & 31;
        transpose_item(FIN(13) + (size_t)j * D * D, D, D, 64 * kb, headperm_src(32 * nb), (bf16_t*)(ws + WS_WQ) + (size_t)j * D * D, 32 * nb, scr, F.lane); return; }
    it -= CV_WQ;
    if (it < CV_WO) { const int j = it >> 9, r = it & 511, kb = r >> 5, nb = r & 31;
        transpose_item(FIN(16) + (size_t)j * D * D, D, D, 64 * kb, 32 * nb, (bf16_t*)(ws + WS_WO) + (size_t)j * D * D, 32 * nb, scr, F.lane); return; }
    it -= CV_WO;
    if (it < CV_WKV) { const int kb = it >> 4, nb = it & 15;
        transpose_item(FIN(20), 2 * KVD, D, 64 * kb, headperm_src(32 * nb), (bf16_t*)(ws + WS_WKV), 32 * nb, scr, F.lane); return; }
    it -= CV_WKV;
    if (it < CV_WIN) { const int l = it / (16 * 176), r = it % (16 * 176), kb = r / 176, nb = r % 176;
        transpose_item(FIN(22) + (size_t)l * D * NIN, NIN, D, 64 * kb, swiglu_src(32 * nb), (bf16_t*)(ws + WS_WIN) + (size_t)l * NIN * D, 32 * nb, scr, F.lane); return; }
    it -= CV_WIN;
    { const int l = it / (44 * 32), r = it % (44 * 32), kb = r >> 5, nb = r & 31;
        transpose_item(FIN(23) + (size_t)l * DFF * D, D, DFF, 64 * kb, 32 * nb, (bf16_t*)(ws + WS_WOUT) + (size_t)l * D * DFF, 32 * nb, scr, F.lane); }
}

constexpr int ADA_ITEMS = 4 * 48 + 16;
__device__ __forceinline__ void ada_item(Frame& F, const Args& args, int it) {
    LAS float* CA = (LAS float*)F.lds;
    LAS float* RED = (LAS float*)(F.lds + 49152);
    const float* W; const float* bias; float* out; int ldn, n0, ostride;
    if (it < 192) { const int l = it / 48; n0 = (it % 48) * 128; W = FIN(7) + (size_t)l * D * ADAW; ldn = ADAW; bias = FIN(8) + l * ADAW; out = (float*)(F.ws + WS_ADA) + (size_t)l * NBATCH * ADAW; ostride = ADAW; }
    else { n0 = (it - 192) * 128; W = FIN(18); ldn = 2 * D; bias = FIN(19); out = (float*)(F.ws + WS_ADAKV); ostride = 2 * D; }
    for (int idx = F.tid; idx < NBATCH * D; idx += NWAVES * 64) { const int b = idx >> 10, k = idx & 1023;
        const float c = b < NBP ? FIN(2)[b * D + k] : FIN(3)[(b - NBP) * D + k]; CA[k * 12 + b] = c / (1.0f + __expf(-c)); }
    LDS_WAIT(); __syncthreads();
    f32x2 acc[NBATCH];
#pragma unroll
    for (int b = 0; b < NBATCH; ++b) acc[b] = (f32x2){0.f, 0.f};
    const float* wp = W + (size_t)(F.wave * 128) * ldn + n0 + 2 * F.lane;
#pragma unroll 32
    for (int k = 0; k < 128; ++k) {
        const f32x2 wv = *(const f32x2*)(wp + (size_t)k * ldn);
        const LAS f32x4* cp = (const LAS f32x4*)(CA + (F.wave * 128 + k) * 12);
        const f32x4 c0 = cp[0], c1 = cp[1], c2 = cp[2];
        acc[0] += wv * c0[0]; acc[1] += wv * c0[1]; acc[2] += wv * c0[2]; acc[3] += wv * c0[3]; acc[4] += wv * c1[0];
        acc[5] += wv * c1[1]; acc[6] += wv * c1[2]; acc[7] += wv * c1[3]; acc[8] += wv * c2[0]; acc[9] += wv * c2[1];
    }
#pragma unroll
    for (int b = 0; b < NBATCH; ++b) *(LAS f32x2*)(RED + (F.wave * NBATCH + b) * 128 + 2 * F.lane) = acc[b];
    LDS_WAIT(); __syncthreads();
    for (int idx = F.tid; idx < NBATCH * 128; idx += NWAVES * 64) { const int b = idx >> 7, c = idx & 127; float s = bias[n0 + c];
#pragma unroll
        for (int w = 0; w < NWAVES; ++w) s += RED[(w * NBATCH + b) * 128 + c];
        out[(size_t)b * ostride + n0 + c] = s; }
    LDS_WAIT(); __syncthreads();
}

constexpr int BI_WIN = 4 * 44, BI_WQ = 2 * 8, BI_WKV = 4, BI_TOTAL = BI_WIN + BI_WQ + BI_WKV, SHP = D + 8;
__device__ __forceinline__ void bias_item(Frame& F, int it) {
    LAS bf16_t* SH = (LAS bf16_t*)F.lds;
    const bf16_t* W; const float* sh; int shs; float* out; int os, r0;
    if (it < BI_WIN) { const int l = it / 44; r0 = (it % 44) * 128; W = (const bf16_t*)(F.ws + WS_WIN) + (size_t)l * NIN * D; sh = (const float*)(F.ws + WS_ADA) + (size_t)l * NBATCH * ADAW + 3 * D; shs = ADAW;
        out = (float*)(F.ws + WS_BIN) + (size_t)l * NBATCH * NIN; os = NIN; }
    else if (it < BI_WIN + BI_WQ) { const int j = (it - BI_WIN) >> 3; r0 = ((it - BI_WIN) & 7) * 128; W = (const bf16_t*)(F.ws + WS_WQ) + (size_t)j * D * D; sh = (const float*)(F.ws + WS_ADA) + (size_t)(2 + j) * NBATCH * ADAW; shs = ADAW;
        out = (float*)(F.ws + WS_BQ) + (size_t)j * NBATCH * D; os = D; }
    else { r0 = (it - BI_WIN - BI_WQ) * 128; W = (const bf16_t*)(F.ws + WS_WKV); sh = (const float*)(F.ws + WS_ADAKV); shs = 2 * D; out = (float*)(F.ws + WS_BKV); os = 2 * KVD; }
    const bf16_t* wp = W + (size_t)(r0 + F.wave * 16 + (F.lane & 15)) * D + 8 * (F.lane >> 4);
    bf16x8 wf[32];
#pragma unroll
    for (int s_ = 0; s_ < 32; ++s_) wf[s_] = *(const bf16x8*)(wp + 32 * s_);
    for (int idx = F.tid; idx < 16 * D; idx += NWAVES * 64) { const int b = idx >> 10, k = idx & 1023; SH[b * SHP + k] = b < NBATCH ? (bf16_t)(pk_bf16(sh[(size_t)b * shs + k], 0.f) & 0xffffu) : (bf16_t)0; }
    LDS_WAIT(); __syncthreads();
    f32x4 acc = {0.f, 0.f, 0.f, 0.f};
    const LAS bf16_t* sp = SH + (F.lane & 15) * SHP + 8 * (F.lane >> 4);
#pragma unroll
    for (int s_ = 0; s_ < 32; ++s_) acc = __builtin_amdgcn_mfma_f32_16x16x32_bf16(*(const LAS bf16x8*)(sp + 32 * s_), wf[s_], acc, 0, 0, 0);
#pragma unroll
    for (int j = 0; j < 4; ++j) { const int b = 4 * (F.lane >> 4) + j; if (b < NBATCH) out[(size_t)b * os + r0 + F.wave * 16 + (F.lane & 15)] = acc[j]; }
    LDS_WAIT(); __syncthreads();
}

constexpr int PP_ITEMS = 2 * 128 + NBS;
__device__ __forceinline__ void pool_prep_item(Frame& F, const Args& args, int layer, int item, const float* xsrc_p, const float* xsrc_s, int pub_seam) {
    LAS float* RS = (LAS float*)F.lds;
    int bidx, t0, nrows, L, pos0, grow0; const float* xb; const float* hist; float* pout;
    if (item < 256) { bidx = item >> 7; t0 = (item & 127) * 64; nrows = 64; L = SEQ; pos0 = 0; grow0 = bidx * SEQ; xb = xsrc_p + (size_t)grow0 * D; hist = nullptr;
        pout = F.out + O_POOLP + (size_t)(layer * NBP + bidx) * PH * D; }
    else { const int bs = item - 256; bidx = NBP + bs; t0 = 0; nrows = LS; L = LS; pos0 = 4096; grow0 = MP + bs * LS; xb = xsrc_s + (size_t)(bs * LS) * D; hist = FIN(4) + (size_t)(layer * NBS + bs) * PH * D;
        pout = F.out + O_POOLS + (size_t)(layer * NBS + bs) * PH * D; }
    if (layer == 1) {
        const float* rss = (const float*)(F.ws + WS_SS) + (size_t)1 * MPAD + grow0;
        for (int e = F.tid; e < 15 + nrows; e += NWAVES * 64) { const int t = t0 - 15 + e; if (t >= 0) RS[e] = 1.0f / sqrtf(rss[t] * (1.0f / D) + EPS); }
    } else
    for (int e0 = F.wave; e0 < 15 + nrows; e0 += 5 * NWAVES) {
        f32x4 v[5][4];
#pragma unroll
        for (int q = 0; q < 5; ++q) { const int e = e0 + q * NWAVES, t = t0 - 15 + e; const bool ok = (e < 15 + nrows) && t >= 0; const f32x4* xr = (const f32x4*)(xb + (size_t)(ok ? t : t0) * D) + F.lane;
#pragma unroll
            for (int j = 0; j < 4; ++j) v[q][j] = xr[64 * j]; }
#pragma unroll
        for (int q = 0; q < 5; ++q) { const int e = e0 + q * NWAVES, t = t0 - 15 + e; float s_ = 0.f;
#pragma unroll
            for (int j = 0; j < 4; ++j) s_ += (v[q][j][0] * v[q][j][0] + v[q][j][1] * v[q][j][1]) + (v[q][j][2] * v[q][j][2] + v[q][j][3] * v[q][j][3]);
            s_ = wave_sum(s_, F.lane); if (F.lane == 0 && e < 15 + nrows && t >= 0) RS[e] = 1.0f / sqrtf(s_ * (1.0f / D) + EPS); }
    }
    LDS_WAIT(); __syncthreads();
    const int g = F.wave & 3, rh = F.wave >> 2, w = 2 << g, col = 256 * g + 4 * F.lane;
    const _Float16* xh = (const _Float16*)(F.ws + WS_XH) + (size_t)grow0 * D;
#define PP_LDX(t_) (layer == 1 ? __builtin_convertvector(*(const h16x4*)(xh + (size_t)(t_) * D + col), f32x4) : *(const f32x4*)(xb + (size_t)(t_) * D + col))
    if (32 * rh < nrows) {
        const float* ada = (const float*)(F.ws + WS_ADA) + ((size_t)layer * NBATCH + bidx) * ADAW;
        const f32x4 gm = *(const f32x4*)(FIN(9) + layer * D + col) * (*(const f32x4*)(ada + D + col) + 1.0f);
        const f32x4 sh = *(const f32x4*)(ada + col);
        const int tb = t0 + 32 * rh;
        const rsrc_t rw = mk_rsrc(F.ws, (unsigned)WS_END);
        const unsigned dout = (unsigned)WS_AB + ((unsigned)grow0 * D + col) * 2;
        f32x4 ring[16];
        ring[0] = (f32x4){0.f, 0.f, 0.f, 0.f};
#pragma unroll
        for (int j = 1; j < 16; ++j) { const int t = tb - 16 + j;
            if (t >= 0) ring[j] = PP_LDX(t) * RS[t - (t0 - 15)] * gm + sh;
            else if (hist) ring[j] = *(const f32x4*)(hist + (size_t)(15 + t) * D + col);
            else ring[j] = (f32x4){0.f, 0.f, 0.f, 0.f}; }
#pragma unroll
        for (int blk = 0; blk < 2; ++blk) if (32 * rh + 16 * blk < nrows) {
#pragma unroll
            for (int jj = 0; jj < 16; ++jj) { const int t = tb + 16 * blk + jj;
                const f32x4 h = PP_LDX(t) * RS[t - (t0 - 15)] * gm + sh;
                ring[jj] = h;
                f32x4 s = ring[jj] + ring[(jj + 15) & 15];
                if (w > 2) { s += ring[(jj + 14) & 15] + ring[(jj + 13) & 15];
                    if (w > 4) { s += (ring[(jj + 12) & 15] + ring[(jj + 11) & 15]) + (ring[(jj + 10) & 15] + ring[(jj + 9) & 15]);
                        if (w > 8) s += ((ring[(jj + 8) & 15] + ring[(jj + 7) & 15]) + (ring[(jj + 6) & 15] + ring[(jj + 5) & 15])) + ((ring[(jj + 4) & 15] + ring[(jj + 3) & 15]) + (ring[(jj + 2) & 15] + ring[(jj + 1) & 15])); } }
                const int cnt = min(w, pos0 + t + 1);
                const f32x4 d = s * (1.0f / (float)cnt) - h;
                u32x2 o; o.x = pk_bf16(d[0], d[1]); o.y = pk_bf16(d[2], d[3]);
                st8_wt(rw, dout + (unsigned)t * D * 2, o);
                if (t >= L - PH) *(f32x4*)(pout + (size_t)(t - (L - PH)) * D + col) = h; }
        }
    }
#undef PP_LDX
    if (pub_seam >= 0) pg8::dep_publish((unsigned*)(F.ws + WS_CTL) + CW_CNT, pub_seam, (grow0 + t0) >> 8, F.lane);
    LDS_WAIT(); __syncthreads();
}

__device__ __forceinline__ void ttable_all(Frame& F, const Args& args, int gt, int NGT) {
    const float* ADA = (const float*)(F.ws + WS_ADA); const float* ADAKV = (const float*)(F.ws + WS_ADAKV);
    float* T = (float*)(F.ws + WS_T);
    for (int e = gt; e < T_NVEC * TV; e += NGT) { const int id = e / TV, idx = e - id * TV, b = idx >> 10, c = idx & 1023; float v;
        if (id < T_GAINF) { const int l = id - T_GATE1; v = ADA[((size_t)l * NBATCH + b) * ADAW + 2 * D + c]; if (l < 2) v *= FIN(12)[l * D + c]; }
        else if (id < T_GATE2) { const int l = id - T_GAINF; v = FIN(10)[l * D + c] * (1.0f + ADA[((size_t)l * NBATCH + b) * ADAW + 4 * D + c]); }
        else if (id < T_GAINQ) { const int l = id - T_GATE2; v = ADA[((size_t)l * NBATCH + b) * ADAW + 5 * D + c]; }
        else if (id < T_GAINKV) { const int l = 2 + id - T_GAINQ; v = FIN(9)[l * D + c] * (1.0f + ADA[((size_t)l * NBATCH + b) * ADAW + D + c]); }
        else v = FIN(17)[c] * (1.0f + ADAKV[(size_t)b * 2 * D + D + c]);
        T[e] = v; }
}

#ifndef PH_MASK
#define PH_MASK 0x7ffff
#endif
#define WSP(T_, off) ((T_*)(wsl + (off)))
template <int ph> __device__ __forceinline__ void run_phase(Frame& F, const Args& args, const XcdBarrier& bar, const int lo, const int hi) {
        if (ph < lo || ph >= hi) return;
        unsigned char* wsl = F.ws; asm volatile("" : "+s"(wsl));
        int lanel; asm volatile("v_mbcnt_lo_u32_b32 %0, -1, 0\n\tv_mbcnt_hi_u32_b32 %0, -1, %0" : "=v"(lanel));
        const int tidl = F.wave * 64 + lanel;
        Frame Fp = F; Fp.tid = tidl; Fp.lane = lanel; Fp.ws = wsl;
        const int layer = ph < 6 ? 0 : ph < 10 ? 1 : ph < 15 ? 2 : 3;
        int Gp = F.G; asm volatile("" : "+s"(Gp));
        unsigned* cnt = WSP(unsigned, WS_CTL) + CW_CNT;
        const bool solo = true;
        const int krot = ph == 7 ? 19 : ph == 12 ? 6 : ph == 17 ? 25 : ph == 2 ? 1 : ph == 4 ? 2 : ph == 6 ? 3 : ph == 8 ? 4 : ph == 9 ? 5 : ph == 11 ? 6 : ph == 13 ? 7 : ph == 14 ? 8 : ph == 16 ? 9 : ph == 18 ? 10 : 0;
        int crot = (int)blockIdx.x; asm volatile("" : "+s"(crot)); (void)krot;
        pg8::DepOrder S; S.cnt = cnt; S.wseam = -1; S.pseam = -1; S.need_p = 0; S.need_s = 0; S.wait_next = 0; S.last_pm = -1;
#define PHQ(k) (ph == (k) && ((PH_MASK >> (k)) & 1))
        if (PHQ(0)) {
            for (int it = F.vcu; it < ADA_ITEMS; it += F.G) ada_item(Fp, args, it);
            LAS float* scr = (LAS float*)(Fp.lds + Fp.wave * 16384);
            const int gw = F.vcu * NWAVES + Fp.wave, NGW = F.G * NWAVES;
            for (int it = gw; it < CV_TOTAL; it += NGW) convert_item(Fp, args, it, scr);
            const int gt = F.vcu * NWAVES * 64 + Fp.tid, NGT = F.G * NWAVES * 64;
            for (int i = gt; i < (RSS_N + 1) * MPAD / 4; i += NGT) WSP(f32x4, WS_SS)[i] = (f32x4){0.f, 0.f, 0.f, 0.f};
            for (int i = gt; i < 2 * NBS * WIN * KVD / 4; i += NGT) {
                const int which = i >= NBS * WIN * KVD / 4, j = which ? i - NBS * WIN * KVD / 4 : i;
                const f32x4 v = ((const f32x4*)(which ? FIN(6) : FIN(5)))[j];
                u32x2 o; o.x = pk_bf16(v[0], v[1]); o.y = pk_bf16(v[2], v[3]);
                (which ? WSP(u32x2, WS_VC) : WSP(u32x2, WS_KC))[j] = o;
                const int e = j * 4, bs = e / (WIN * KVD), r = (e / KVD) % WIN, cidx = e % KVD;
                if (r >= LS) *(f32x4*)(F.out + (which ? O_VS : O_KS) + ((size_t)bs * WIN + (r - LS)) * KVD + cidx) = v;
            }
        } else if (PHQ(1)) {
            for (int it = F.vcu; it < PP_ITEMS; it += F.G) pool_prep_item(Fp, args, 0, it, FIN(0), FIN(1), -1);
            ttable_all(Fp, args, F.vcu * NWAVES * 64 + Fp.tid, F.G * NWAVES * 64);
            for (int it = F.G - 1 - F.vcu; it < BI_TOTAL; it += F.G) bias_item(Fp, it);
        } else if (PHQ(5)) {
            for (int it = F.vcu; it < PP_ITEMS; it += F.G) pool_prep_item(Fp, args, 1, it, nullptr, nullptr, solo ? -1 : 5);
        } else if (PHQ(2)) {
            int kp = 256; asm volatile("" : "+s"(kp));
            const float* Tt = WSP(const float, WS_T);
            if (F.vcu < 256) { sk::Gemm sg{WSP(const bf16_t, WS_AB), D, 1, WSP(const bf16_t, WS_WPOOL), 256, 0};
                sk::Res sr{FIN(1), nullptr, WSP(_Float16, WS_XH), Tt + (T_GATE1 + 0) * TV, Tt + (T_GAINF + 0) * TV, nullptr, WSP(bf16_t, WS_AQ), nullptr, WSP(float, WS_SS) + (size_t)(0) * MPAD}; sk::Head sh{};
                for (int tl = F.vcu; tl < 256; tl += F.G) sk::run<0, 1>(Fp.lds, tidl, tl, sg, sr, sh); }
            pg8::Gemm g{WSP(const bf16_t, WS_AB), WSP(const bf16_t, WS_WPOOL), D, 256, kp}; S.init(NTM - 1, 4, Gp, crot);
            if (!solo) S.pseam = 2;
            typedef pg8::EpiRes<true, 1, true> EP; EP E{Fp.lds + XIN_OFF, mk_rsrc(F.out, (unsigned)(O_END * 4)), mk_rsrc(wsl, (unsigned)WS_END), T_GATE1 + 0, T_GAINF + 0, 0, WSP(float, WS_SS) + (size_t)(0) * MPAD};
            pg8::gemm_phase<EP, pg8::DepOrder, true>(Fp.lds, tidl, g, S, E);
        } else if (PHQ(6)) {
            int kp = 256; asm volatile("" : "+s"(kp));
            if (F.vcu < 256) { const float* Tt = WSP(const float, WS_T); sk::Gemm sg{WSP(const bf16_t, WS_AB), D, 1, WSP(const bf16_t, WS_WPOOL) + (size_t)D * 256, 256, 0};
                sk::Res sr{nullptr, nullptr, WSP(_Float16, WS_XH), Tt + (T_GATE1 + 1) * TV, Tt + (T_GAINF + 1) * TV, nullptr, WSP(bf16_t, WS_AQ), nullptr, WSP(float, WS_SS) + (size_t)2 * MPAD}; sk::Head sh{};
                for (int tl = F.vcu; tl < 256; tl += F.G) sk::run<0, 1>(Fp.lds, tidl, tl, sg, sr, sh); }
            pg8::Gemm g{WSP(const bf16_t, WS_AB), WSP(const bf16_t, WS_WPOOL) + (size_t)D * 256, D, 256, kp}; S.init(NTM - 1, 4, Gp, crot);
            typedef pg8::EpiRes<false, 1, true> EP; EP E{nullptr, mk_rsrc(F.out, (unsigned)(O_END * 4)), mk_rsrc(wsl, (unsigned)WS_END), T_GATE1 + 1, T_GAINF + 1, 0, WSP(float, WS_SS) + (size_t)2 * MPAD};
            pg8::gemm_phase<EP, pg8::DepOrder, true>(Fp.lds, tidl, g, S, E);
        } else if (PHQ(11) || PHQ(16)) {
            const bf16_t* Bw = WSP(const bf16_t, WS_WO) + (size_t)(layer - 2) * D * D; float* rssp = WSP(float, WS_SS) + (size_t)(2 * layer) * MPAD;
            if (F.vcu < 256) { const float* Tt = WSP(const float, WS_T); sk::Gemm sg{WSP(const bf16_t, WS_AB), D, 0, Bw, D, 0};
                sk::Res sr{nullptr, nullptr, WSP(_Float16, WS_XH), Tt + (T_GATE1 + layer) * TV, Tt + (T_GAINF + layer) * TV, nullptr, WSP(bf16_t, WS_AQ), nullptr, rssp}; sk::Head sh{};
                for (int tl = F.vcu; tl < 256; tl += F.G) sk::run<0, 1>(Fp.lds, tidl, tl, sg, sr, sh); }
            pg8::Gemm g{WSP(const bf16_t, WS_AB), Bw, D, 0, D}; S.init(NTM - 1, 4, Gp, crot);
            typedef pg8::EpiRes<false, 1, true> EP; EP E{nullptr, mk_rsrc(F.out, (unsigned)(O_END * 4)), mk_rsrc(wsl, (unsigned)WS_END), T_GATE1 + layer, T_GAINF + layer, 0, rssp};
            pg8::gemm_phase<EP, pg8::DepOrder, true>(Fp.lds, tidl, g, S, E);
        } else if (PHQ(13)) {
            const bf16_t* Bw = WSP(const bf16_t, WS_WOUT) + (size_t)2 * D * DFF;
            if (F.vcu < 256) { const float* Tt = WSP(const float, WS_T); sk::Gemm sg{WSP(const bf16_t, WS_H), DFF, 0, Bw, DFF, 0};
                sk::Res sr{nullptr, nullptr, WSP(_Float16, WS_XH), Tt + (T_GATE2 + 2) * TV, Tt + (T_GAINQ + 1) * TV, nullptr, WSP(bf16_t, WS_AQ), nullptr, WSP(float, WS_SS) + (size_t)5 * MPAD}; sk::Head sh{};
                for (int tl = F.vcu; tl < 256; tl += F.G) sk::run<0, 1>(Fp.lds, tidl, tl, sg, sr, sh); }
            pg8::Gemm g{WSP(const bf16_t, WS_H), Bw, DFF, 0, DFF}; S.init(NTM - 1, 4, Gp, crot);
            typedef pg8::EpiRes<false, 1, true> EP; EP E{nullptr, mk_rsrc(F.out, (unsigned)(O_END * 4)), mk_rsrc(wsl, (unsigned)WS_END), T_GATE2 + 2, T_GAINQ + 1, 0, WSP(float, WS_SS) + (size_t)5 * MPAD};
            pg8::gemm_phase<EP, pg8::DepOrder, true>(Fp.lds, tidl, g, S, E);
        } else if (PHQ(8)) {
            pg8::Gemm g{WSP(const bf16_t, WS_H), WSP(const bf16_t, WS_WOUT) + (size_t)1 * D * DFF, DFF, 0, DFF}; S.init(NTM - 1, 4, Gp, crot);
            if (F.vcu < 256) { const float* Tt = WSP(const float, WS_T); sk::Gemm sg{g.A, g.lda, 0, g.Bt, g.K, 0};
                sk::Res sr{nullptr, nullptr, WSP(_Float16, WS_XH), Tt + (T_GATE2 + 1) * TV, Tt + (T_GAINQ + 0) * TV, Tt + T_GAINKV * TV, WSP(bf16_t, WS_AQ), WSP(bf16_t, WS_AB), WSP(float, WS_SS) + (size_t)(3) * MPAD}; sk::Head sh{};
                for (int tl = F.vcu; tl < 256; tl += F.G) sk::run<0, 1>(Fp.lds, tidl, tl, sg, sr, sh); }
            if (!solo) { S.wseam = 7; S.need_p = S.need_s = 22 * 8; S.pseam = 8; }
            typedef pg8::EpiRes<false, 2, true> EP; EP E{nullptr, mk_rsrc(F.out, (unsigned)(O_END * 4)), mk_rsrc(wsl, (unsigned)WS_END), T_GATE2 + 1, T_GAINQ + 0, T_GAINKV, WSP(float, WS_SS) + (size_t)(3) * MPAD};
            pg8::gemm_phase<EP, pg8::DepOrder, true>(Fp.lds, tidl, g, S, E);
        } else if (PHQ(4) || PHQ(18)) {
            pg8::Gemm g{WSP(const bf16_t, WS_H), WSP(const bf16_t, WS_WOUT) + (size_t)layer * D * DFF, DFF, 0, DFF}; S.init(NTM - 1, 4, Gp, crot);
            if (F.vcu < 256) { const float* Tt = WSP(const float, WS_T); sk::Gemm sg{g.A, g.lda, 0, g.Bt, g.K, 0};
                sk::Res sr{nullptr, ph == 18 ? F.out : nullptr, WSP(_Float16, WS_XH), Tt + (T_GATE2 + layer) * TV, nullptr, nullptr, nullptr, nullptr, ph == 4 ? WSP(float, WS_SS) + (size_t)1 * MPAD : nullptr}; sk::Head sh{};
                for (int tl = F.vcu; tl < 256; tl += F.G) sk::run<0, 1>(Fp.lds, tidl, tl, sg, sr, sh); }
            if (!solo) { S.wseam = ph - 1; S.need_p = S.need_s = 22 * 8; }
            if (ph == 4) { typedef pg8::EpiRes<false, 0, true, false> EP; EP E{nullptr, mk_rsrc(F.out, (unsigned)(O_END * 4)), mk_rsrc(wsl, (unsigned)WS_END), T_GATE2 + layer, 0, 0, WSP(float, WS_SS) + (size_t)1 * MPAD};
                pg8::gemm_phase<EP, pg8::DepOrder, true>(Fp.lds, tidl, g, S, E); }
            else { typedef pg8::EpiRes<false, 0, false, true> EP; EP E{nullptr, mk_rsrc(F.out, (unsigned)(O_END * 4)), mk_rsrc(wsl, (unsigned)WS_END), T_GATE2 + layer, 0, 0, nullptr};
                pg8::gemm_phase<EP, pg8::DepOrder, true>(Fp.lds, tidl, g, S, E); }
        } else if (PHQ(3) || PHQ(7) || PHQ(12) || PHQ(17)) {
            pg8::Gemm g{WSP(const bf16_t, WS_AQ), WSP(const bf16_t, WS_WIN) + (size_t)layer * NIN * D, D, 0, D}; S.init(NTM, NIN / 256, Gp, crot);
            if (!solo) { S.wseam = ph - 1; S.need_p = S.need_s = 4 * 8; S.pseam = ph; }
            pg8::EpiSwiglu E{WSP(const float, WS_SS) + (size_t)(2 * layer) * MPAD, WSP(const float, WS_BIN) + (size_t)layer * NBATCH * NIN, mk_rsrc(wsl, (unsigned)WS_END)};
            pg8::gemm_phase<pg8::EpiSwiglu, pg8::DepOrder, true>(Fp.lds, tidl, g, S, E);
        } else if (PHQ(9) || PHQ(14)) {
            const int j = layer - 1;
            if (ph == 14) { sk::Gemm sg{WSP(const bf16_t, WS_AQ), D, 0, WSP(const bf16_t, WS_WQ) + (size_t)j * D * D, D, 1}; sk::Res sr{};
                sk::Head sh{WSP(const float, WS_SS) + (size_t)5 * MPAD, WSP(const float, WS_BQ) + (size_t)j * NBATCH * D, FIN(14) + j * HD, att::C2, WSP(bf16_t, WS_QO)};
                for (int tl = F.vcu; tl < 64; tl += F.G) sk::run<1, 4>(Fp.lds, tidl, tl, sg, sr, sh); }
            { pg8::Gemm g{WSP(const bf16_t, WS_AQ), WSP(const bf16_t, WS_WQ) + (size_t)j * D * D, D, 0, D}; S.init(ph == 14 ? NTM - 1 : NTM, 4, Gp, crot);
              pg8::EpiHead<0> E{WSP(const float, WS_SS) + (size_t)(ph == 9 ? 3 : 5) * MPAD, WSP(const float, WS_BQ) + (size_t)j * NBATCH * D, D, FIN(14) + j * HD, att::C2, mk_rsrc(wsl, (unsigned)WS_END), nullptr, nullptr, nullptr, nullptr};
              pg8::gemm_phase<pg8::EpiHead<0>, pg8::DepOrder, true>(Fp.lds, tidl, g, S, E); }
            if (ph == 9) {
              pg8::Gemm g{WSP(const bf16_t, WS_AB), WSP(const bf16_t, WS_WKV), D, 0, D}; S.init(NTM, 2, Gp, Gp - 1 - crot); S.last_pm = -1;
              pg8::EpiHead<1> E{WSP(const float, WS_SS) + (size_t)3 * MPAD, WSP(const float, WS_BKV), 2 * KVD, FIN(21), 1.0f, mk_rsrc(wsl, (unsigned)WS_END), F.out + O_KP, F.out + O_VP, F.out + O_KS, F.out + O_VS};
              pg8::gemm_phase<pg8::EpiHead<1>, pg8::DepOrder, true>(Fp.lds, tidl, g, S, E); }
        } else if (PHQ(10) || PHQ(15)) {
            const float* sk = FIN(15) + (layer - 2) * NH;
            att::attn_phase(Fp.lds, tidl, F.vcu, F.G, NBP * 128 * NKV + NBS * NKV, 0, 0, WSP(const bf16_t, WS_QO), wsl, WSP(const bf16_t, WS_KB), WSP(const bf16_t, WS_VB), WSP(const bf16_t, WS_KC), WSP(const bf16_t, WS_VC), sk);
        }
        if (ph + 1 < hi) xcd_barrier(bar, tidl);
}
#undef WSP

__global__ void __launch_bounds__(NWAVES * 64, 2) yoco_fwd(Args args) {
    extern __shared__ __attribute__((aligned(16))) unsigned char lds_raw[];
    Frame F;
    F.lds = (LAS unsigned char*)lds_raw;
    F.tid = 0; F.lane = 0; F.wave = __builtin_amdgcn_readfirstlane((int)threadIdx.x >> 6);
    F.G = gridDim.x; { const int bx = blockIdx.x; int v_ = ((F.G & 7) == 0) ? (bx & 7) * (F.G >> 3) + (bx >> 3) : bx; asm volatile("" : "+s"(v_)); F.vcu = v_; }
    F.out = args.out; F.ws = args.ws;
    for (int u = threadIdx.x; u < (LDS_BYTES - LDSCTL_OFF) / 4; u += NWAVES * 64) ((LAS unsigned*)(F.lds + LDSCTL_OFF))[u] = 0u;
    __syncthreads();
    if (threadIdx.x == 0) { ((LAS unsigned long long*)(F.lds + XIN_OFF))[0] = (unsigned long long)FIN(0); ((LAS unsigned long long*)(F.lds + XIN_OFF))[1] = (unsigned long long)(FIN(1) - (size_t)MP * D); }
    __syncthreads();
    const int lo = args.ph_lo, hi = args.ph_hi;
    XcdBarrier bar; bar.bar = (unsigned*)(args.ws + WS_CTL) + CW_BAR; bar.x = 0; bar.st = nullptr;
    if (hi - lo > 1) bar = xcd_barrier_post((unsigned*)(args.ws + WS_CTL) + CW_BAR, (volatile LAS unsigned*)(F.lds + MISC_OFF) + 8);
    run_phase<0>(F, args, bar, lo, hi);  run_phase<1>(F, args, bar, lo, hi);  run_phase<2>(F, args, bar, lo, hi);  run_phase<3>(F, args, bar, lo, hi);  run_phase<4>(F, args, bar, lo, hi);
    run_phase<5>(F, args, bar, lo, hi);  run_phase<6>(F, args, bar, lo, hi);  run_phase<7>(F, args, bar, lo, hi);  run_phase<8>(F, args, bar, lo, hi);  run_phase<9>(F, args, bar, lo, hi);
    run_phase<10>(F, args, bar, lo, hi); run_phase<11>(F, args, bar, lo, hi); run_phase<12>(F, args, bar, lo, hi); run_phase<13>(F, args, bar, lo, hi); run_phase<14>(F, args, bar, lo, hi);
    run_phase<15>(F, args, bar, lo, hi); run_phase<16>(F, args, bar, lo, hi); run_phase<17>(F, args, bar, lo, hi); run_phase<18>(F, args, bar, lo, hi);
}

extern "C" void kernel_launch(void* const* d_in, const int* in_sizes, int n_in, void* d_out, int out_size, void* d_ws, size_t ws_size, hipStream_t stream) {
    static int grid = 0;
    if (grid == 0) {
        if (n_in != 24 || (size_t)out_size != O_END || ws_size < WS_END) { fprintf(stderr, "kernel_launch: unexpected sizes n_in %d out %d ws %zu\n", n_in, out_size, ws_size); grid = -1; return; }
        int dev = 0, cus = 0, per_cu = 0;
        if (hipGetDevice(&dev) != hipSuccess || hipDeviceGetAttribute(&cus, hipDeviceAttributeMultiprocessorCount, dev) != hipSuccess) { grid = -1; return; }
        if (hipFuncSetAttribute((const void*)yoco_fwd, hipFuncAttributeMaxDynamicSharedMemorySize, LDS_BYTES) != hipSuccess) { fprintf(stderr, "kernel_launch: hipFuncSetAttribute failed\n"); grid = -1; return; }
        if (hipOccupancyMaxActiveBlocksPerMultiprocessor(&per_cu, (const void*)yoco_fwd, NWAVES * 64, LDS_BYTES) != hipSuccess || per_cu < 1) { fprintf(stderr, "kernel_launch: occupancy query reports %d blocks per CU\n", per_cu); grid = -1; (void)hipGetLastError(); return; }
        grid = cus;
    }
    if (grid < 0) return;
    (void)hipMemsetAsync((char*)d_ws + WS_CTL, 0, CTL_ZERO_BYTES, stream);
    Args a{};
    for (int i = 0; i < 24; ++i) a.in[i] = (const float*)d_in[i];
    a.out = (float*)d_out; a.ws = (unsigned char*)d_ws;
#if MK_ONE_LAUNCH
    a.ph_lo = 0; a.ph_hi = NPHASE;
    hipLaunchKernelGGL(yoco_fwd, dim3(grid), dim3(NWAVES * 64), LDS_BYTES, stream, a);
#else
#ifndef DUP_MASK
#define DUP_MASK 0
#endif
#ifdef PRE_PHASE
    { a.ph_lo = PRE_PHASE; a.ph_hi = PRE_PHASE + 1; hipLaunchKernelGGL(yoco_fwd, dim3(grid), dim3(NWAVES * 64), LDS_BYTES, stream, a); }
#endif
    for (int p = 0; p < NPHASE; ++p) { a.ph_lo = p; a.ph_hi = p + 1; hipLaunchKernelGGL(yoco_fwd, dim3(grid), dim3(NWAVES * 64), LDS_BYTES, stream, a);
        if ((DUP_MASK >> p) & 1) hipLaunchKernelGGL(yoco_fwd, dim3(grid), dim3(NWAVES * 64), LDS_BYTES, stream, a); }
#endif
}
```
